# Optimizing an MI355X kernel written in HIP

```python
import jax, jax.numpy as jnp
from jax import lax
import numpy as np

D_MODEL = 1024
BATCH = 8
SEQ = 2048
DEPTH = 1
DEC_BATCH = 128
DEC_SEQ = 8
PAST_LEN = 8192
PAGE_SIZE = 128

D_MIX = D_MODEL
D_ATTN = D_MIX // 2
D_SSM = D_MIX - D_ATTN
V_HEAD = 64
MLA_HEADS = D_ATTN // V_HEAD
QK_NOPE = 64
QK_ROPE = 32
KV_LORA = D_MODEL // 4
Q_LORA = (3 * D_MODEL) // 8
ROPE_THETA = 10000.0
SSM_HEADDIM = 64
SSM_HEADS = D_SSM // SSM_HEADDIM
SSM_GROUPS = 2
D_STATE = 128
CONV_K = 4
CHUNK = 256
CONV_DIM = D_SSM + 2 * SSM_GROUPS * D_STATE
D_FF = 4 * D_MODEL
N_IN = Q_LORA + KV_LORA + QK_ROPE + D_SSM + CONV_DIM + SSM_HEADS
EPS = 1e-6
QBLOCK = 128

kernel_name = 'hymba_mla_ssd_decode_step'


def rmsnorm(x, g):
    xf = x.astype(jnp.float32)
    xf = xf * lax.rsqrt(jnp.mean(xf * xf, axis=-1, keepdims=True) + EPS)
    return (xf * g.astype(jnp.float32)).astype(x.dtype)


def rope_tables(pos):
    inv = ROPE_THETA ** (-(jnp.arange(0, QK_ROPE, 2, dtype=jnp.float32) / QK_ROPE))
    ang = pos.astype(jnp.float32)[:, None] * inv[None, :]
    return jnp.cos(ang), jnp.sin(ang)


def apply_rope(x, cos, sin):
    half = QK_ROPE // 2
    xf = x.astype(jnp.float32)
    x1, x2 = xf[..., :half], xf[..., half:]
    return jnp.concatenate([x1 * cos - x2 * sin, x2 * cos + x1 * sin], axis=-1).astype(x.dtype)


def mla_attend(q_abs, q_pe, c_kv, k_pe, q_pos, k_pos):
    b, lq, h, r = q_abs.shape
    qb = QBLOCK if lq % QBLOCK == 0 else lq
    nb = lq // qb
    scale = (QK_NOPE + QK_ROPE) ** -0.5
    qa = jnp.moveaxis(q_abs.reshape(b, nb, qb, h, r), 1, 0)
    qp = jnp.moveaxis(q_pe.reshape(b, nb, qb, h, QK_ROPE), 1, 0)
    qpos = q_pos.reshape(nb, qb)

    def block(args):
        qa_b, qp_b, pos_b = args
        s = (jnp.einsum('bqhr,bkr->bhqk', qa_b, c_kv) + jnp.einsum('bqhd,bkd->bhqk', qp_b, k_pe)).astype(jnp.float32) * scale
        mask = k_pos[None, :] <= pos_b[:, None]
        s = jnp.where(mask[None, None], s, -jnp.inf)
        p = jax.nn.softmax(s, axis=-1).astype(c_kv.dtype)
        return jnp.einsum('bhqk,bkr->bqhr', p, c_kv)

    out = lax.map(block, (qa, qp, qpos))
    return jnp.moveaxis(out, 0, 1).reshape(b, lq, h, r)


def ssd_chunked(x, dt, A, Bm, Cm, h0):
    b, L, H, P = x.shape
    G, N = Bm.shape[2], Bm.shape[3]
    E = H // G
    Q = min(CHUNK, L)
    pad = (-L) % Q
    x = x.astype(jnp.float32)
    dt = dt.astype(jnp.float32)
    Bm = Bm.astype(jnp.float32)
    Cm = Cm.astype(jnp.float32)
    if pad:
        x = jnp.pad(x, ((0, 0), (0, pad), (0, 0), (0, 0)))
        dt = jnp.pad(dt, ((0, 0), (0, pad), (0, 0)))
        Bm = jnp.pad(Bm, ((0, 0), (0, pad), (0, 0), (0, 0)))
        Cm = jnp.pad(Cm, ((0, 0), (0, pad), (0, 0), (0, 0)))
    nc = (L + pad) // Q
    xc = x.reshape(b, nc, Q, G, E, P)
    dtc = dt.reshape(b, nc, Q, G, E)
    Bc = Bm.reshape(b, nc, Q, G, N)
    Cc = Cm.reshape(b, nc, Q, G, N)
    acs = jnp.cumsum(dtc * A.astype(jnp.float32).reshape(G, E), axis=2)
    causal = jnp.tril(jnp.ones((Q, Q), dtype=bool))
    seg = acs[:, :, :, None] - acs[:, :, None, :]
    lmat = jnp.exp(jnp.where(causal[:, :, None, None], seg, -jnp.inf))
    x_dt = xc * dtc[..., None]
    cb = jnp.einsum('bcqgn,bcsgn->bcqsg', Cc, Bc)
    y_diag = jnp.einsum('bcqsge,bcsgep->bcqgep', cb[..., None] * lmat, x_dt)
    decay_to_end = jnp.exp(acs[:, :, -1:] - acs)
    chunk_states = jnp.einsum('bcsgn,bcsgep->bcgepn', Bc, x_dt * decay_to_end[..., None])
    chunk_decay = jnp.exp(acs[:, :, -1])

    def step(h, inp):
        dec, st = inp
        return dec[..., None, None] * h + st, h

    h_init = h0.astype(jnp.float32).reshape(b, G, E, P, N)
    h_final, h_prev = lax.scan(step, h_init, (jnp.moveaxis(chunk_decay, 1, 0), jnp.moveaxis(chunk_states, 1, 0)))
    h_prev = jnp.moveaxis(h_prev, 0, 1)
    y_off = jnp.einsum('bcqgn,bcgepn->bcqgep', Cc, h_prev) * jnp.exp(acs)[..., None]
    y = (y_diag + y_off).reshape(b, nc * Q, H, P)[:, :L]
    return y, h_final.reshape(b, H, P, N)


def mixer_block(x, c_past, kr_past, h0, conv_buf, norm_attn, w_in, q_norm, kv_norm, w_uq, w_uk, w_uv,
                conv_w, conv_b, dt_bias, a_log, d_skip, ssm_norm, w_out):
    b, L, _ = x.shape
    past_len = c_past.shape[1]
    h = rmsnorm(x, norm_attn)
    proj = jnp.einsum('bld,dn->bln', h, w_in)
    o1 = Q_LORA
    o2 = o1 + KV_LORA
    o3 = o2 + QK_ROPE
    o4 = o3 + D_SSM
    o5 = o4 + CONV_DIM
    q_lat, kv_lat, k_pe, z, xbc, dt_raw = jnp.split(proj, [o1, o2, o3, o4, o5], axis=-1)
    q_pos = past_len + jnp.arange(L, dtype=jnp.int32)
    cos, sin = rope_tables(q_pos)
    q = jnp.einsum('blr,rn->bln', rmsnorm(q_lat, q_norm), w_uq).reshape(b, L, MLA_HEADS, QK_NOPE + QK_ROPE)
    q_nope, q_pe = q[..., :QK_NOPE], q[..., QK_NOPE:]
    q_pe = apply_rope(q_pe, cos[:, None, :], sin[:, None, :])
    c_new = rmsnorm(kv_lat, kv_norm)
    kr_new = apply_rope(k_pe, cos, sin)
    q_abs = jnp.einsum('blhd,hdr->blhr', q_nope, w_uk)
    c_all = jnp.concatenate([c_past.astype(c_new.dtype), c_new], axis=1)
    kr_all = jnp.concatenate([kr_past.astype(kr_new.dtype), kr_new], axis=1)
    k_pos = jnp.arange(past_len + L, dtype=jnp.int32)
    o_lat = mla_attend(q_abs, q_pe, c_all, kr_all, q_pos, k_pos)
    o_attn = jnp.einsum('blhr,hrv->blhv', o_lat, w_uv).reshape(b, L, D_ATTN)
    xpad = jnp.concatenate([conv_buf.astype(xbc.dtype), xbc], axis=1)
    conv = conv_b
    for k in range(CONV_K):
        conv = conv + xpad[:, k:k + L] * conv_w[k]
    conv = jax.nn.silu(conv)
    conv_new = xpad[:, L:]
    xs, Bm, Cm = jnp.split(conv, [D_SSM, D_SSM + SSM_GROUPS * D_STATE], axis=-1)
    xs = xs.reshape(b, L, SSM_HEADS, SSM_HEADDIM)
    dt = jax.nn.softplus(dt_raw.astype(jnp.float32) + dt_bias.astype(jnp.float32))
    A = -jnp.exp(a_log.astype(jnp.float32))
    y, h_new = ssd_chunked(xs, dt, A, Bm.reshape(b, L, SSM_GROUPS, D_STATE), Cm.reshape(b, L, SSM_GROUPS, D_STATE), h0)
    y = y + d_skip.astype(jnp.float32)[:, None] * xs.astype(jnp.float32)
    g = y.reshape(b, L, D_SSM) * jax.nn.silu(z.astype(jnp.float32))
    g = g.reshape(b, L, SSM_GROUPS, D_SSM // SSM_GROUPS)
    g = g * lax.rsqrt(jnp.mean(g * g, axis=-1, keepdims=True) + EPS)
    o_ssm = (g.reshape(b, L, D_SSM) * ssm_norm.astype(jnp.float32)).astype(x.dtype)
    out = jnp.einsum('blm,md->bld', jnp.concatenate([o_attn, o_ssm], axis=-1), w_out)
    return out, c_new, kr_new, h_new.astype(h0.dtype), conv_new


def sq_relu_mlp(x, g, w_up, w_down):
    u = jax.nn.relu(jnp.einsum('bld,df->blf', rmsnorm(x, g), w_up))
    return jnp.einsum('blf,fd->bld', u * u, w_down)


def setup_inputs(seed: int = 0) -> dict:
    key = jax.random.key(seed)
    ks = jax.random.split(key, 32)
    n_pages = PAST_LEN // PAGE_SIZE
    used = DEC_BATCH * n_pages
    n_pool = used + used // 4
    f32 = jnp.float32

    def nrm(k, shape, scale):
        return jax.random.normal(k, shape, f32) * scale

    dt0 = jnp.exp(jax.random.uniform(ks[14], (DEPTH, SSM_HEADS), f32, np.log(1e-3), np.log(1e-1)))
    return {
        'x_prompt': nrm(ks[0], (BATCH, SEQ, D_MODEL), 1.0),
        'x_sample': nrm(ks[1], (DEC_BATCH, DEC_SEQ, D_MODEL), 1.0),
        'cache_kv_latent': nrm(ks[2], (DEPTH, n_pool, PAGE_SIZE, KV_LORA), 1.0),
        'cache_k_rope': nrm(ks[3], (DEPTH, n_pool, PAGE_SIZE, QK_ROPE), 1.0),
        'state_ssm': nrm(ks[4], (DEPTH, DEC_BATCH, SSM_HEADS, SSM_HEADDIM, D_STATE), 0.1),
        'state_conv': nrm(ks[5], (DEPTH, DEC_BATCH, CONV_K - 1, CONV_DIM), 1.0),
        'page_table': jax.random.permutation(ks[6], n_pool)[:used].reshape(DEC_BATCH, n_pages).astype(jnp.int32),
        'norm_attn': 1.0 + nrm(ks[7], (DEPTH, D_MODEL), 0.02),
        'w_in': nrm(ks[8], (DEPTH, D_MODEL, N_IN), D_MODEL ** -0.5),
        'q_norm': 1.0 + nrm(ks[9], (DEPTH, Q_LORA), 0.02),
        'kv_norm': 1.0 + nrm(ks[10], (DEPTH, KV_LORA), 0.02),
        'w_uq': nrm(ks[11], (DEPTH, Q_LORA, MLA_HEADS * (QK_NOPE + QK_ROPE)), Q_LORA ** -0.5),
        'w_uk': nrm(ks[12], (DEPTH, MLA_HEADS, QK_NOPE, KV_LORA), KV_LORA ** -0.5),
        'w_uv': nrm(ks[13], (DEPTH, MLA_HEADS, KV_LORA, V_HEAD), KV_LORA ** -0.5),
        'conv_w': nrm(ks[15], (DEPTH, CONV_K, CONV_DIM), CONV_K ** -0.5),
        'conv_b': nrm(ks[16], (DEPTH, CONV_DIM), 0.02),
        'dt_bias': dt0 + jnp.log(-jnp.expm1(-dt0)),
        'a_log': jnp.log(jax.random.uniform(ks[17], (DEPTH, SSM_HEADS), f32, 1.0, 16.0)),
        'd_skip': 1.0 + nrm(ks[18], (DEPTH, SSM_HEADS), 0.1),
        'ssm_norm': 1.0 + nrm(ks[19], (DEPTH, D_SSM), 0.02),
        'w_out': nrm(ks[20], (DEPTH, D_MIX, D_MODEL), D_MIX ** -0.5),
        'norm_mlp': 1.0 + nrm(ks[21], (DEPTH, D_MODEL), 0.02),
        'w_up': nrm(ks[22], (DEPTH, D_MODEL, D_FF), D_MODEL ** -0.5),
        'w_down': nrm(ks[23], (DEPTH, D_FF, D_MODEL), D_FF ** -0.5),
        'norm_final': 1.0 + nrm(ks[24], (D_MODEL,), 0.02),
    }


def reference(x_prompt, x_sample, cache_kv_latent, cache_k_rope, state_ssm, state_conv, page_table,
              norm_attn, w_in, q_norm, kv_norm, w_uq, w_uk, w_uv, conv_w, conv_b, dt_bias, a_log, d_skip,
              ssm_norm, w_out, norm_mlp, w_up, w_down, norm_final):
    bp = x_prompt.shape[0]
    bs, n_pages = page_table.shape
    page = cache_kv_latent.shape[2]
    xp, xs = x_prompt, x_sample
    ckv_p, ckr_p, ssm_p, conv_p = [], [], [], []
    ckv_s, ckr_s, ssm_s, conv_s = [], [], [], []
    for l in range(DEPTH):
        lw = (norm_attn[l], w_in[l], q_norm[l], kv_norm[l], w_uq[l], w_uk[l], w_uv[l], conv_w[l], conv_b[l],
              dt_bias[l], a_log[l], d_skip[l], ssm_norm[l], w_out[l])
        att, c_new, kr_new, h_new, cv_new = mixer_block(
            xp, jnp.zeros((bp, 0, KV_LORA), xp.dtype), jnp.zeros((bp, 0, QK_ROPE), xp.dtype),
            jnp.zeros((bp, SSM_HEADS, SSM_HEADDIM, D_STATE), xp.dtype), jnp.zeros((bp, CONV_K - 1, CONV_DIM), xp.dtype), *lw)
        xp = xp + att
        xp = xp + sq_relu_mlp(xp, norm_mlp[l], w_up[l], w_down[l])
        ckv_p.append(c_new); ckr_p.append(kr_new); ssm_p.append(h_new); conv_p.append(cv_new)
        c_past = cache_kv_latent[l][page_table].reshape(bs, n_pages * page, KV_LORA)
        kr_past = cache_k_rope[l][page_table].reshape(bs, n_pages * page, QK_ROPE)
        att, c_new, kr_new, h_new, cv_new = mixer_block(xs, c_past, kr_past, state_ssm[l], state_conv[l], *lw)
        xs = xs + att
        xs = xs + sq_relu_mlp(xs, norm_mlp[l], w_up[l], w_down[l])
        ckv_s.append(c_new); ckr_s.append(kr_new); ssm_s.append(h_new); conv_s.append(cv_new)
    y_prompt = rmsnorm(xp, norm_final)
    y_sample = rmsnorm(xs, norm_final)
    return (y_prompt, y_sample,
            jnp.stack(ckv_p), jnp.stack(ckr_p), jnp.stack(ssm_p), jnp.stack(conv_p),
            jnp.stack(ckv_s), jnp.stack(ckr_s), jnp.stack(ssm_s), jnp.stack(conv_s))
```

```cpp
#include <hip/hip_runtime.h>
#include <cstdio>
#include <cstdint>
#define XB_TMO      128
#define XB_XCNT(j)  (256  + 64 * (j))
#define XB_XSUB(j)  (1280 + 64 * (j))
#define XB_XGEN(j)  (2304 + 64 * (j))
#define XB_TOP      3328
#define XB_TOPGEN   3392
#define XCD_BAR_WORDS 3456
#define XB_SPIN_CAP (1u << 18)
#define LAS __attribute__((address_space(3)))

__device__ __forceinline__ unsigned xb_ld(unsigned* p)              { return __hip_atomic_load(p, __ATOMIC_RELAXED, __HIP_MEMORY_SCOPE_AGENT); }
__device__ __forceinline__ unsigned xb_add(unsigned* p, unsigned v) { return __hip_atomic_fetch_add(p, v, __ATOMIC_RELAXED, __HIP_MEMORY_SCOPE_AGENT); }
__device__ __forceinline__ unsigned xb_xcc_id() { return (unsigned)__builtin_amdgcn_s_getreg((3 << 11) | 20) & 0xFu; }
#define XB_SPIN(cond, bar) do { unsigned _sp = 0; while (cond) { __builtin_amdgcn_s_sleep(1); \
    if ((++_sp & 255u) == 0u) { if (xb_ld(&(bar)[XB_TMO])) break; if (_sp > XB_SPIN_CAP) { atomicAdd(&(bar)[XB_TMO], 1u); break; } } } } while (0)

struct XcdBarrier {
    unsigned* bar; unsigned x;
    volatile LAS unsigned* st;
};

__device__ __forceinline__ XcdBarrier xcd_barrier_post(unsigned* bar, volatile LAS unsigned* st) {
    XcdBarrier b; b.bar = bar; b.x = xb_xcc_id(); b.st = st;
    if (threadIdx.x == 0) (void)xb_add(&bar[XB_XCNT(b.x)], 1u);
    return b;
}
__device__ __forceinline__ void xcd_barrier_complete(unsigned* bar, unsigned x, unsigned& nloc, unsigned& nx) {
    const unsigned G = gridDim.x * gridDim.y * gridDim.z;
    unsigned sum, cnt, mine, sp = 0u;
    for (;;) {
        sum = 0u; cnt = 0u; mine = 0u;
#pragma unroll
        for (unsigned j = 0; j < 16; ++j) { const unsigned c = xb_ld(&bar[XB_XCNT(j)]); sum += c; cnt += (c > 0u) ? 1u : 0u; mine = (j == x) ? c : mine; }
        if (sum == G) break;
        __builtin_amdgcn_s_sleep(1);
        if ((++sp & 255u) == 0u) { if (xb_ld(&bar[XB_TMO])) break; if (sp > XB_SPIN_CAP) { atomicAdd(&bar[XB_TMO], 1u); break; } }
    }
    nloc = mine > 0u ? mine : 1u; nx = cnt > 0u ? cnt : 1u;
}

__device__ __forceinline__ void xcd_barrier(const XcdBarrier& b) {
    asm volatile("s_waitcnt vmcnt(0)" ::: "memory");
    __syncthreads();
    if (threadIdx.x == 0) {
        unsigned* bar = b.bar;
        __builtin_amdgcn_s_waitcnt(0);
        unsigned nloc = b.st[0], nx = b.st[1];
        if (nloc == 0u) { xcd_barrier_complete(bar, b.x, nloc, nx); b.st[0] = nloc; b.st[1] = nx; }
        const unsigned old = xb_add(&bar[XB_XSUB(b.x)], 1u);
        const unsigned gen = old / nloc;
        if (old + 1u == (gen + 1u) * nloc) {
            __builtin_amdgcn_fence(__ATOMIC_RELEASE, "agent");
            asm volatile("s_waitcnt vmcnt(0)" ::: "memory");
            const unsigned og = xb_add(&bar[XB_TOP], 1u);
            const unsigned tg = og / nx;
            if (og + 1u == (tg + 1u) * nx) xb_add(&bar[XB_TOPGEN], 1u);
            else XB_SPIN(xb_ld(&bar[XB_TOPGEN]) == tg, bar);
            __builtin_amdgcn_fence(__ATOMIC_ACQUIRE, "agent");
            xb_add(&bar[XB_XGEN(b.x)], 1u);
            asm volatile("s_waitcnt vmcnt(0)" ::: "memory");
        } else {
            XB_SPIN(xb_ld(&bar[XB_XGEN(b.x)]) == gen, bar);
            __builtin_amdgcn_fence(__ATOMIC_ACQUIRE, "agent");
            asm volatile("s_waitcnt vmcnt(0)" ::: "memory");
        }
    }
    __syncthreads();
}
namespace pg8 {
__device__ __forceinline__ int opaque_tid() { int t; asm volatile("v_mov_b32 %0, %1" : "=v"(t) : "v"((int)threadIdx.x)); return t; }
#define PG8_LAS __attribute__((address_space(3)))
typedef unsigned short bf16_t;
typedef short bf16x8 __attribute__((ext_vector_type(8)));
typedef float f32x4 __attribute__((ext_vector_type(4)));
typedef unsigned u32x4 __attribute__((ext_vector_type(4)));
constexpr int BM = 256, BK = 64, HALF = 128, HTB = HALF * BK * 2  , STAGE_BYTES = 8 * HTB, NXCD = 8, WGM = 8;

__host__ __device__ __forceinline__ int lds_byte(int r, int c) { const int st = (r >> 4) * 2 + (c >> 5), rr = r & 15, cc = c & 31, ob = rr * 64 + cc * 2; return st * 1024 + (ob ^ (((ob >> 9) & 1) << 5)); }
__host__ __device__ __forceinline__ void stage_rc(int b, int& R, int& C) { const int st = b / 1024, sb = b % 1024, swz = sb ^ (((sb >> 9) & 1) << 5); R = (st >> 1) * 16 + swz / 64; C = (st & 1) * 32 + (swz % 64) / 2; }
__host__ __device__ __forceinline__ int perm32(int rho) { const int n = rho >> 4, i = rho & 15; return 8 * (i >> 2) + 4 * n + (i & 3); }

struct Unit { int pm, pn; };
struct Gemm { const bf16_t* A; const bf16_t* Bt; int M, N, K; };

struct StaticOrder {
    int nM, nN, nwg, G, c;
    __host__ __device__ void init(int M, int N, int G_, int c_) { nM = M / BM; nN = N / BM; nwg = nM * nN; G = G_; c = c_; }
    __host__ __device__ bool next(int i, Unit& u) const {
        const long L = (long)i * G + c; if (L >= nwg) return false;
        int wgid = (int)L; { const int q = nwg / NXCD, r = nwg % NXCD, xcd = wgid % NXCD, off = wgid / NXCD; wgid = (xcd < r ? xcd * (q + 1) : r * (q + 1) + (xcd - r) * q) + off; }
        const int nig = WGM * nN, gid = wgid / nig, fm = gid * WGM, gsz = (nM - fm) < WGM ? (nM - fm) : WGM;
        u.pm = fm + ((wgid % nig) % gsz); u.pn = (wgid % nig) / gsz; return true;
    }
    __device__ __forceinline__ void a_ready(const Unit&) const {}
    __device__ __forceinline__ void done(const Unit&) const {}
};

__device__ __forceinline__ unsigned cvt_pk_bf16(float lo, float hi) { unsigned r; asm volatile("v_cvt_pk_bf16_f32 %0, %1, %2" : "=v"(r) : "v"(lo), "v"(hi)); return r; }
typedef float f32x2 __attribute__((ext_vector_type(2)));

struct EpiF32 {
    static constexpr bool PERM = false, AFTER_DRAIN = false;
    float* C; int ldc; const float* bias;
    __device__ __forceinline__ void operator()(const f32x4 (&acc)[2][2][4][2], const Unit& u, int wr, int wc, int fr, int fq) const {
        const int row0 = u.pm * BM + wr * 64 + fr, col0 = u.pn * BM + wc * 32 + 4 * fq;
        f32x4 bv[2][2];
#pragma unroll
        for (int bj = 0; bj < 2; ++bj)
#pragma unroll
            for (int n = 0; n < 2; ++n) bv[bj][n] = bias ? *(const f32x4*)(bias + col0 + bj * HALF + n * 16) : (f32x4){0.f, 0.f, 0.f, 0.f};
#pragma unroll
        for (int ai = 0; ai < 2; ++ai)
#pragma unroll
            for (int m = 0; m < 4; ++m) { float* rowp = C + (size_t)(row0 + ai * HALF + m * 16) * ldc + col0;
#pragma unroll
                for (int bj = 0; bj < 2; ++bj)
#pragma unroll
                    for (int n = 0; n < 2; ++n) *(f32x4*)(rowp + bj * HALF + n * 16) = acc[ai][bj][m][n] + bv[bj][n]; }
    }
};
template <int ACT  > struct EpiBf16 {
    static constexpr bool PERM = true, AFTER_DRAIN = false;
    bf16_t* O; int ldc; const float* bias; int split_cols; size_t split_stride;
    __device__ __forceinline__ void operator()(const f32x4 (&acc)[2][2][4][2], const Unit& u, int wr, int wc, int fr, int fq) const {
        const int row0 = u.pm * BM + wr * 64 + fr; int colt = u.pn * BM; bf16_t* base = O;
        if (split_cols) { const int t = colt / split_cols; base += (size_t)t * split_stride; colt -= t * split_cols; }
        const int col0 = colt + wc * 32 + 8 * fq, bcol0 = u.pn * BM + wc * 32 + 8 * fq;
        f32x4 bv[2][2];
#pragma unroll
        for (int bj = 0; bj < 2; ++bj)
#pragma unroll
            for (int n = 0; n < 2; ++n) bv[bj][n] = bias ? *(const f32x4*)(bias + bcol0 + bj * HALF + 4 * n) : (f32x4){0.f, 0.f, 0.f, 0.f};
#pragma unroll
        for (int ai = 0; ai < 2; ++ai)
#pragma unroll
            for (int m = 0; m < 4; ++m) { bf16_t* rowp = base + (size_t)(row0 + ai * HALF + m * 16) * ldc + col0;
#pragma unroll
                for (int bj = 0; bj < 2; ++bj) { f32x4 v0 = acc[ai][bj][m][0] + bv[bj][0], v1 = acc[ai][bj][m][1] + bv[bj][1];
                    u32x4 w; w.x = cvt_pk_bf16(v0[0], v0[1]); w.y = cvt_pk_bf16(v0[2], v0[3]); w.z = cvt_pk_bf16(v1[0], v1[1]); w.w = cvt_pk_bf16(v1[2], v1[3]);
                    *(u32x4*)(rowp + bj * HALF) = w; } }
    }
};

template <class Epi, class Sched, bool STAMP = false>
__device__ __forceinline__ void gemm_phase(PG8_LAS unsigned char* lds, const Gemm g, const Sched& S, const Epi& E, unsigned long long* stamps) {
    const int tid = opaque_tid(), wid = __builtin_amdgcn_readfirstlane(tid >> 6), lane = tid & 63, wr = wid >> 2, wc = wid & 3, fr = lane & 15, fq = lane >> 4;
    const int K = g.K, nt = K / BK;
    int ts_lo = 0, ts_hi = 0, nts = 0; const unsigned long long rt_entry = STAMP ? (unsigned long long)wall_clock64() : 0ull;
#define PG8_STAMP() do { if (STAMP && wid == 0 && nts < 64) { const unsigned long long _c = (unsigned long long)clock64(); \
        ts_lo = (lane == nts) ? (int)(unsigned)_c : ts_lo; ts_hi = (lane == nts) ? (int)(unsigned)(_c >> 32) : ts_hi; ++nts; } } while (0)
    PG8_STAMP();
    unsigned voffA[2], voffB[2];
#pragma unroll
    for (int i = 0; i < 2; ++i) { int R, C; stage_rc(tid * 16 + i * 8192, R, C); const int Rb = Epi::PERM ? ((R & ~31) + perm32(R & 31)) : R;
        voffA[i] = (unsigned)(R * K + C) * 2u; voffB[i] = (unsigned)(Rb * K + C) * 2u; }
    const size_t kstep = (size_t)(BK * 2);
    const size_t hstep = (size_t)HALF * K * 2;
    const size_t tstep = 2 * hstep;
    const unsigned ldsw = (unsigned)wid * 1024u;
    const int aoff = lds_byte(wr * 64 + fr, fq * 8), boff = lds_byte(wc * 32 + fr, fq * 8);
#define PG8_SA(b, h) (((b) * 2 + (h)) * HTB)
#define PG8_SB(b, h) ((4 + (b) * 2 + (h)) * HTB)
#define PG8_STAGE(bufoff, gbase, voff) do { _Pragma("unroll") for (int _i = 0; _i < 2; ++_i) \
        __builtin_amdgcn_global_load_lds((const unsigned*)((const char*)(gbase) + (voff)[_i]), (PG8_LAS unsigned*)(lds + (bufoff) + ldsw + _i * 8192), 16, 0, 0); } while (0)
#define PG8_LDA(dst, b, h) do { _Pragma("unroll") for (int m = 0; m < 4; ++m) _Pragma("unroll") for (int k = 0; k < 2; ++k) dst[m][k] = *(const PG8_LAS bf16x8*)(lds + PG8_SA(b, h) + aoff + m * 2048 + k * 1024); } while (0)
#define PG8_LDB(dst, b, h) do { _Pragma("unroll") for (int n = 0; n < 2; ++n) _Pragma("unroll") for (int k = 0; k < 2; ++k) dst[n][k] = *(const PG8_LAS bf16x8*)(lds + PG8_SB(b, h) + boff + n * 2048 + k * 1024); } while (0)
#define PG8_MMA(ai, bj, At, Bt) do { __builtin_amdgcn_s_setprio(1); _Pragma("unroll") for (int m = 0; m < 4; ++m) _Pragma("unroll") for (int n = 0; n < 2; ++n) _Pragma("unroll") for (int k = 0; k < 2; ++k) \
        acc[ai][bj][m][n] = __builtin_amdgcn_mfma_f32_16x16x32_bf16(Bt[n][k], At[m][k], acc[ai][bj][m][n], 0, 0, 0); __builtin_amdgcn_s_setprio(0); } while (0)
#define PG8_WAIT_V(n) asm volatile("s_waitcnt vmcnt(" #n ")" ::: "memory")
#define PG8_WAIT_L(n) asm volatile("s_waitcnt lgkmcnt(" #n ")" ::: "memory")
#define PG8_BAR __builtin_amdgcn_s_barrier()
#define PG8_SCHED __builtin_amdgcn_sched_barrier(0)
    Unit cur, nxt; int ui = 0;
    if (!S.next(0, cur)) return;
    f32x4 acc[2][2][4][2];
#pragma unroll
    for (int a = 0; a < 2; ++a)
#pragma unroll
        for (int b = 0; b < 2; ++b)
#pragma unroll
            for (int m = 0; m < 4; ++m)
#pragma unroll
                for (int n = 0; n < 2; ++n) acc[a][b][m][n] = (f32x4){0.f, 0.f, 0.f, 0.f};
    bf16x8 At[4][2], B0[2][2], B1[2][2];
    const char* cA = (const char*)g.A + (size_t)cur.pm * tstep; const char* cB = (const char*)g.Bt + (size_t)cur.pn * tstep;
    S.a_ready(cur);
    PG8_STAGE(PG8_SB(0, 0), cB, voffB); PG8_STAGE(PG8_SA(0, 0), cA, voffA); PG8_STAGE(PG8_SB(0, 1), cB + hstep, voffB); PG8_STAGE(PG8_SA(0, 1), cA + hstep, voffA);
    if (wr == 1) PG8_BAR;
    PG8_WAIT_V(4); PG8_BAR;
    PG8_STAGE(PG8_SB(1, 0), cB + kstep, voffB); PG8_STAGE(PG8_SA(1, 0), cA + kstep, voffA); PG8_STAGE(PG8_SB(1, 1), cB + hstep + kstep, voffB);
    PG8_WAIT_V(6); PG8_BAR;
    PG8_STAMP();
    for (;;) {
        const bool has_next = S.next(ui + 1, nxt);
        const char* nA = has_next ? (const char*)g.A + (size_t)nxt.pm * tstep : cA; const char* nB = has_next ? (const char*)g.Bt + (size_t)nxt.pn * tstep : cB;
        for (int t = 0; t < nt; t += 2) {
            const bool last = (t == nt - 2);
            const char* a1 = cA + (size_t)(t + 1) * kstep;
            const char* a2 = last ? nA : cA + (size_t)(t + 2) * kstep; const char* b2 = last ? nB : cB + (size_t)(t + 2) * kstep;
            const char* a3 = a2 + kstep; const char* b3 = b2 + kstep;
            if (last && has_next) S.a_ready(nxt);
            PG8_LDB(B0, 0, 0); PG8_SCHED; PG8_LDA(At, 0, 0); PG8_STAGE(PG8_SA(1, 1), a1 + hstep, voffA);
            PG8_WAIT_L(8); PG8_BAR; PG8_WAIT_L(0); PG8_MMA(0, 0, At, B0); PG8_BAR; PG8_SCHED;
            PG8_LDB(B1, 0, 1); PG8_STAGE(PG8_SB(0, 0), b2, voffB);
            PG8_BAR; PG8_WAIT_L(0); PG8_MMA(0, 1, At, B1); PG8_BAR;
            PG8_LDA(At, 0, 1); PG8_STAGE(PG8_SA(0, 0), a2, voffA);
            PG8_BAR; PG8_WAIT_L(0); PG8_MMA(1, 0, At, B0); PG8_BAR; PG8_SCHED;
            PG8_STAGE(PG8_SB(0, 1), b2 + hstep, voffB);
            PG8_WAIT_V(6); PG8_BAR; PG8_MMA(1, 1, At, B1); PG8_BAR;
            PG8_LDB(B0, 1, 0); PG8_SCHED; PG8_LDA(At, 1, 0); PG8_STAGE(PG8_SA(0, 1), a2 + hstep, voffA);
            PG8_WAIT_L(8); PG8_BAR; PG8_WAIT_L(0); PG8_MMA(0, 0, At, B0); PG8_BAR; PG8_SCHED;
            PG8_LDB(B1, 1, 1); PG8_STAGE(PG8_SB(1, 0), b3, voffB);
            PG8_BAR; PG8_WAIT_L(0); PG8_MMA(0, 1, At, B1); PG8_BAR;
            PG8_LDA(At, 1, 1); PG8_STAGE(PG8_SA(1, 0), a3, voffA);
            PG8_BAR; PG8_WAIT_L(0); PG8_MMA(1, 0, At, B0); PG8_BAR; PG8_SCHED;
            PG8_STAGE(PG8_SB(1, 1), b3 + hstep, voffB);
            PG8_WAIT_V(6); PG8_BAR; PG8_MMA(1, 1, At, B1); PG8_BAR;
        }
        PG8_STAMP();
        if constexpr (!Epi::AFTER_DRAIN) { E(acc, cur, wr, wc, fr, fq); S.done(cur); }
        PG8_STAMP();
        if (!has_next) break;
#pragma unroll
        for (int a = 0; a < 2; ++a)
#pragma unroll
            for (int b = 0; b < 2; ++b)
#pragma unroll
                for (int m = 0; m < 4; ++m)
#pragma unroll
                    for (int n = 0; n < 2; ++n) acc[a][b][m][n] = (f32x4){0.f, 0.f, 0.f, 0.f};
        cur = nxt; cA = nA; cB = nB; ++ui;
    }
    PG8_WAIT_V(0);
    if (wr == 0) PG8_BAR;
    PG8_BAR;
    if constexpr (Epi::AFTER_DRAIN) { E.fused(acc, cur, wr, wc, fr, fq, lds, wid, lane); S.done(cur); }
    PG8_STAMP();
    if (STAMP && wid == 0) { stamps[lane] = lane < nts ? (((unsigned long long)(unsigned)ts_hi << 32) | (unsigned)ts_lo) : 0ull;
        if (lane == 62) stamps[62] = rt_entry; if (lane == 63) stamps[63] = (unsigned long long)wall_clock64(); }
#undef PG8_STAMP
#undef PG8_SA
#undef PG8_SB
#undef PG8_STAGE
#undef PG8_LDA
#undef PG8_LDB
#undef PG8_MMA
#undef PG8_WAIT_V
#undef PG8_WAIT_L
#undef PG8_BAR
#undef PG8_SCHED
}
}
namespace mk {
using pg8::bf16_t; using pg8::bf16x8; using pg8::f32x4; using pg8::u32x4; using pg8::cvt_pk_bf16;
typedef float f32x16 __attribute__((ext_vector_type(16)));
typedef short s16x4 __attribute__((ext_vector_type(4)));
typedef unsigned u32x2 __attribute__((ext_vector_type(2)));
constexpr int T = 17408, TP = 16384, TS = 1024, NPOS = 2056;
constexpr long O_Y_P = 0, O_Y_S = 16777216, O_KV_P = 17825792, O_KR_P = 22020096, O_SSM_P = 22544384, O_CONV_P = 23068672,
               O_KV_S = 23093248, O_KR_S = 23355392, O_SSM_S = 23388160, O_CONV_S = 31776768, O_TOTAL = 32169984;
constexpr int LDS_BYTES = 147456;
constexpr int LDS_XB = LDS_BYTES - 16;

constexpr size_t al(size_t x) { return (x + 255) & ~(size_t)255; }
constexpr size_t W_CTL = 0;
constexpr size_t W_ROPE = 16384;
constexpr size_t W_BIN = W_ROPE + al((size_t)NPOS * 32 * 4);
constexpr size_t W_BUQP = W_BIN + (size_t)2304 * 1024 * 2;
constexpr size_t W_BQS = W_BUQP + (size_t)768 * 384 * 2;
constexpr size_t W_BKV = W_BQS + (size_t)2304 * 384 * 2;
constexpr size_t W_BOUT = W_BKV + (size_t)1024 * 256 * 2;
constexpr size_t W_BUP = W_BOUT + (size_t)1024 * 1024 * 2;
constexpr size_t W_BDOWN = W_BUP + (size_t)4096 * 1024 * 2;
constexpr size_t W_HN = W_BDOWN + (size_t)1024 * 4096 * 2;
constexpr size_t W_PROJ = W_HN + (size_t)T * 1024 * 2;
constexpr size_t W_QN = W_PROJ + (size_t)T * 2304 * 2;
constexpr size_t W_CB = W_QN + (size_t)T * 384 * 2;
constexpr size_t W_KP = W_CB + (size_t)T * 256 * 2;
constexpr size_t W_VP = W_KP + (size_t)TP * 768 * 2;
constexpr size_t W_QP = W_VP + (size_t)TP * 512 * 2;
constexpr size_t W_QS = W_QP + (size_t)TP * 768 * 2;
constexpr size_t W_KRS = W_QS + (size_t)TS * 2304 * 2;
constexpr size_t W_BC = W_KRS + (size_t)TS * 32 * 2;
constexpr size_t W_CC = W_BC + (size_t)T * 256 * 2;
constexpr size_t W_XSF = W_CC + (size_t)T * 256 * 2;
constexpr size_t W_DTF = W_XSF + (size_t)T * 512 * 4;
constexpr size_t W_CAT = W_DTF + (size_t)T * 8 * 4;
constexpr size_t W_X1 = W_CAT + (size_t)T * 1024 * 2;
constexpr size_t W_X1B = W_X1 + (size_t)T * 1024 * 4;
constexpr size_t W_SSQ1 = W_X1B + (size_t)T * 1024 * 2;
constexpr size_t W_SSQ2 = W_SSQ1 + (size_t)T * 16 * 4;
constexpr size_t W_U = W_SSQ2 + (size_t)T * 16 * 4;
constexpr size_t W_X2 = W_U + (size_t)T * 4096 * 2;
constexpr size_t W_STATES = W_X2 + (size_t)T * 1024 * 4;
constexpr size_t W_CHDEC = W_STATES + (size_t)512 * 8192 * 4;
constexpr size_t W_PML = W_CHDEC + 4096;
constexpr size_t W_PO = W_PML + (size_t)128 * 2 * 64 * 2 * 4;
constexpr size_t W_END = W_PO + (size_t)128 * 2 * 64 * 256 * 4;

struct P {
    const float *x_p, *x_s, *ckv, *ckr, *st_ssm, *st_conv; const int* pt;
    const float *norm_attn, *w_in, *q_norm, *kv_norm, *w_uq, *w_uk, *w_uv, *conv_w, *conv_b, *dt_bias, *a_log, *d_skip, *ssm_norm, *w_out, *norm_mlp, *w_up, *w_down, *norm_final;
    float* out; unsigned char* ws; int ph_lo, ph_hi;
};

__device__ __forceinline__ float bf2f(unsigned short b) { return __uint_as_float(((unsigned)b) << 16); }
__device__ __forceinline__ float bflo(unsigned w) { return __uint_as_float(w << 16); }
__device__ __forceinline__ float bfhi(unsigned w) { return __uint_as_float(w & 0xffff0000u); }
__device__ __forceinline__ unsigned short f2bf(float f) { return (unsigned short)(cvt_pk_bf16(f, 0.f) & 0xffffu); }
__device__ __forceinline__ float wave_sum(float v) {
#pragma unroll
    for (int o = 32; o; o >>= 1) v += __shfl_xor(v, o);
    return v; }
__device__ __forceinline__ float silu(float v) { return v / (1.f + __expf(-v)); }

__device__ __forceinline__ int inproj_colmap(int n) {
    if (n < 256) return 384 + n; if (n < 640) return n - 256; if (n < 672) return n; if (n < 680) return n + 1536; if (n < 768) return -1; return n - 96; }
template <int MODE> __device__ __forceinline__ void tconv(bf16_t* dst, const float* src, int ld, int K, int n0, int k0, const float* ks, float* tile) {
    const int tid = threadIdx.x;
#pragma unroll
    for (int i = 0; i < 4; ++i) { const int e = tid + i * 512, kk = e >> 4, n4 = (e & 15) * 4, n = n0 + n4, c = MODE ? inproj_colmap(n) : n;
        float4 v = make_float4(0.f, 0.f, 0.f, 0.f);
        if (c >= 0) v = *(const float4*)(src + (size_t)(k0 + kk) * ld + c);
        if (ks) { const float s = ks[k0 + kk]; v.x *= s; v.y *= s; v.z *= s; v.w *= s; }
        *(float4*)(tile + kk * 68 + n4) = v; }
    __syncthreads();
#pragma unroll
    for (int i = 0; i < 2; ++i) { const int e = tid + i * 512, nn = e >> 4, kc = (e & 15) * 8; float f[8];
#pragma unroll
        for (int j = 0; j < 8; ++j) f[j] = tile[(kc + j) * 68 + nn];
        u32x4 w; w.x = cvt_pk_bf16(f[0], f[1]); w.y = cvt_pk_bf16(f[2], f[3]); w.z = cvt_pk_bf16(f[4], f[5]); w.w = cvt_pk_bf16(f[6], f[7]);
        *(u32x4*)(dst + (size_t)(n0 + nn) * K + k0 + kc) = w; }
    __syncthreads();
}
__device__ void phase_prep(const P& p, unsigned char* lds) {
    const int tid = pg8::opaque_tid(), lane = tid & 63, wid = tid >> 6, G = gridDim.x;
    unsigned char* ws = p.ws;
    { bf16_t* hn = (bf16_t*)(ws + W_HN);
      for (int t = blockIdx.x * 8 + wid; t < T; t += G * 8) {
        const float* xr = t < TP ? p.x_p + (size_t)t * 1024 : p.x_s + (size_t)(t - TP) * 1024;
        float4 v[4]; float ss = 0.f;
#pragma unroll
        for (int i = 0; i < 4; ++i) { v[i] = *(const float4*)(xr + i * 256 + lane * 4); ss += v[i].x * v[i].x + v[i].y * v[i].y + v[i].z * v[i].z + v[i].w * v[i].w; }
        ss = wave_sum(ss); const float rs = rsqrtf(ss * (1.f / 1024.f) + 1e-6f);
#pragma unroll
        for (int i = 0; i < 4; ++i) { const float4 g = *(const float4*)(p.norm_attn + i * 256 + lane * 4);
            u32x2 w; w.x = cvt_pk_bf16(v[i].x * rs * g.x, v[i].y * rs * g.y); w.y = cvt_pk_bf16(v[i].z * rs * g.z, v[i].w * rs * g.w);
            *(u32x2*)(hn + (size_t)t * 1024 + i * 256 + lane * 4) = w; } } }
    float* tile = (float*)lds;
    for (int j = blockIdx.x; j < 1492; j += G) {
        if (j < 288) { const int kt = j & 7, nt = j >> 3; tconv<1>((bf16_t*)(ws + W_BIN), p.w_in, 2216, 1024, nt * 64, kt * 128, nullptr, tile); }
        else if (j < 324) { const int q = j - 288, kt = q % 3, nt = q / 3; tconv<0>((bf16_t*)(ws + W_BUQP), p.w_uq, 768, 384, nt * 64, kt * 128, nullptr, tile); }
        else if (j < 340) { const int q = j - 324, kt = q & 1, h = q >> 1; tconv<0>((bf16_t*)(ws + W_BKV) + (size_t)(512 + h * 64) * 256, p.w_uv + (size_t)h * 16384, 64, 256, 0, kt * 128, nullptr, tile); }
        else if (j < 468) { const int q = j - 340, kt = q & 7, nt = q >> 3; tconv<0>((bf16_t*)(ws + W_BOUT), p.w_out, 1024, 1024, nt * 64, kt * 128, nullptr, tile); }
        else if (j < 980) { const int q = j - 468, kt = q & 7, nt = q >> 3; tconv<0>((bf16_t*)(ws + W_BUP), p.w_up, 4096, 1024, nt * 64, kt * 128, p.norm_mlp, tile); }
        else { const int q = j - 980, kt = q & 31, nt = q >> 5; tconv<0>((bf16_t*)(ws + W_BDOWN), p.w_down, 1024, 4096, nt * 64, kt * 128, nullptr, tile); }
    }
    const long gtid = (long)blockIdx.x * 512 + tid, gstride = (long)G * 512;
    { bf16_t* d = (bf16_t*)(ws + W_BKV); for (long i = gtid; i < 131072 / 2; i += gstride) { const float2 v = *(const float2*)(p.w_uk + 2 * i); *(unsigned*)(d + 2 * i) = cvt_pk_bf16(v.x, v.y); } }
    { bf16_t* d = (bf16_t*)(ws + W_BQS);
      for (long i = gtid; i < 2304L * 384; i += gstride) { const int k = (int)(i % 384), n = (int)(i / 384), h = n / 288, c = n % 288; float v;
        if (c >= 256) v = p.w_uq[(size_t)k * 768 + h * 96 + 64 + (c - 256)];
        else { v = 0.f; const float* a = p.w_uq + (size_t)k * 768 + h * 96; const float* bq = p.w_uk + (size_t)h * 16384 + c;
#pragma unroll 8
            for (int dd = 0; dd < 64; ++dd) v += a[dd] * bq[dd * 256]; }
        d[i] = f2bf(v); } }
    { float* rt = (float*)(ws + W_ROPE);
      for (long i = gtid; i < (long)NPOS * 16; i += gstride) { const int pi = (int)(i >> 4), fi = (int)(i & 15), pos = pi < 2048 ? pi : 8192 + (pi - 2048);
        const double inv = exp2(-(double)(2 * fi) / 32.0 * 13.287712379549449); double sd, cd; sincos((double)pos * inv, &sd, &cd);
        rt[pi * 32 + fi] = (float)cd; rt[pi * 32 + 16 + fi] = (float)sd; } }
}

__device__ void phase_thin(const P& p) {
    const int tid = pg8::opaque_tid(), lane = tid & 63, wid = tid >> 6, G = gridDim.x;
    unsigned char* ws = p.ws;
    const bf16_t* projp = (const bf16_t*)(ws + W_PROJ); const float* rope = (const float*)(ws + W_ROPE);
    bf16_t* cb = (bf16_t*)(ws + W_CB); bf16_t* qn = (bf16_t*)(ws + W_QN); bf16_t* Kp = (bf16_t*)(ws + W_KP); bf16_t* krs = (bf16_t*)(ws + W_KRS);
    bf16_t* Bc = (bf16_t*)(ws + W_BC); bf16_t* Cc = (bf16_t*)(ws + W_CC); float* xsf = (float*)(ws + W_XSF); float* dtf = (float*)(ws + W_DTF);
    float cw[4][16], cbias[16];
#pragma unroll
    for (int k = 0; k < 4; ++k)
#pragma unroll
        for (int j = 0; j < 4; ++j) { const float4 v = *(const float4*)(p.conv_w + k * 1024 + 16 * lane + 4 * j); cw[k][4 * j] = v.x; cw[k][4 * j + 1] = v.y; cw[k][4 * j + 2] = v.z; cw[k][4 * j + 3] = v.w; }
#pragma unroll
    for (int j = 0; j < 4; ++j) { const float4 v = *(const float4*)(p.conv_b + 16 * lane + 4 * j); cbias[4 * j] = v.x; cbias[4 * j + 1] = v.y; cbias[4 * j + 2] = v.z; cbias[4 * j + 3] = v.w; }
    const float4 kvn = *(const float4*)(p.kv_norm + 4 * lane);
    float qg[6];
#pragma unroll
    for (int j = 0; j < 6; ++j) qg[j] = p.q_norm[6 * lane + j];
    for (int t = blockIdx.x * 8 + wid; t < T; t += G * 8) {
        const bool pr = t < TP; const int l = pr ? (t & 2047) : ((t - TP) & 7), b = pr ? (t >> 11) : ((t - TP) >> 3), L = pr ? 2048 : 8;
        const bf16_t* row = projp + (size_t)t * 2304;
        { const u32x2 raw = *(const u32x2*)(row + 4 * lane); const float v0 = bflo(raw.x), v1 = bfhi(raw.x), v2 = bflo(raw.y), v3 = bfhi(raw.y);
          const float ss = wave_sum(v0 * v0 + v1 * v1 + v2 * v2 + v3 * v3), rs = rsqrtf(ss * (1.f / 256.f) + 1e-6f);
          const float o0 = v0 * rs * kvn.x, o1 = v1 * rs * kvn.y, o2 = v2 * rs * kvn.z, o3 = v3 * rs * kvn.w;
          float* od = pr ? p.out + O_KV_P + (size_t)t * 256 : p.out + O_KV_S + (size_t)(t - TP) * 256;
          *(float4*)(od + 4 * lane) = make_float4(o0, o1, o2, o3);
          u32x2 w; w.x = cvt_pk_bf16(o0, o1); w.y = cvt_pk_bf16(o2, o3); *(u32x2*)(cb + (size_t)t * 256 + 4 * lane) = w; }
        { const unsigned* qr = (const unsigned*)(row + 256 + 6 * lane); const unsigned r0 = qr[0], r1 = qr[1], r2 = qr[2];
          float q[6] = {bflo(r0), bfhi(r0), bflo(r1), bfhi(r1), bflo(r2), bfhi(r2)};
          float ss = 0.f;
#pragma unroll
          for (int j = 0; j < 6; ++j) ss += q[j] * q[j];
          ss = wave_sum(ss); const float rs = rsqrtf(ss * (1.f / 384.f) + 1e-6f);
          unsigned* qo = (unsigned*)(qn + (size_t)t * 384 + 6 * lane);
          qo[0] = cvt_pk_bf16(q[0] * rs * qg[0], q[1] * rs * qg[1]); qo[1] = cvt_pk_bf16(q[2] * rs * qg[2], q[3] * rs * qg[3]); qo[2] = cvt_pk_bf16(q[4] * rs * qg[4], q[5] * rs * qg[5]); }
        { const int i = lane & 15, pidx = pr ? l : 2048 + l; const float x1 = bf2f(row[640 + i]), x2 = bf2f(row[656 + i]);
          const float c = rope[pidx * 32 + i], s = rope[pidx * 32 + 16 + i];
          const float val = (lane & 16) ? (x2 * c + x1 * s) : (x1 * c - x2 * s); const int e = lane & 31;
          if (lane < 32) { float* od = pr ? p.out + O_KR_P + (size_t)t * 32 : p.out + O_KR_S + (size_t)(t - TP) * 32; od[e] = val; }
          const unsigned short vb = f2bf(val);
          if (pr) {
#pragma unroll
              for (int j = 0; j < 4; ++j) Kp[(size_t)t * 768 + ((lane >> 5) * 4 + j) * 96 + 64 + e] = vb; }
          else if (lane < 32) krs[(size_t)(t - TP) * 32 + e] = vb; }
        if (lane < 8) { const float v = bf2f(row[672 + lane]) + p.dt_bias[lane]; dtf[(size_t)t * 8 + lane] = v > 20.f ? v : log1pf(expf(v)); }
        { float acc[16], xc[16];
#pragma unroll
          for (int j = 0; j < 16; ++j) { acc[j] = cbias[j]; xc[j] = 0.f; }
#pragma unroll
          for (int k = 0; k < 4; ++k) { const int lk = l + k - 3; float xv[16];
            if (lk >= 0) { const u32x4* src = (const u32x4*)(projp + (size_t)(t + k - 3) * 2304 + 1280 + 16 * lane); const u32x4 a = src[0], c2 = src[1];
                xv[0] = bflo(a.x); xv[1] = bfhi(a.x); xv[2] = bflo(a.y); xv[3] = bfhi(a.y); xv[4] = bflo(a.z); xv[5] = bfhi(a.z); xv[6] = bflo(a.w); xv[7] = bfhi(a.w);
                xv[8] = bflo(c2.x); xv[9] = bfhi(c2.x); xv[10] = bflo(c2.y); xv[11] = bfhi(c2.y); xv[12] = bflo(c2.z); xv[13] = bfhi(c2.z); xv[14] = bflo(c2.w); xv[15] = bfhi(c2.w); }
            else if (!pr) { const float* src = p.st_conv + ((size_t)b * 3 + (l + k)) * 1024 + 16 * lane;
#pragma unroll
                for (int j = 0; j < 4; ++j) { const float4 v = *(const float4*)(src + 4 * j); xv[4 * j] = v.x; xv[4 * j + 1] = v.y; xv[4 * j + 2] = v.z; xv[4 * j + 3] = v.w; } }
            else {
#pragma unroll
                for (int j = 0; j < 16; ++j) xv[j] = 0.f; }
#pragma unroll
            for (int j = 0; j < 16; ++j) { acc[j] += xv[j] * cw[k][j]; if (k == 3) xc[j] = xv[j]; } }
#pragma unroll
          for (int j = 0; j < 16; ++j) acc[j] = silu(acc[j]);
          if (lane < 32) { float* d = xsf + (size_t)t * 512 + 16 * lane;
#pragma unroll
              for (int j = 0; j < 4; ++j) *(float4*)(d + 4 * j) = make_float4(acc[4 * j], acc[4 * j + 1], acc[4 * j + 2], acc[4 * j + 3]); }
          else { bf16_t* d = (lane < 48 ? Bc + (size_t)t * 256 + 16 * (lane - 32) : Cc + (size_t)t * 256 + 16 * (lane - 48));
              u32x4 w0, w1; w0.x = cvt_pk_bf16(acc[0], acc[1]); w0.y = cvt_pk_bf16(acc[2], acc[3]); w0.z = cvt_pk_bf16(acc[4], acc[5]); w0.w = cvt_pk_bf16(acc[6], acc[7]);
              w1.x = cvt_pk_bf16(acc[8], acc[9]); w1.y = cvt_pk_bf16(acc[10], acc[11]); w1.z = cvt_pk_bf16(acc[12], acc[13]); w1.w = cvt_pk_bf16(acc[14], acc[15]);
              *(u32x4*)d = w0; *(u32x4*)(d + 8) = w1; }
          if (l >= L - 3) { float* d = (pr ? p.out + O_CONV_P : p.out + O_CONV_S) + ((size_t)b * 3 + (l - (L - 3))) * 1024 + 16 * lane;
#pragma unroll
              for (int j = 0; j < 4; ++j) *(float4*)(d + 4 * j) = make_float4(xc[4 * j], xc[4 * j + 1], xc[4 * j + 2], xc[4 * j + 3]); } }
    }
}
struct EpiKV {
    static constexpr bool PERM = true, AFTER_DRAIN = false;
    bf16_t* Kp; bf16_t* Vp;
    __device__ __forceinline__ void operator()(const f32x4 (&acc)[2][2][4][2], const pg8::Unit& u, int wr, int wc, int fr, int fq) const {
        const int row0 = u.pm * 256 + wr * 64 + fr, col = u.pn * 256 + wc * 32 + 8 * fq; const bool km = u.pn < 2;
        bf16_t* base = km ? Kp + (size_t)row0 * 768 + (col >> 6) * 96 + (col & 63) : Vp + (size_t)row0 * 512 + (col - 512);
        const int pitch = km ? 768 : 512, bjo = km ? 192 : 128;
#pragma unroll
        for (int ai = 0; ai < 2; ++ai)
#pragma unroll
            for (int m = 0; m < 4; ++m) { bf16_t* rp = base + (size_t)(ai * 128 + m * 16) * pitch;
#pragma unroll
                for (int bj = 0; bj < 2; ++bj) { const f32x4 v0 = acc[ai][bj][m][0], v1 = acc[ai][bj][m][1];
                    u32x4 w; w.x = cvt_pk_bf16(v0[0], v0[1]); w.y = cvt_pk_bf16(v0[2], v0[3]); w.z = cvt_pk_bf16(v1[0], v1[1]); w.w = cvt_pk_bf16(v1[2], v1[3]);
                    *(u32x4*)(rp + bj * bjo) = w; }
                asm volatile("" ::: "memory"); }
    }
};
template <int HD, int ROPE_OFF, int POS_MODE> struct EpiQ {
    static constexpr bool PERM = false, AFTER_DRAIN = false;
    bf16_t* O; int ldc; const float* rope; float scale;
    __device__ __forceinline__ void operator()(const f32x4 (&acc)[2][2][4][2], const pg8::Unit& u, int wr, int wc, int fr, int fq) const {
        const int row0 = u.pm * 256 + wr * 64 + fr;
#pragma unroll
        for (int bj = 0; bj < 2; ++bj) { const int g32 = u.pn * 256 + bj * 128 + wc * 32; const bool rg = ((g32 % HD) == ROPE_OFF);
#pragma unroll
            for (int ai = 0; ai < 2; ++ai)
#pragma unroll
                for (int m = 0; m < 4; ++m) { const int row = row0 + ai * 128 + m * 16; const int pidx = POS_MODE ? 2048 + (row & 7) : (row & 2047);
                    f32x4 v0 = acc[ai][bj][m][0], v1 = acc[ai][bj][m][1];
                    if (rg) { const f32x4 c = *(const f32x4*)(rope + pidx * 32 + 4 * fq), s = *(const f32x4*)(rope + pidx * 32 + 16 + 4 * fq);
                        const f32x4 r1 = v0 * c - v1 * s, r2 = v1 * c + v0 * s; v0 = r1; v1 = r2; }
                    v0 *= scale; v1 *= scale;
                    bf16_t* dst = O + (size_t)row * ldc + g32 + 4 * fq;
                    u32x2 w0, w1; w0.x = cvt_pk_bf16(v0[0], v0[1]); w0.y = cvt_pk_bf16(v0[2], v0[3]); w1.x = cvt_pk_bf16(v1[0], v1[1]); w1.y = cvt_pk_bf16(v1[2], v1[3]);
                    *(u32x2*)dst = w0; *(u32x2*)(dst + 16) = w1; asm volatile("" ::: "memory"); } }
    }
};

#define MFMA32(a, b, c) __builtin_amdgcn_mfma_f32_32x32x16_bf16((a), (b), (c), 0, 0, 0)
typedef short v4i16_t __attribute__((ext_vector_type(4)));
__device__ __forceinline__ s16x4 tr_read(LAS const unsigned char* p) { return __builtin_bit_cast(s16x4, __builtin_amdgcn_ds_read_tr16_b64_v4i16((LAS v4i16_t*)p)); }
__device__ __forceinline__ bf16x8 lds128(LAS const unsigned char* p) { return *(LAS const bf16x8*)p; }
__device__ __forceinline__ int crow(int r, int hi) { return (r & 3) + 8 * (r >> 2) + 4 * hi; }
__device__ __forceinline__ bf16x8 pack8(const f32x16& x, int s) {
    u32x4 w; w.x = cvt_pk_bf16(x[8 * s], x[8 * s + 1]); w.y = cvt_pk_bf16(x[8 * s + 2], x[8 * s + 3]); w.z = cvt_pk_bf16(x[8 * s + 4], x[8 * s + 5]); w.w = cvt_pk_bf16(x[8 * s + 6], x[8 * s + 7]);
    return __builtin_bit_cast(bf16x8, w); }
__device__ __forceinline__ void glds16(const void* g, LAS unsigned char* l) { __builtin_amdgcn_global_load_lds((const unsigned*)g, (LAS unsigned*)l, 16, 0, 0); }
__device__ __forceinline__ float max16(const f32x16& a) { float m = fmaxf(a[0], a[1]);
#pragma unroll
    for (int r = 2; r < 16; ++r) m = fmaxf(m, a[r]);
    return m; }

constexpr int PA_K = 0, PA_V = 24576, PA_KB = 12288, PA_VB = 8192;
__device__ __forceinline__ void attn_prompt_unit(const bf16_t* Qp, const bf16_t* Kp, const bf16_t* Vp, bf16_t* cat, int b, int h, int qb, LAS unsigned char* lds) {
    const int tid = pg8::opaque_tid(), lane = tid & 63, r32 = lane & 31, hi = lane >> 5; const int wid = __builtin_amdgcn_readfirstlane(tid >> 6);
    const size_t rowbase = (size_t)b * 2048; const int q0 = qb * 256, NT = 4 * qb + 4;
    const int qrow = q0 + wid * 32 + r32, qmin = q0 + wid * 32, qmax = qmin + 31;
    bf16x8 qf[6];
    { const bf16_t* Qw = Qp + (rowbase + qrow) * 768 + h * 96;
#pragma unroll
      for (int d0 = 0; d0 < 6; ++d0) qf[d0] = *(const bf16x8*)(Qw + d0 * 16 + hi * 8); }
    const bf16_t* ksrc = Kp + (rowbase + lane) * 768 + h * 96;
    const bf16_t* vsrc = Vp + (rowbase + 16 * (wid & 3) + (lane >> 2)) * 512 + h * 64 + (wid >> 2) * 32 + (lane & 3) * 8;
#define PA_ISSUE(t, buf) do { const bf16_t* kt_ = ksrc + (size_t)(t) * 64 * 768; \
        glds16(kt_ + wid * 8, lds + PA_K + (buf) * PA_KB + wid * 1024); \
        if (wid < 4) glds16(kt_ + (8 + wid) * 8, lds + PA_K + (buf) * PA_KB + (8 + wid) * 1024); \
        glds16(vsrc + (size_t)(t) * 64 * 512, lds + PA_V + (buf) * PA_VB + wid * 1024); } while (0)
    f32x16 o0, o1;
#pragma unroll
    for (int r = 0; r < 16; ++r) { o0[r] = 0.f; o1[r] = 0.f; }
    float m_run = -INFINITY, l_run = 0.f;
    const int voff = (4 * hi + ((lane & 15) >> 2)) * 64 + ((lane >> 4) & 1) * 32 + (lane & 3) * 8;
    PA_ISSUE(0, 0);
    asm volatile("s_waitcnt vmcnt(0)" ::: "memory"); __syncthreads();
    for (int t = 0; t < NT; ++t) { const int buf = t & 1, kbase = t * 64;
        if (t + 1 < NT) PA_ISSUE(t + 1, buf ^ 1);
        if (kbase <= qmax) {
            LAS const unsigned char* kb = lds + PA_K + buf * PA_KB + hi * 1024 + r32 * 16;
            f32x16 s0, s1;
#pragma unroll
            for (int r = 0; r < 16; ++r) { s0[r] = 0.f; s1[r] = 0.f; }
#pragma unroll
            for (int d0 = 0; d0 < 6; ++d0) { const bf16x8 k0 = lds128(kb + d0 * 2048), k1 = lds128(kb + d0 * 2048 + 512); s0 = MFMA32(k0, qf[d0], s0); s1 = MFMA32(k1, qf[d0], s1); }
            if (kbase + 63 > qmin) {
#pragma unroll
                for (int r = 0; r < 16; ++r) { const int key = kbase + crow(r, hi); if (key > qrow) s0[r] = -INFINITY; if (key + 32 > qrow) s1[r] = -INFINITY; } }
            float mx = fmaxf(max16(s0), max16(s1)); mx = fmaxf(mx, __shfl_xor(mx, 32));
            const float m_new = fmaxf(m_run, mx), alpha = __builtin_amdgcn_exp2f(m_run - m_new); m_run = m_new;
            float ps = 0.f;
#pragma unroll
            for (int r = 0; r < 16; ++r) { s0[r] = __builtin_amdgcn_exp2f(s0[r] - m_new); s1[r] = __builtin_amdgcn_exp2f(s1[r] - m_new); ps += s0[r] + s1[r]; }
            l_run = l_run * alpha + ps;
#pragma unroll
            for (int r = 0; r < 16; ++r) { o0[r] *= alpha; o1[r] *= alpha; }
            bf16x8 pf[4]; pf[0] = pack8(s0, 0); pf[1] = pack8(s0, 1); pf[2] = pack8(s1, 0); pf[3] = pack8(s1, 1);
            LAS const unsigned char* vb = lds + PA_V + buf * PA_VB + voff;
#pragma unroll
            for (int ks = 0; ks < 4; ++ks) {
                const s16x4 a0 = tr_read(vb + ks * 1024), a1 = tr_read(vb + ks * 1024 + 512), c0 = tr_read(vb + 4096 + ks * 1024), c1 = tr_read(vb + 4096 + ks * 1024 + 512);
                const bf16x8 va = __builtin_shufflevector(a0, a1, 0, 1, 2, 3, 4, 5, 6, 7), vc = __builtin_shufflevector(c0, c1, 0, 1, 2, 3, 4, 5, 6, 7);
                o0 = MFMA32(va, pf[ks], o0); o1 = MFMA32(vc, pf[ks], o1); }
        }
        asm volatile("s_waitcnt vmcnt(0)" ::: "memory"); __syncthreads();
    }
#undef PA_ISSUE
    const float lt = l_run + __shfl_xor(l_run, 32), inv = 1.f / lt;
    bf16_t* orow = cat + (rowbase + qrow) * 1024 + h * 64 + 4 * hi;
#pragma unroll
    for (int g = 0; g < 4; ++g) { u32x2 w0, w1;
        w0.x = cvt_pk_bf16(o0[4 * g] * inv, o0[4 * g + 1] * inv); w0.y = cvt_pk_bf16(o0[4 * g + 2] * inv, o0[4 * g + 3] * inv);
        w1.x = cvt_pk_bf16(o1[4 * g] * inv, o1[4 * g + 1] * inv); w1.y = cvt_pk_bf16(o1[4 * g + 2] * inv, o1[4 * g + 3] * inv);
        *(u32x2*)(orow + 8 * g) = w0; *(u32x2*)(orow + 32 + 8 * g) = w1; }
}
__device__ void phase_attn_prompt(const P& p, LAS unsigned char* lds) {
    const bf16_t* Qp = (const bf16_t*)(p.ws + W_QP); const bf16_t* Kp = (const bf16_t*)(p.ws + W_KP); const bf16_t* Vp = (const bf16_t*)(p.ws + W_VP); bf16_t* cat = (bf16_t*)(p.ws + W_CAT);
    for (int it = blockIdx.x; it < 256; it += gridDim.x) { const int x = it & 7, kk = it >> 3, bh = x + 8 * (kk >> 2), j = kk & 3;
        attn_prompt_unit(Qp, Kp, Vp, cat, bh >> 3, bh & 7, j, lds);
        attn_prompt_unit(Qp, Kp, Vp, cat, bh >> 3, bh & 7, 7 - j, lds); }
}
template <bool WRITE_BF16> struct EpiRes {
    static constexpr bool PERM = false, AFTER_DRAIN = false;
    const float* r0; const float* r1; float* C; bf16_t* Cb; float* ssq;
    __device__ __forceinline__ void operator()(const f32x4 (&acc)[2][2][4][2], const pg8::Unit& u, int wr, int wc, int fr, int fq) const {
        const int row0 = u.pm * 256 + wr * 64 + fr, col0 = u.pn * 256 + wc * 32 + 4 * fq;
#pragma unroll
        for (int ai = 0; ai < 2; ++ai)
#pragma unroll
            for (int m = 0; m < 4; ++m) { const int row = row0 + ai * 128 + m * 16; const float* xr = (row < TP ? r0 + (size_t)row * 1024 : r1 + (size_t)(row - TP) * 1024) + col0;
                float* cp = C + (size_t)row * 1024 + col0; float ss = 0.f;
#pragma unroll
                for (int bj = 0; bj < 2; ++bj)
#pragma unroll
                    for (int n = 0; n < 2; ++n) { const f32x4 v = acc[ai][bj][m][n] + *(const f32x4*)(xr + bj * 128 + n * 16); *(f32x4*)(cp + bj * 128 + n * 16) = v;
                        ss += v[0] * v[0] + v[1] * v[1] + v[2] * v[2] + v[3] * v[3];
                        if (WRITE_BF16) { u32x2 w; w.x = cvt_pk_bf16(v[0], v[1]); w.y = cvt_pk_bf16(v[2], v[3]); *(u32x2*)(Cb + (size_t)row * 1024 + col0 + bj * 128 + n * 16) = w; } }
                ss += __shfl_xor(ss, 16); ss += __shfl_xor(ss, 32);
                if (fq == 0) ssq[(size_t)row * 16 + u.pn * 4 + wc] = ss;
                asm volatile("" ::: "memory"); }
    }
};
struct EpiUp {
    static constexpr bool PERM = true, AFTER_DRAIN = false;
    bf16_t* O; const float* ssq;
    __device__ __forceinline__ void operator()(const f32x4 (&acc)[2][2][4][2], const pg8::Unit& u, int wr, int wc, int fr, int fq) const {
        const int row0 = u.pm * 256 + wr * 64 + fr, col0 = u.pn * 256 + wc * 32 + 8 * fq;
#pragma unroll
        for (int ai = 0; ai < 2; ++ai)
#pragma unroll
            for (int m = 0; m < 4; ++m) { const int row = row0 + ai * 128 + m * 16; const f32x4* sp = (const f32x4*)(ssq + (size_t)row * 16);
                const f32x4 a = sp[0], b = sp[1], c = sp[2], d = sp[3];
                const float tot = (a[0] + a[1] + a[2] + a[3]) + (b[0] + b[1] + b[2] + b[3]) + (c[0] + c[1] + c[2] + c[3]) + (d[0] + d[1] + d[2] + d[3]);
                const float rs = rsqrtf(tot * (1.f / 1024.f) + 1e-6f), rs2 = rs * rs;
                bf16_t* rp = O + (size_t)row * 4096 + col0;
#pragma unroll
                for (int bj = 0; bj < 2; ++bj) { f32x4 v0 = acc[ai][bj][m][0], v1 = acc[ai][bj][m][1];
#pragma unroll
                    for (int j = 0; j < 4; ++j) { const float p0 = fmaxf(v0[j], 0.f), p1 = fmaxf(v1[j], 0.f); v0[j] = p0 * p0 * rs2; v1[j] = p1 * p1 * rs2; }
                    u32x4 w; w.x = cvt_pk_bf16(v0[0], v0[1]); w.y = cvt_pk_bf16(v0[2], v0[3]); w.z = cvt_pk_bf16(v1[0], v1[1]); w.w = cvt_pk_bf16(v1[2], v1[3]);
                    *(u32x4*)(rp + bj * 128) = w; }
                asm volatile("" ::: "memory"); }
    }
};
__device__ void phase_final(const P& p) {
    const int tid = pg8::opaque_tid(), lane = tid & 63, wid = tid >> 6, G = gridDim.x;
    const float* x2 = (const float*)(p.ws + W_X2); const float* ssq = (const float*)(p.ws + W_SSQ2);
    float4 g[4];
#pragma unroll
    for (int i = 0; i < 4; ++i) g[i] = *(const float4*)(p.norm_final + i * 256 + lane * 4);
    for (int t = blockIdx.x * 8 + wid; t < T; t += G * 8) {
        float s = ssq[(size_t)t * 16 + (lane & 15)]; s += __shfl_xor(s, 1); s += __shfl_xor(s, 2); s += __shfl_xor(s, 4); s += __shfl_xor(s, 8);
        const float rs = rsqrtf(s * (1.f / 1024.f) + 1e-6f);
        float* o = t < TP ? p.out + O_Y_P + (size_t)t * 1024 : p.out + O_Y_S + (size_t)(t - TP) * 1024;
#pragma unroll
        for (int i = 0; i < 4; ++i) { const float4 v = *(const float4*)(x2 + (size_t)t * 1024 + i * 256 + lane * 4);
            *(float4*)(o + i * 256 + lane * 4) = make_float4(v.x * rs * g[i].x, v.y * rs * g[i].y, v.z * rs * g[i].z, v.w * rs * g[i].w); } }
}

__device__ void phase_ssd_sample(const P& p, LAS unsigned char* lds) {
    const int tid = pg8::opaque_tid(), row = tid >> 1, nh = tid & 1, hh = row >> 6, pp = row & 63;
    const float* xsf = (const float*)(p.ws + W_XSF); const float* dtf = (const float*)(p.ws + W_DTF); const bf16_t* Bc = (const bf16_t*)(p.ws + W_BC); const bf16_t* Cc = (const bf16_t*)(p.ws + W_CC);
    const bf16_t* projp = (const bf16_t*)(p.ws + W_PROJ); bf16_t* cat = (bf16_t*)(p.ws + W_CAT);
    LAS float* red = (LAS float*)lds;
    for (int it = blockIdx.x; it < 256; it += gridDim.x) { const int b = it >> 1, g = it & 1, h = g * 4 + hh;
        const float A = -__expf(p.a_log[h]), D = p.d_skip[h], gn = p.ssm_norm[h * 64 + pp];
        const size_t sidx = (((size_t)b * 8 + h) * 64 + pp) * 128 + nh * 64;
        float hs[64];
#pragma unroll
        for (int j = 0; j < 16; ++j) { const float4 v = *(const float4*)(p.st_ssm + sidx + 4 * j); hs[4 * j] = v.x; hs[4 * j + 1] = v.y; hs[4 * j + 2] = v.z; hs[4 * j + 3] = v.w; }
        for (int l = 0; l < 8; ++l) { const size_t t = TP + b * 8 + l; const float dtv = dtf[t * 8 + h], da = __expf(dtv * A), xv = xsf[t * 512 + h * 64 + pp], cf = dtv * xv;
            const u32x4* bp = (const u32x4*)(Bc + t * 256 + g * 128 + nh * 64); const u32x4* cp = (const u32x4*)(Cc + t * 256 + g * 128 + nh * 64); float yp = 0.f;
#pragma unroll
            for (int j = 0; j < 8; ++j) { const u32x4 bw = bp[j], cw = cp[j];
                const float bv[8] = {bflo(bw.x), bfhi(bw.x), bflo(bw.y), bfhi(bw.y), bflo(bw.z), bfhi(bw.z), bflo(bw.w), bfhi(bw.w)};
                const float cv[8] = {bflo(cw.x), bfhi(cw.x), bflo(cw.y), bfhi(cw.y), bflo(cw.z), bfhi(cw.z), bflo(cw.w), bfhi(cw.w)};
#pragma unroll
                for (int e = 0; e < 8; ++e) { hs[8 * j + e] = da * hs[8 * j + e] + cf * bv[e]; yp += cv[e] * hs[8 * j + e]; } }
            float y = yp + __shfl_xor(yp, 1); y += D * xv;
            const float z = bf2f(projp[t * 2304 + 768 + h * 64 + pp]); const float gv = y * silu(z);
            float ss = nh == 0 ? gv * gv : 0.f; ss = wave_sum(ss);
            __syncthreads();
            if ((tid & 63) == 0) red[tid >> 6] = ss;
            __syncthreads();
            const float tot = red[0] + red[1] + red[2] + red[3] + red[4] + red[5] + red[6] + red[7];
            if (nh == 0) cat[t * 1024 + 512 + h * 64 + pp] = f2bf(gv * rsqrtf(tot * (1.f / 256.f) + 1e-6f) * gn); }
        float* so = p.out + O_SSM_S + sidx;
#pragma unroll
        for (int j = 0; j < 16; ++j) *(float4*)(so + 4 * j) = make_float4(hs[4 * j], hs[4 * j + 1], hs[4 * j + 2], hs[4 * j + 3]);
    }
}
constexpr int SS_CS = 0, SS_DT = 4096, SS_XW = 8192, SS_B1 = 8192 + 32768;
constexpr int SS_H = 8192, SS_BT = 8192 + 32768, SS_XD = SS_BT + 16384;
__device__ __forceinline__ unsigned off_b(unsigned row, unsigned ch) { return 256u * row + 16u * (ch ^ (((row & 3) << 2) | ((row >> 2) & 3))); }
__device__ __forceinline__ bf16x8 trpair(LAS const unsigned char* p) { const s16x4 a = tr_read(p), b = tr_read(p + 512); return __builtin_shufflevector(a, b, 0, 1, 2, 3, 4, 5, 6, 7); }
__device__ __forceinline__ void ssd_cumsum(const P& p, int t0, int g, int wid, int lane, LAS unsigned char* lds) {
    if (wid < 4) { const int h = g * 4 + wid; const float A2 = -__expf(p.a_log[h]) * 1.4426950408889634f; const float* dtf = (const float*)(p.ws + W_DTF);
        float d[4], s[4];
#pragma unroll
        for (int j = 0; j < 4; ++j) d[j] = dtf[(size_t)(t0 + 4 * lane + j) * 8 + h];
        s[0] = d[0] * A2; s[1] = s[0] + d[1] * A2; s[2] = s[1] + d[2] * A2; s[3] = s[2] + d[3] * A2;
        float incl = s[3];
#pragma unroll
        for (int o = 1; o < 64; o <<= 1) { const float v = __shfl_up(incl, o); if (lane >= o) incl += v; }
        const float ex = incl - s[3];
        *(LAS f32x4*)(lds + SS_CS + wid * 1024 + lane * 16) = (f32x4){ex + s[0], ex + s[1], ex + s[2], ex + s[3]};
        *(LAS f32x4*)(lds + SS_DT + wid * 1024 + lane * 16) = (f32x4){d[0], d[1], d[2], d[3]}; }
}
__device__ void phase_ssd_pass1(const P& p, LAS unsigned char* lds) {
    const int tid = pg8::opaque_tid(), lane = tid & 63, r32 = lane & 31, hi = lane >> 5; const int wid = __builtin_amdgcn_readfirstlane(tid >> 6);
    const float* xsf = (const float*)(p.ws + W_XSF); const bf16_t* Bc = (const bf16_t*)(p.ws + W_BC); float* states = (float*)(p.ws + W_STATES); float* chdec = (float*)(p.ws + W_CHDEC);
    const int voff = (4 * hi + ((lane & 15) >> 2)) * 64 + ((lane >> 4) & 1) * 32 + (lane & 3) * 8;
    LAS const float* cs = (LAS const float*)(lds + SS_CS); LAS const float* dtl = (LAS const float*)(lds + SS_DT);
    for (int it = blockIdx.x; it < 128; it += gridDim.x) { const int b = it >> 4, g = (it >> 3) & 1, c = it & 7, t0 = b * 2048 + c * 256;
        __syncthreads();
        ssd_cumsum(p, t0, g, wid, lane, lds);
        __syncthreads();
        if (tid < 4) chdec[(b * 8 + g * 4 + tid) * 8 + c] = cs[tid * 256 + 255];
        f32x16 acc[4];
#pragma unroll
        for (int nb = 0; nb < 4; ++nb)
#pragma unroll
            for (int r = 0; r < 16; ++r) acc[nb][r] = 0.f;
        for (int ls = 0; ls < 4; ++ls) {
            __syncthreads();
#pragma unroll
            for (int i = 0; i < 8; ++i) { const int f = tid + 512 * i, l = f >> 6, c4 = f & 63, hl = c4 >> 4;
                const float4 v = *(const float4*)(xsf + (size_t)(t0 + 64 * ls + l) * 512 + g * 256 + 4 * c4);
                const float w = __builtin_amdgcn_exp2f(cs[hl * 256 + 255] - cs[hl * 256 + 64 * ls + l]) * dtl[hl * 256 + 64 * ls + l];
                u32x2 o; o.x = cvt_pk_bf16(v.x * w, v.y * w); o.y = cvt_pk_bf16(v.z * w, v.w * w);
                *(LAS u32x2*)(lds + SS_XW + (c4 >> 3) * 4096 + l * 64 + (c4 & 7) * 8) = o; }
#pragma unroll
            for (int i = 0; i < 2; ++i) { const int q = tid + 512 * i, l = q >> 4, ch = q & 15;
                const u32x4 v = *(const u32x4*)(Bc + (size_t)(t0 + 64 * ls + l) * 256 + g * 128 + 8 * ch);
                *(LAS u32x4*)(lds + SS_B1 + (ch >> 2) * 4096 + l * 64 + (ch & 3) * 16) = v; }
            __syncthreads();
#pragma unroll
            for (int ks = 0; ks < 4; ++ks) { const bf16x8 a = trpair(lds + SS_XW + wid * 4096 + voff + ks * 1024);
#pragma unroll
                for (int nb = 0; nb < 4; ++nb) { const bf16x8 bb = trpair(lds + SS_B1 + nb * 4096 + voff + ks * 1024); acc[nb] = MFMA32(a, bb, acc[nb]); } }
        }
        float* so = states + ((size_t)((b * 8 + g * 4 + (wid >> 1)) * 8 + c)) * 8192;
#pragma unroll
        for (int nb = 0; nb < 4; ++nb)
#pragma unroll
            for (int r = 0; r < 16; ++r) so[(32 * (wid & 1) + crow(r, hi)) * 128 + 32 * nb + r32] = acc[nb][r];
    }
}
__device__ void phase_ssd_pass2(const P& p, LAS unsigned char* lds) {
    const int tid = pg8::opaque_tid(), lane = tid & 63, r32 = lane & 31, hi = lane >> 5; const int wid = __builtin_amdgcn_readfirstlane(tid >> 6);
    const float* xsf = (const float*)(p.ws + W_XSF); const bf16_t* Bc = (const bf16_t*)(p.ws + W_BC); const bf16_t* Cc = (const bf16_t*)(p.ws + W_CC);
    const float* states = (const float*)(p.ws + W_STATES); const float* chdec = (const float*)(p.ws + W_CHDEC); const bf16_t* projp = (const bf16_t*)(p.ws + W_PROJ); bf16_t* cat = (bf16_t*)(p.ws + W_CAT);
    const int voff = (4 * hi + ((lane & 15) >> 2)) * 64 + ((lane >> 4) & 1) * 32 + (lane & 3) * 8;
    LAS const float* cs = (LAS const float*)(lds + SS_CS); LAS const float* dtl = (LAS const float*)(lds + SS_DT);
    for (int it = blockIdx.x; it < 128; it += gridDim.x) { const int b = it >> 4, g = (it >> 3) & 1, c = it & 7, t0 = b * 2048 + c * 256;
        const int ll = 32 * wid + r32; const size_t tl = (size_t)t0 + ll;
        __syncthreads();
        ssd_cumsum(p, t0, g, wid, lane, lds);
        bf16x8 Cf[8];
#pragma unroll
        for (int ks = 0; ks < 8; ++ks) Cf[ks] = *(const bf16x8*)(Cc + tl * 256 + g * 128 + 16 * ks + 8 * hi);
        float ssq_tok = 0.f;
        for (int hd = 0; hd < 4; ++hd) { const int h = g * 4 + hd;
            __syncthreads();
            if (c > 0) {
#pragma unroll
                for (int i = 0; i < 4; ++i) { const int f = tid + 512 * i, pp = f >> 5, n4 = f & 31;
                    const float* sb = states + ((size_t)(b * 8 + h) * 8) * 8192 + pp * 128 + 4 * n4; const float* cd = chdec + (b * 8 + h) * 8;
                    float4 sum = make_float4(0.f, 0.f, 0.f, 0.f); float coef = 1.f;
                    for (int j = c - 1; j >= 0; --j) { const float4 v = *(const float4*)(sb + (size_t)j * 8192); sum.x += coef * v.x; sum.y += coef * v.y; sum.z += coef * v.z; sum.w += coef * v.w; coef *= __builtin_amdgcn_exp2f(cd[j]); }
                    u32x2 o; o.x = cvt_pk_bf16(sum.x, sum.y); o.y = cvt_pk_bf16(sum.z, sum.w);
                    *(LAS u32x2*)(lds + SS_H + off_b(pp, n4 >> 1) + 8 * (n4 & 1)) = o;
                    if (c == 7) { const float d7 = __builtin_amdgcn_exp2f(cd[7]); const float4 v = *(const float4*)(sb + (size_t)7 * 8192);
                        *(float4*)(p.out + O_SSM_P + ((size_t)(b * 8 + h) * 64 + pp) * 128 + 4 * n4) = make_float4(d7 * sum.x + v.x, d7 * sum.y + v.y, d7 * sum.z + v.z, d7 * sum.w + v.w); } } }
            f32x16 acc[2];
#pragma unroll
            for (int q = 0; q < 2; ++q)
#pragma unroll
                for (int r = 0; r < 16; ++r) acc[q][r] = 0.f;
            __syncthreads();
            if (c > 0) {
#pragma unroll
                for (int pb = 0; pb < 2; ++pb)
#pragma unroll
                    for (int ks = 0; ks < 8; ++ks) { const bf16x8 a = lds128(lds + SS_H + off_b(32 * pb + r32, 2 * ks + hi)); acc[pb] = MFMA32(a, Cf[ks], acc[pb]); }
                const float e = __builtin_amdgcn_exp2f(cs[hd * 256 + ll]);
#pragma unroll
                for (int r = 0; r < 16; ++r) { acc[0][r] *= e; acc[1][r] *= e; } }
            for (int kt = 0; kt < 4; ++kt) {
                __syncthreads();
#pragma unroll
                for (int i = 0; i < 2; ++i) { const int q = tid + 512 * i, s = q >> 4, ch = q & 15;
                    const u32x4 v = *(const u32x4*)(Bc + (size_t)(t0 + 64 * kt + s) * 256 + g * 128 + 8 * ch);
                    *(LAS u32x4*)(lds + SS_BT + off_b(s, ch)) = v; }
#pragma unroll
                for (int i = 0; i < 2; ++i) { const int f = tid + 512 * i, s = f >> 4, c4 = f & 15;
                    const float4 v = *(const float4*)(xsf + (size_t)(t0 + 64 * kt + s) * 512 + h * 64 + 4 * c4); const float w = dtl[hd * 256 + 64 * kt + s];
                    u32x2 o; o.x = cvt_pk_bf16(v.x * w, v.y * w); o.y = cvt_pk_bf16(v.z * w, v.w * w);
                    *(LAS u32x2*)(lds + SS_XD + (c4 >> 3) * 4096 + s * 64 + (c4 & 7) * 8) = o; }
                __syncthreads();
                if (kt <= (wid >> 1)) {
                    f32x16 s0, s1;
#pragma unroll
                    for (int r = 0; r < 16; ++r) { s0[r] = 0.f; s1[r] = 0.f; }
#pragma unroll
                    for (int ks = 0; ks < 8; ++ks) { const bf16x8 a0 = lds128(lds + SS_BT + off_b(r32, 2 * ks + hi)), a1 = lds128(lds + SS_BT + off_b(32 + r32, 2 * ks + hi));
                        s0 = MFMA32(a0, Cf[ks], s0); s1 = MFMA32(a1, Cf[ks], s1); }
                    LAS const float* ch = cs + hd * 256; const float cl = ch[ll];
#pragma unroll
                    for (int g4 = 0; g4 < 4; ++g4) { const int sb = 64 * kt + 8 * g4 + 4 * hi; const f32x4 ca = *(LAS const f32x4*)(ch + sb), cb2 = *(LAS const f32x4*)(ch + sb + 32);
#pragma unroll
                        for (int j = 0; j < 4; ++j) { const int r = 4 * g4 + j;
                            s0[r] = (sb + j <= ll) ? s0[r] * __builtin_amdgcn_exp2f(cl - ca[j]) : 0.f;
                            s1[r] = (sb + 32 + j <= ll) ? s1[r] * __builtin_amdgcn_exp2f(cl - cb2[j]) : 0.f; } }
                    bf16x8 pf[4]; pf[0] = pack8(s0, 0); pf[1] = pack8(s0, 1); pf[2] = pack8(s1, 0); pf[3] = pack8(s1, 1);
#pragma unroll
                    for (int pb = 0; pb < 2; ++pb)
#pragma unroll
                        for (int ks = 0; ks < 4; ++ks) { const bf16x8 a = trpair(lds + SS_XD + pb * 4096 + voff + ks * 1024); acc[pb] = MFMA32(a, pf[ks], acc[pb]); }
                }
            }
            { const float D = p.d_skip[h];
#pragma unroll
                for (int pb = 0; pb < 2; ++pb)
#pragma unroll
                    for (int g4 = 0; g4 < 4; ++g4) { const int p0 = 32 * pb + 8 * g4 + 4 * hi;
                        const float4 xv = *(const float4*)(xsf + tl * 512 + h * 64 + p0); const u32x2 zr = *(const u32x2*)(projp + tl * 2304 + 768 + h * 64 + p0);
                        const float y0 = acc[pb][4 * g4] + D * xv.x, y1 = acc[pb][4 * g4 + 1] + D * xv.y, y2 = acc[pb][4 * g4 + 2] + D * xv.z, y3 = acc[pb][4 * g4 + 3] + D * xv.w;
                        const float g0 = y0 * silu(bflo(zr.x)), g1 = y1 * silu(bfhi(zr.x)), g2 = y2 * silu(bflo(zr.y)), g3 = y3 * silu(bfhi(zr.y));
                        ssq_tok += g0 * g0 + g1 * g1 + g2 * g2 + g3 * g3;
                        u32x2 o; o.x = cvt_pk_bf16(g0, g1); o.y = cvt_pk_bf16(g2, g3); *(u32x2*)(cat + tl * 1024 + 512 + h * 64 + p0) = o; } }
        }
        asm volatile("s_waitcnt vmcnt(0)" ::: "memory");
        { const float tot = ssq_tok + __shfl_xor(ssq_tok, 32); const float rs = rsqrtf(tot * (1.f / 256.f) + 1e-6f);
#pragma unroll
          for (int hl = 0; hl < 4; ++hl)
#pragma unroll
              for (int pb = 0; pb < 2; ++pb)
#pragma unroll
                  for (int g4 = 0; g4 < 4; ++g4) { const int col = (g * 4 + hl) * 64 + 32 * pb + 8 * g4 + 4 * hi; bf16_t* a = cat + tl * 1024 + 512 + col;
                      const u32x2 v = *(const u32x2*)a; const float4 gn = *(const float4*)(p.ssm_norm + col);
                      u32x2 o; o.x = cvt_pk_bf16(bflo(v.x) * rs * gn.x, bfhi(v.x) * rs * gn.y); o.y = cvt_pk_bf16(bflo(v.y) * rs * gn.z, bfhi(v.y) * rs * gn.w); *(u32x2*)a = o; } }
    }
}
constexpr int SA_Q = 0, SA_T = 36864, SA_TB = 36864, SA_ROPE = 32768;
__device__ void attn_sample_item(const P& p, int b, int split, LAS unsigned char* lds) {
    const int tid = pg8::opaque_tid(), lane = tid & 63, r32 = lane & 31, hi = lane >> 5; const int wid = __builtin_amdgcn_readfirstlane(tid >> 6);
    const int qb = wid & 1, kb = (wid >> 1) & 1, dh = wid >> 2;
    const bf16_t* Qs = (const bf16_t*)(p.ws + W_QS);
    __syncthreads();
    for (int idx = tid; idx < 2304; idx += 512) { const int qrow = idx / 36, ch = idx % 36;
        *(LAS u32x4*)(lds + SA_Q + ch * 1024 + qrow * 16) = *(const u32x4*)(Qs + (size_t)(b * 64 + qrow) * 288 + 8 * ch); }
    const int ntiles = 64 + (split ? 1 : 0);
    f32x4 st[9];
#define SA_LOAD(t) do { const int pg_ = p.pt[b * 64 + split * 32 + ((t) >> 1)]; const float* kv_ = p.ckv + ((size_t)pg_ * 128 + ((t) & 1) * 64) * 256; const float* kr_ = p.ckr + ((size_t)pg_ * 128 + ((t) & 1) * 64) * 32; \
        _Pragma("unroll") for (int i_ = 0; i_ < 8; ++i_) st[i_] = __builtin_nontemporal_load((const f32x4*)(kv_ + (size_t)(tid + 512 * i_) * 4)); st[8] = __builtin_nontemporal_load((const f32x4*)(kr_ + (size_t)tid * 4)); } while (0)
#define SA_WRITE(buf) do { LAS unsigned char* tb_ = lds + SA_T + (buf) * SA_TB; \
        _Pragma("unroll") for (int i_ = 0; i_ < 8; ++i_) { const int f_ = tid + 512 * i_, key_ = f_ >> 6, d4_ = f_ & 63; u32x2 o_; o_.x = cvt_pk_bf16(st[i_][0], st[i_][1]); o_.y = cvt_pk_bf16(st[i_][2], st[i_][3]); \
            *(LAS u32x2*)(tb_ + (d4_ >> 5) * 16384 + off_b(key_, (d4_ & 31) >> 1) + 8 * (d4_ & 1)) = o_; } \
        { const int key_ = tid >> 3, pc_ = tid & 7; u32x2 o_; o_.x = cvt_pk_bf16(st[8][0], st[8][1]); o_.y = cvt_pk_bf16(st[8][2], st[8][3]); *(LAS u32x2*)(tb_ + SA_ROPE + (pc_ >> 1) * 1024 + key_ * 16 + (pc_ & 1) * 8) = o_; } } while (0)
    f32x16 o[4];
#pragma unroll
    for (int d = 0; d < 4; ++d)
#pragma unroll
        for (int r = 0; r < 16; ++r) o[d][r] = 0.f;
    float m_run = -INFINITY, l_run = 0.f;
    const int q4 = (lane & 15) >> 2, p4 = lane & 3, blk = (lane >> 4) & 1, lq = 4 * qb + (r32 >> 3);
    SA_LOAD(0); SA_WRITE(0);
    __syncthreads();
    for (int t = 0; t < ntiles; ++t) { const int buf = t & 1; LAS const unsigned char* tb = lds + SA_T + buf * SA_TB;
        if (t + 1 < 64) SA_LOAD(t + 1);
        f32x16 s;
#pragma unroll
        for (int r = 0; r < 16; ++r) s[r] = 0.f;
#pragma unroll
        for (int ks = 0; ks < 16; ++ks) { const bf16x8 a = lds128(tb + (ks >> 3) * 16384 + off_b(32 * kb + r32, 2 * (ks & 7) + hi)), bq = lds128(lds + SA_Q + (2 * ks + hi) * 1024 + (32 * qb + r32) * 16); s = MFMA32(a, bq, s); }
#pragma unroll
        for (int ks = 16; ks < 18; ++ks) { const bf16x8 a = lds128(tb + SA_ROPE + (2 * (ks - 16) + hi) * 1024 + (32 * kb + r32) * 16), bq = lds128(lds + SA_Q + (2 * ks + hi) * 1024 + (32 * qb + r32) * 16); s = MFMA32(a, bq, s); }
        if (t == 64) {
#pragma unroll
            for (int r = 0; r < 16; ++r) { const int key = 32 * kb + crow(r, hi); if (key >= 8 || key > lq) s[r] = -INFINITY; } }
        float mx = max16(s); mx = fmaxf(mx, __shfl_xor(mx, 32));
        const float m_new = fmaxf(m_run, mx), alpha = __builtin_amdgcn_exp2f(m_run - m_new); m_run = m_new;
        float ps = 0.f;
#pragma unroll
        for (int r = 0; r < 16; ++r) { s[r] = __builtin_amdgcn_exp2f(s[r] - m_new); ps += s[r]; }
        l_run = l_run * alpha + ps;
#pragma unroll
        for (int d = 0; d < 4; ++d)
#pragma unroll
            for (int r = 0; r < 16; ++r) o[d][r] *= alpha;
        bf16x8 pf[2]; pf[0] = pack8(s, 0); pf[1] = pack8(s, 1);
#pragma unroll
        for (int sx = 0; sx < 2; ++sx)
#pragma unroll
            for (int db = 0; db < 4; ++db) { const int row = 32 * kb + 16 * sx + 4 * hi + q4, ch = 4 * db + 2 * blk + (p4 >> 1);
                const s16x4 lo = tr_read(tb + dh * 16384 + off_b(row, ch) + 8 * (p4 & 1)), hh = tr_read(tb + dh * 16384 + off_b(row + 8, ch) + 8 * (p4 & 1));
                const bf16x8 a = __builtin_shufflevector(lo, hh, 0, 1, 2, 3, 4, 5, 6, 7); o[db] = MFMA32(a, pf[sx], o[db]); }
        if (t + 1 < 64) SA_WRITE(buf ^ 1);
        else if (t + 1 < ntiles) { LAS unsigned char* tn = lds + SA_T + (buf ^ 1) * SA_TB;
            if (tid < 256) { const int key = tid >> 5, c32 = tid & 31; *(LAS u32x4*)(tn + (c32 >> 4) * 16384 + off_b(key, c32 & 15)) = *(const u32x4*)((const bf16_t*)(p.ws + W_CB) + (size_t)(TP + b * 8 + key) * 256 + 8 * c32); }
            else if (tid < 288) { const int key = (tid - 256) >> 2, pc = (tid - 256) & 3; *(LAS u32x4*)(tn + SA_ROPE + pc * 1024 + key * 16) = *(const u32x4*)((const bf16_t*)(p.ws + W_KRS) + (size_t)(b * 8 + key) * 32 + 8 * pc); } }
        __syncthreads();
    }
#undef SA_LOAD
#undef SA_WRITE
    const float l_tot = l_run + __shfl_xor(l_run, 32);
    LAS float* xo = (LAS float*)(lds + SA_T) + (qb + 2 * dh) * 4096; LAS float* xs = (LAS float*)(lds + SA_T + 65536) + (qb + 2 * dh) * 128;
    if (kb == 1) {
#pragma unroll
        for (int d = 0; d < 4; ++d)
#pragma unroll
            for (int r = 0; r < 16; ++r) xo[(d * 16 + r) * 64 + lane] = o[d][r];
        xs[lane] = m_run; xs[64 + lane] = l_tot; }
    __syncthreads();
    if (kb == 0) { const float m1 = xs[lane], l1 = xs[64 + lane], m = fmaxf(m_run, m1), w0 = __builtin_amdgcn_exp2f(m_run - m), w1 = __builtin_amdgcn_exp2f(m1 - m), l = l_tot * w0 + l1 * w1;
        float* po = (float*)(p.ws + W_PO) + ((size_t)(b * 2 + split) * 64 + 32 * qb + r32) * 256 + 128 * dh + 4 * hi;
#pragma unroll
        for (int d = 0; d < 4; ++d)
#pragma unroll
            for (int g4 = 0; g4 < 4; ++g4) { float4 v;
                v.x = o[d][4 * g4] * w0 + xo[(d * 16 + 4 * g4) * 64 + lane] * w1; v.y = o[d][4 * g4 + 1] * w0 + xo[(d * 16 + 4 * g4 + 1) * 64 + lane] * w1;
                v.z = o[d][4 * g4 + 2] * w0 + xo[(d * 16 + 4 * g4 + 2) * 64 + lane] * w1; v.w = o[d][4 * g4 + 3] * w0 + xo[(d * 16 + 4 * g4 + 3) * 64 + lane] * w1;
                *(float4*)(po + 32 * d + 8 * g4) = v; }
        if (dh == 0 && hi == 0) { float* pm = (float*)(p.ws + W_PML) + ((size_t)(b * 2 + split) * 64 + 32 * qb + r32) * 2; pm[0] = m; pm[1] = l; } }
}
__device__ void phase_attn_sample(const P& p, LAS unsigned char* lds) {
    for (int it = blockIdx.x; it < 256; it += gridDim.x) attn_sample_item(p, it >> 1, it & 1, lds);
}
__device__ void phase_sample_combine(const P& p, LAS unsigned char* lds) {
    const int tid = pg8::opaque_tid(); LAS float* ol = (LAS float*)lds;
    const float* po = (const float*)(p.ws + W_PO); const float* pm = (const float*)(p.ws + W_PML); bf16_t* cat = (bf16_t*)(p.ws + W_CAT);
    for (int b = blockIdx.x; b < 128; b += gridDim.x) {
        __syncthreads();
        { const int row = tid >> 3, seg = tid & 7; const float m0 = pm[((size_t)(b * 2) * 64 + row) * 2], l0 = pm[((size_t)(b * 2) * 64 + row) * 2 + 1], m1 = pm[((size_t)(b * 2 + 1) * 64 + row) * 2], l1 = pm[((size_t)(b * 2 + 1) * 64 + row) * 2 + 1];
          const float m = fmaxf(m0, m1), w0 = __builtin_amdgcn_exp2f(m0 - m), w1 = __builtin_amdgcn_exp2f(m1 - m), li = 1.f / (l0 * w0 + l1 * w1);
#pragma unroll
          for (int j = 0; j < 8; ++j) { const float4 a = *(const float4*)(po + ((size_t)(b * 2) * 64 + row) * 256 + seg * 32 + 4 * j), c = *(const float4*)(po + ((size_t)(b * 2 + 1) * 64 + row) * 256 + seg * 32 + 4 * j);
              *(LAS f32x4*)(ol + row * 260 + seg * 32 + 4 * j) = (f32x4){(a.x * w0 + c.x * w1) * li, (a.y * w0 + c.y * w1) * li, (a.z * w0 + c.z * w1) * li, (a.w * w0 + c.w * w1) * li}; } }
        __syncthreads();
        { const int row = tid >> 3, v0 = (tid & 7) * 8, h = row & 7; const float* wv = p.w_uv + (size_t)h * 16384 + v0; float acc[8];
#pragma unroll
          for (int j = 0; j < 8; ++j) acc[j] = 0.f;
#pragma unroll 4
          for (int r = 0; r < 256; ++r) { const float ov = ol[row * 260 + r]; const float4 a = *(const float4*)(wv + r * 64), c = *(const float4*)(wv + r * 64 + 4);
              acc[0] += ov * a.x; acc[1] += ov * a.y; acc[2] += ov * a.z; acc[3] += ov * a.w; acc[4] += ov * c.x; acc[5] += ov * c.y; acc[6] += ov * c.z; acc[7] += ov * c.w; }
          u32x4 w; w.x = cvt_pk_bf16(acc[0], acc[1]); w.y = cvt_pk_bf16(acc[2], acc[3]); w.z = cvt_pk_bf16(acc[4], acc[5]); w.w = cvt_pk_bf16(acc[6], acc[7]);
          *(u32x4*)(cat + (size_t)(TP + b * 8 + (row >> 3)) * 1024 + h * 64 + v0) = w; }
    }
}
__global__ void __launch_bounds__(512, 2) mega(P p) {
    extern __shared__ __attribute__((aligned(16))) unsigned char lds[];
    LAS unsigned char* ldsl = (LAS unsigned char*)lds;
    if (threadIdx.x < 4) ((volatile LAS unsigned*)(ldsl + LDS_XB))[threadIdx.x] = 0u;
    __syncthreads();
    XcdBarrier bar = xcd_barrier_post((unsigned*)(p.ws + W_CTL), (volatile LAS unsigned*)(ldsl + LDS_XB));
    const int lo = p.ph_lo, hi = p.ph_hi;
#define IN(k) (lo <= (k) && (k) < hi)
#define SEAM(k) do { if (IN(k) && IN((k) + 1)) xcd_barrier(bar); } while (0)
    if (IN(0)) phase_prep(p, lds);
    SEAM(0);
    if (IN(1)) { pg8::Gemm g{(const bf16_t*)(p.ws + W_HN), (const bf16_t*)(p.ws + W_BIN), T, 2304, 1024}; pg8::StaticOrder S; S.init(T, 2304, gridDim.x, (int)blockIdx.x);
        pg8::EpiBf16<0> E{(bf16_t*)(p.ws + W_PROJ), 2304, nullptr, 0, 0}; pg8::gemm_phase<pg8::EpiBf16<0>, pg8::StaticOrder>(ldsl, g, S, E, nullptr); }
    SEAM(1);
    if (IN(2)) phase_thin(p);
    SEAM(2);
    if (IN(3)) { const float qscale = 0.14724418f;
        const bf16_t* qn = (const bf16_t*)(p.ws + W_QN); const float* rope = (const float*)(p.ws + W_ROPE);
        { pg8::Gemm g{(const bf16_t*)(p.ws + W_CB), (const bf16_t*)(p.ws + W_BKV), TP, 1024, 256}; pg8::StaticOrder S; S.init(TP, 1024, gridDim.x, (int)blockIdx.x);
          EpiKV E{(bf16_t*)(p.ws + W_KP), (bf16_t*)(p.ws + W_VP)}; pg8::gemm_phase<EpiKV, pg8::StaticOrder>(ldsl, g, S, E, nullptr); }
        asm volatile("" ::: "memory"); __builtin_amdgcn_sched_barrier(0);
        { pg8::Gemm g{qn, (const bf16_t*)(p.ws + W_BUQP), TP, 768, 384}; pg8::StaticOrder S; S.init(TP, 768, gridDim.x, (int)((blockIdx.x + 192) & 255));
          EpiQ<96, 64, 0> E{(bf16_t*)(p.ws + W_QP), 768, rope, qscale}; pg8::gemm_phase<EpiQ<96, 64, 0>, pg8::StaticOrder>(ldsl, g, S, E, nullptr); }
        asm volatile("" ::: "memory"); __builtin_amdgcn_sched_barrier(0);
        { pg8::Gemm g{qn + (size_t)TP * 384, (const bf16_t*)(p.ws + W_BQS), TS, 2304, 384}; pg8::StaticOrder S; S.init(TS, 2304, gridDim.x, (int)blockIdx.x);
          EpiQ<288, 256, 1> E{(bf16_t*)(p.ws + W_QS), 2304, rope, qscale}; pg8::gemm_phase<EpiQ<288, 256, 1>, pg8::StaticOrder>(ldsl, g, S, E, nullptr); }
    }
    if (IN(3)) phase_ssd_pass1(p, ldsl);
    SEAM(3);
    if (IN(4)) { phase_attn_prompt(p, ldsl); phase_attn_sample(p, ldsl); __syncthreads(); phase_ssd_pass2(p, ldsl); __syncthreads(); phase_ssd_sample(p, ldsl); }
    SEAM(4);
    if (IN(5)) phase_sample_combine(p, ldsl);
    SEAM(5);
    if (IN(6)) { pg8::Gemm g{(const bf16_t*)(p.ws + W_CAT), (const bf16_t*)(p.ws + W_BOUT), T, 1024, 1024}; pg8::StaticOrder S; S.init(T, 1024, gridDim.x, (int)blockIdx.x);
        EpiRes<true> E{p.x_p, p.x_s, (float*)(p.ws + W_X1), (bf16_t*)(p.ws + W_X1B), (float*)(p.ws + W_SSQ1)}; pg8::gemm_phase<EpiRes<true>, pg8::StaticOrder>(ldsl, g, S, E, nullptr); }
    SEAM(6);
    if (IN(7)) { pg8::Gemm g{(const bf16_t*)(p.ws + W_X1B), (const bf16_t*)(p.ws + W_BUP), T, 4096, 1024}; pg8::StaticOrder S; S.init(T, 4096, gridDim.x, (int)blockIdx.x);
        EpiUp E{(bf16_t*)(p.ws + W_U), (const float*)(p.ws + W_SSQ1)}; pg8::gemm_phase<EpiUp, pg8::StaticOrder>(ldsl, g, S, E, nullptr); }
    SEAM(7);
    if (IN(8)) { pg8::Gemm g{(const bf16_t*)(p.ws + W_U), (const bf16_t*)(p.ws + W_BDOWN), T, 1024, 4096}; pg8::StaticOrder S; S.init(T, 1024, gridDim.x, (int)blockIdx.x);
        const float* x1 = (const float*)(p.ws + W_X1);
        EpiRes<false> E{x1, x1 + (size_t)TP * 1024, (float*)(p.ws + W_X2), nullptr, (float*)(p.ws + W_SSQ2)}; pg8::gemm_phase<EpiRes<false>, pg8::StaticOrder>(ldsl, g, S, E, nullptr); }
    SEAM(8);
    if (IN(9)) phase_final(p);
#undef IN
#undef SEAM
}

static void fill_params(P& p, void* const* d_in, float* out, unsigned char* ws) {
    p.x_p = (const float*)d_in[0]; p.x_s = (const float*)d_in[1]; p.ckv = (const float*)d_in[2]; p.ckr = (const float*)d_in[3]; p.st_ssm = (const float*)d_in[4]; p.st_conv = (const float*)d_in[5];
    p.pt = (const int*)d_in[6]; p.norm_attn = (const float*)d_in[7]; p.w_in = (const float*)d_in[8]; p.q_norm = (const float*)d_in[9]; p.kv_norm = (const float*)d_in[10]; p.w_uq = (const float*)d_in[11];
    p.w_uk = (const float*)d_in[12]; p.w_uv = (const float*)d_in[13]; p.conv_w = (const float*)d_in[14]; p.conv_b = (const float*)d_in[15]; p.dt_bias = (const float*)d_in[16]; p.a_log = (const float*)d_in[17];
    p.d_skip = (const float*)d_in[18]; p.ssm_norm = (const float*)d_in[19]; p.w_out = (const float*)d_in[20]; p.norm_mlp = (const float*)d_in[21]; p.w_up = (const float*)d_in[22]; p.w_down = (const float*)d_in[23];
    p.norm_final = (const float*)d_in[24]; p.out = out; p.ws = ws;
}
static bool launch(void* const* d_in, float* out, unsigned char* ws, int ph_lo, int ph_hi, hipStream_t stream) {
    static int ready = 0;
    if (!ready) {
        if (hipFuncSetAttribute((const void*)mega, hipFuncAttributeMaxDynamicSharedMemorySize, LDS_BYTES) != hipSuccess) { fprintf(stderr, "mk: hipFuncSetAttribute failed\n"); ready = -1; }
        else { int per_cu = 0; if (hipOccupancyMaxActiveBlocksPerMultiprocessor(&per_cu, (const void*)mega, 512, LDS_BYTES) != hipSuccess || per_cu < 1) fprintf(stderr, "mk: occupancy query says %d\n", per_cu); (void)hipGetLastError(); ready = 1; }
    }
    if (ready < 0) return false;
    hipMemsetAsync(ws + W_CTL, 0, 16384, stream);
    P p{}; fill_params(p, d_in, out, ws); p.ph_lo = ph_lo; p.ph_hi = ph_hi;
    hipLaunchKernelGGL(mega, dim3(256), dim3(512), LDS_BYTES, stream, p);
    return hipPeekAtLastError() == hipSuccess;
}
}
extern "C" void kernel_launch(void* const* d_in, const int* in_sizes, int n_in, void* d_out, int out_size, void* d_ws, size_t ws_size, hipStream_t stream) {
    if (n_in != 25 || out_size != (int)mk::O_TOTAL || ws_size < mk::W_END) { fprintf(stderr, "kernel_launch: unexpected shapes (n_in %d, out %d, ws %zu)\n", n_in, out_size, ws_size); return; }
    mk::launch(d_in, (float*)d_out, (unsigned char*)d_ws, 0, 10, stream);
}
```

```cpp
#include <hip/hip_runtime.h>
#include <cstdio>
#include <cstdint>
#define XB_TMO      128
#define XB_XCNT(j)  (256  + 64 * (j))
#define XB_XSUB(j)  (1280 + 64 * (j))
#define XB_XGEN(j)  (2304 + 64 * (j))
#define XB_TOP      3328
#define XB_TOPGEN   3392
#define XCD_BAR_WORDS 3456
#define XB_SPIN_CAP (1u << 18)
#define LAS __attribute__((address_space(3)))

__device__ __forceinline__ unsigned xb_ld(unsigned* p)              { return __hip_atomic_load(p, __ATOMIC_RELAXED, __HIP_MEMORY_SCOPE_AGENT); }
__device__ __forceinline__ unsigned xb_add(unsigned* p, unsigned v) { return __hip_atomic_fetch_add(p, v, __ATOMIC_RELAXED, __HIP_MEMORY_SCOPE_AGENT); }
__device__ __forceinline__ unsigned xb_xcc_id() { return (unsigned)__builtin_amdgcn_s_getreg((3 << 11) | 20) & 0xFu; }
#define XB_SPIN(cond, bar) do { unsigned _sp = 0; while (cond) { __builtin_amdgcn_s_sleep(1); \
    if ((++_sp & 255u) == 0u) { if (xb_ld(&(bar)[XB_TMO])) break; if (_sp > XB_SPIN_CAP) { atomicAdd(&(bar)[XB_TMO], 1u); break; } } } } while (0)

struct XcdBarrier {
    unsigned* bar; unsigned x;
    volatile LAS unsigned* st;
};

__device__ __forceinline__ XcdBarrier xcd_barrier_post(unsigned* bar, volatile LAS unsigned* st) {
    XcdBarrier b; b.bar = bar; b.x = xb_xcc_id(); b.st = st;
    if (threadIdx.x == 0) (void)xb_add(&bar[XB_XCNT(b.x)], 1u);
    return b;
}
__device__ __forceinline__ void xcd_barrier_complete(unsigned* bar, unsigned x, unsigned& nloc, unsigned& nx) {
    const unsigned G = gridDim.x * gridDim.y * gridDim.z;
    unsigned sum, cnt, mine, sp = 0u;
    for (;;) {
        sum = 0u; cnt = 0u; mine = 0u;
#pragma unroll
        for (unsigned j = 0; j < 16; ++j) { const unsigned c = xb_ld(&bar[XB_XCNT(j)]); sum += c; cnt += (c > 0u) ? 1u : 0u; mine = (j == x) ? c : mine; }
        if (sum == G) break;
        __builtin_amdgcn_s_sleep(1);
        if ((++sp & 255u) == 0u) { if (xb_ld(&bar[XB_TMO])) break; if (sp > XB_SPIN_CAP) { atomicAdd(&bar[XB_TMO], 1u); break; } }
    }
    nloc = mine > 0u ? mine : 1u; nx = cnt > 0u ? cnt : 1u;
}

__device__ __forceinline__ void xcd_barrier(const XcdBarrier& b) {
    asm volatile("s_waitcnt vmcnt(0)" ::: "memory");
    __syncthreads();
    if (threadIdx.x == 0) {
        unsigned* bar = b.bar;
        __builtin_amdgcn_s_waitcnt(0);
        unsigned nloc = b.st[0], nx = b.st[1];
        if (nloc == 0u) { xcd_barrier_complete(bar, b.x, nloc, nx); b.st[0] = nloc; b.st[1] = nx; }
        const unsigned old = xb_add(&bar[XB_XSUB(b.x)], 1u);
        const unsigned gen = old / nloc;
        if (old + 1u == (gen + 1u) * nloc) {
            __builtin_amdgcn_fence(__ATOMIC_RELEASE, "agent");
            asm volatile("s_waitcnt vmcnt(0)" ::: "memory");
            const unsigned og = xb_add(&bar[XB_TOP], 1u);
            const unsigned tg = og / nx;
            if (og + 1u == (tg + 1u) * nx) xb_add(&bar[XB_TOPGEN], 1u);
            else XB_SPIN(xb_ld(&bar[XB_TOPGEN]) == tg, bar);
            __builtin_amdgcn_fence(__ATOMIC_ACQUIRE, "agent");
            xb_add(&bar[XB_XGEN(b.x)], 1u);
            asm volatile("s_waitcnt vmcnt(0)" ::: "memory");
        } else {
            XB_SPIN(xb_ld(&bar[XB_XGEN(b.x)]) == gen, bar);
            __builtin_amdgcn_fence(__ATOMIC_ACQUIRE, "agent");
            asm volatile("s_waitcnt vmcnt(0)" ::: "memory");
        }
    }
    __syncthreads();
}
namespace pg8 {
__device__ __forceinline__ int opaque_tid() { int t; asm volatile("v_mov_b32 %0, %1" : "=v"(t) : "v"((int)threadIdx.x)); return t; }
#define PG8_LAS __attribute__((address_space(3)))
typedef unsigned short bf16_t;
typedef short bf16x8 __attribute__((ext_vector_type(8)));
typedef float f32x4 __attribute__((ext_vector_type(4)));
typedef unsigned u32x4 __attribute__((ext_vector_type(4)));
constexpr int BM = 256, BK = 64, HALF = 128, HTB = HALF * BK * 2  , STAGE_BYTES = 8 * HTB, NXCD = 8, WGM = 8;

__host__ __device__ __forceinline__ int lds_byte(int r, int c) { const int st = (r >> 4) * 2 + (c >> 5), rr = r & 15, cc = c & 31, ob = rr * 64 + cc * 2; return st * 1024 + (ob ^ (((ob >> 9) & 1) << 5)); }
__host__ __device__ __forceinline__ void stage_rc(int b, int& R, int& C) { const int st = b / 1024, sb = b % 1024, swz = sb ^ (((sb >> 9) & 1) << 5); R = (st >> 1) * 16 + swz / 64; C = (st & 1) * 32 + (swz % 64) / 2; }
__host__ __device__ __forceinline__ int perm32(int rho) { const int n = rho >> 4, i = rho & 15; return 8 * (i >> 2) + 4 * n + (i & 3); }

struct Unit { int pm, pn; };
struct Gemm { const bf16_t* A; const bf16_t* Bt; int M, N, K; int ldk = 0; };

struct StaticOrder {
    int nM, nN, nwg, G, c;
    __host__ __device__ __forceinline__ void init(int M, int N, int G_, int c_) { nM = M / BM; nN = N / BM; nwg = nM * nN; G = G_; c = c_; }
    __host__ __device__ __forceinline__ bool next(int i, Unit& u) const {
        const long L = (long)i * G + c; if (L >= nwg) return false;
        int wgid = (int)L; { const int q = nwg / NXCD, r = nwg % NXCD, xcd = wgid % NXCD, off = wgid / NXCD; wgid = (xcd < r ? xcd * (q + 1) : r * (q + 1) + (xcd - r) * q) + off; }
        const int nig = WGM * nN, gid = wgid / nig, fm = gid * WGM, gsz = (nM - fm) < WGM ? (nM - fm) : WGM;
        u.pm = fm + ((wgid % nig) % gsz); u.pn = (wgid % nig) / gsz; return true;
    }
    __device__ __forceinline__ void a_ready(const Unit&) const {}
    __device__ __forceinline__ void done(const Unit&) const {}
};

__device__ __forceinline__ unsigned cvt_pk_bf16(float lo, float hi) { unsigned r; asm volatile("v_cvt_pk_bf16_f32 %0, %1, %2" : "=v"(r) : "v"(lo), "v"(hi)); return r; }
typedef float f32x2 __attribute__((ext_vector_type(2)));

struct EpiF32 {
    static constexpr bool PERM = false, AFTER_DRAIN = false;
    float* C; int ldc; const float* bias;
    __device__ __forceinline__ void operator()(const f32x4 (&acc)[2][2][4][2], const Unit& u, int wr, int wc, int fr, int fq) const {
        const int row0 = u.pm * BM + wr * 64 + fr, col0 = u.pn * BM + wc * 32 + 4 * fq;
        f32x4 bv[2][2];
#pragma unroll
        for (int bj = 0; bj < 2; ++bj)
#pragma unroll
            for (int n = 0; n < 2; ++n) bv[bj][n] = bias ? *(const f32x4*)(bias + col0 + bj * HALF + n * 16) : (f32x4){0.f, 0.f, 0.f, 0.f};
#pragma unroll
        for (int ai = 0; ai < 2; ++ai)
#pragma unroll
            for (int m = 0; m < 4; ++m) { float* rowp = C + (size_t)(row0 + ai * HALF + m * 16) * ldc + col0;
#pragma unroll
                for (int bj = 0; bj < 2; ++bj)
#pragma unroll
                    for (int n = 0; n < 2; ++n) *(f32x4*)(rowp + bj * HALF + n * 16) = acc[ai][bj][m][n] + bv[bj][n]; }
    }
};
template <int ACT  > struct EpiBf16 {
    static constexpr bool PERM = true, AFTER_DRAIN = false;
    bf16_t* O; int ldc; const float* bias; int split_cols; size_t split_stride;
    __device__ __forceinline__ void operator()(const f32x4 (&acc)[2][2][4][2], const Unit& u, int wr, int wc, int fr, int fq) const {
        const int row0 = u.pm * BM + wr * 64 + fr; int colt = u.pn * BM; bf16_t* base = O;
        if (split_cols) { const int t = colt / split_cols; base += (size_t)t * split_stride; colt -= t * split_cols; }
        const int col0 = colt + wc * 32 + 8 * fq, bcol0 = u.pn * BM + wc * 32 + 8 * fq;
        f32x4 bv[2][2];
#pragma unroll
        for (int bj = 0; bj < 2; ++bj)
#pragma unroll
            for (int n = 0; n < 2; ++n) bv[bj][n] = bias ? *(const f32x4*)(bias + bcol0 + bj * HALF + 4 * n) : (f32x4){0.f, 0.f, 0.f, 0.f};
#pragma unroll
        for (int ai = 0; ai < 2; ++ai)
#pragma unroll
            for (int m = 0; m < 4; ++m) { bf16_t* rowp = base + (size_t)(row0 + ai * HALF + m * 16) * ldc + col0;
#pragma unroll
                for (int bj = 0; bj < 2; ++bj) { f32x4 v0 = acc[ai][bj][m][0] + bv[bj][0], v1 = acc[ai][bj][m][1] + bv[bj][1];
                    u32x4 w; w.x = cvt_pk_bf16(v0[0], v0[1]); w.y = cvt_pk_bf16(v0[2], v0[3]); w.z = cvt_pk_bf16(v1[0], v1[1]); w.w = cvt_pk_bf16(v1[2], v1[3]);
                    *(u32x4*)(rowp + bj * HALF) = w; } }
    }
};

template <class Epi, class Sched, bool STAMP = false>
__device__ __forceinline__ void gemm_phase(PG8_LAS unsigned char* lds, const Gemm g, const Sched& S, const Epi& E, unsigned long long* stamps) {
    const int tid = opaque_tid(), wid = __builtin_amdgcn_readfirstlane(tid >> 6), lane = tid & 63, wr = wid >> 2, wc = wid & 3, fr = lane & 15, fq = lane >> 4;
    const int nt = g.K / BK, K = g.ldk ? g.ldk : g.K;
    int ts_lo = 0, ts_hi = 0, nts = 0; const unsigned long long rt_entry = STAMP ? (unsigned long long)wall_clock64() : 0ull;
#define PG8_STAMP() do { if (STAMP && wid == 0 && nts < 64) { const unsigned long long _c = (unsigned long long)clock64(); \
        ts_lo = (lane == nts) ? (int)(unsigned)_c : ts_lo; ts_hi = (lane == nts) ? (int)(unsigned)(_c >> 32) : ts_hi; ++nts; } } while (0)
    PG8_STAMP();
    unsigned voffA[2], voffB[2];
#pragma unroll
    for (int i = 0; i < 2; ++i) { int R, C; stage_rc(tid * 16 + i * 8192, R, C); const int Rb = Epi::PERM ? ((R & ~31) + perm32(R & 31)) : R;
        voffA[i] = (unsigned)(R * K + C) * 2u; voffB[i] = (unsigned)(Rb * K + C) * 2u; }
    const size_t kstep = (size_t)(BK * 2);
    const size_t hstep = (size_t)HALF * K * 2;
    const size_t tstep = 2 * hstep;
    const unsigned ldsw = (unsigned)wid * 1024u;
    const int aoff = lds_byte(wr * 64 + fr, fq * 8), boff = lds_byte(wc * 32 + fr, fq * 8);
#define PG8_SA(b, h) (((b) * 2 + (h)) * HTB)
#define PG8_SB(b, h) ((4 + (b) * 2 + (h)) * HTB)
#define PG8_STAGE(bufoff, gbase, voff) do { _Pragma("unroll") for (int _i = 0; _i < 2; ++_i) \
        __builtin_amdgcn_global_load_lds((const unsigned*)((const char*)(gbase) + (voff)[_i]), (PG8_LAS unsigned*)(lds + (bufoff) + ldsw + _i * 8192), 16, 0, 0); } while (0)
#define PG8_LDA(dst, b, h) do { _Pragma("unroll") for (int m = 0; m < 4; ++m) _Pragma("unroll") for (int k = 0; k < 2; ++k) dst[m][k] = *(const PG8_LAS bf16x8*)(lds + PG8_SA(b, h) + aoff + m * 2048 + k * 1024); } while (0)
#define PG8_LDB(dst, b, h) do { _Pragma("unroll") for (int n = 0; n < 2; ++n) _Pragma("unroll") for (int k = 0; k < 2; ++k) dst[n][k] = *(const PG8_LAS bf16x8*)(lds + PG8_SB(b, h) + boff + n * 2048 + k * 1024); } while (0)
#define PG8_MMA(ai, bj, At, Bt) do { __builtin_amdgcn_s_setprio(1); _Pragma("unroll") for (int m = 0; m < 4; ++m) _Pragma("unroll") for (int n = 0; n < 2; ++n) _Pragma("unroll") for (int k = 0; k < 2; ++k) \
        acc[ai][bj][m][n] = __builtin_amdgcn_mfma_f32_16x16x32_bf16(Bt[n][k], At[m][k], acc[ai][bj][m][n], 0, 0, 0); __builtin_amdgcn_s_setprio(0); } while (0)
#define PG8_WAIT_V(n) asm volatile("s_waitcnt vmcnt(" #n ")" ::: "memory")
#define PG8_WAIT_L(n) asm volatile("s_waitcnt lgkmcnt(" #n ")" ::: "memory")
#define PG8_BAR __builtin_amdgcn_s_barrier()
#define PG8_SCHED __builtin_amdgcn_sched_barrier(0)
    Unit cur, nxt; int ui = 0;
    if (!S.next(0, cur)) return;
    f32x4 acc[2][2][4][2];
#pragma unroll
    for (int a = 0; a < 2; ++a)
#pragma unroll
        for (int b = 0; b < 2; ++b)
#pragma unroll
            for (int m = 0; m < 4; ++m)
#pragma unroll
                for (int n = 0; n < 2; ++n) acc[a][b][m][n] = (f32x4){0.f, 0.f, 0.f, 0.f};
    bf16x8 At[4][2], B0[2][2], B1[2][2];
    const char* cA = (const char*)g.A + (size_t)cur.pm * tstep; const char* cB = (const char*)g.Bt + (size_t)cur.pn * tstep;
    S.a_ready(cur);
    PG8_STAGE(PG8_SB(0, 0), cB, voffB); PG8_STAGE(PG8_SA(0, 0), cA, voffA); PG8_STAGE(PG8_SB(0, 1), cB + hstep, voffB); PG8_STAGE(PG8_SA(0, 1), cA + hstep, voffA);
    if (wr == 1) PG8_BAR;
    PG8_WAIT_V(4); PG8_BAR;
    PG8_STAGE(PG8_SB(1, 0), cB + kstep, voffB); PG8_STAGE(PG8_SA(1, 0), cA + kstep, voffA); PG8_STAGE(PG8_SB(1, 1), cB + hstep + kstep, voffB);
    PG8_WAIT_V(6); PG8_BAR;
    PG8_STAMP();
    for (;;) {
        const bool has_next = S.next(ui + 1, nxt);
        const char* nA = has_next ? (const char*)g.A + (size_t)nxt.pm * tstep : cA; const char* nB = has_next ? (const char*)g.Bt + (size_t)nxt.pn * tstep : cB;
        for (int t = 0; t < nt; t += 2) {
            const bool last = (t == nt - 2);
            const char* a1 = cA + (size_t)(t + 1) * kstep;
            const char* a2 = last ? nA : cA + (size_t)(t + 2) * kstep; const char* b2 = last ? nB : cB + (size_t)(t + 2) * kstep;
            const char* a3 = a2 + kstep; const char* b3 = b2 + kstep;
            if (last && has_next) S.a_ready(nxt);
            PG8_LDB(B0, 0, 0); PG8_SCHED; PG8_LDA(At, 0, 0); PG8_STAGE(PG8_SA(1, 1), a1 + hstep, voffA);
            PG8_WAIT_L(8); PG8_BAR; PG8_WAIT_L(0); PG8_MMA(0, 0, At, B0); PG8_BAR; PG8_SCHED;
            PG8_LDB(B1, 0, 1); PG8_STAGE(PG8_SB(0, 0), b2, voffB);
            PG8_BAR; PG8_WAIT_L(0); PG8_MMA(0, 1, At, B1); PG8_BAR;
            PG8_LDA(At, 0, 1); PG8_STAGE(PG8_SA(0, 0), a2, voffA);
            PG8_BAR; PG8_WAIT_L(0); PG8_MMA(1, 0, At, B0); PG8_BAR; PG8_SCHED;
            PG8_STAGE(PG8_SB(0, 1), b2 + hstep, voffB);
            PG8_WAIT_V(6); PG8_BAR; PG8_MMA(1, 1, At, B1); PG8_BAR;
            PG8_LDB(B0, 1, 0); PG8_SCHED; PG8_LDA(At, 1, 0); PG8_STAGE(PG8_SA(0, 1), a2 + hstep, voffA);
            PG8_WAIT_L(8); PG8_BAR; PG8_WAIT_L(0); PG8_MMA(0, 0, At, B0); PG8_BAR; PG8_SCHED;
            PG8_LDB(B1, 1, 1); PG8_STAGE(PG8_SB(1, 0), b3, voffB);
            PG8_BAR; PG8_WAIT_L(0); PG8_MMA(0, 1, At, B1); PG8_BAR;
            PG8_LDA(At, 1, 1); PG8_STAGE(PG8_SA(1, 0), a3, voffA);
            PG8_BAR; PG8_WAIT_L(0); PG8_MMA(1, 0, At, B0); PG8_BAR; PG8_SCHED;
            PG8_STAGE(PG8_SB(1, 1), b3 + hstep, voffB);
            PG8_WAIT_V(6); PG8_BAR; PG8_MMA(1, 1, At, B1); PG8_BAR;
        }
        PG8_STAMP();
        if constexpr (!Epi::AFTER_DRAIN) { E(acc, cur, wr, wc, fr, fq); S.done(cur); }
        PG8_STAMP();
        if (!has_next) break;
#pragma unroll
        for (int a = 0; a < 2; ++a)
#pragma unroll
            for (int b = 0; b < 2; ++b)
#pragma unroll
                for (int m = 0; m < 4; ++m)
#pragma unroll
                    for (int n = 0; n < 2; ++n) acc[a][b][m][n] = (f32x4){0.f, 0.f, 0.f, 0.f};
        cur = nxt; cA = nA; cB = nB; ++ui;
    }
    PG8_WAIT_V(0);
    if (wr == 0) PG8_BAR;
    PG8_BAR;
    if constexpr (Epi::AFTER_DRAIN) { E.fused(acc, cur, wr, wc, fr, fq, lds, wid, lane); S.done(cur); }
    PG8_STAMP();
    if (STAMP && wid == 0) { stamps[lane] = lane < nts ? (((unsigned long long)(unsigned)ts_hi << 32) | (unsigned)ts_lo) : 0ull;
        if (lane == 62) stamps[62] = rt_entry; if (lane == 63) stamps[63] = (unsigned long long)wall_clock64(); }
#undef PG8_STAMP
#undef PG8_SA
#undef PG8_SB
#undef PG8_STAGE
#undef PG8_LDA
#undef PG8_LDB
#undef PG8_MMA
#undef PG8_WAIT_V
#undef PG8_WAIT_L
#undef PG8_BAR
#undef PG8_SCHED
}
}
namespace mk {
using pg8::bf16_t; using pg8::bf16x8; using pg8::f32x4; using pg8::u32x4; using pg8::cvt_pk_bf16;
typedef float f32x16 __attribute__((ext_vector_type(16)));
typedef short s16x4 __attribute__((ext_vector_type(4)));
typedef unsigned u32x2 __attribute__((ext_vector_type(2)));
constexpr int T = 17408, TP = 16384, TS = 1024, NPOS = 2056;
constexpr long O_Y_P = 0, O_Y_S = 16777216, O_KV_P = 17825792, O_KR_P = 22020096, O_SSM_P = 22544384, O_CONV_P = 23068672,
               O_KV_S = 23093248, O_KR_S = 23355392, O_SSM_S = 23388160, O_CONV_S = 31776768, O_TOTAL = 32169984;
constexpr int LDS_BYTES = 147456;
constexpr int LDS_XB = LDS_BYTES - 16;

constexpr size_t al(size_t x) { return (x + 255) & ~(size_t)255; }
constexpr size_t W_CTL = 0;
constexpr size_t W_ROPE = 16384;
constexpr size_t W_BIN = W_ROPE + al((size_t)NPOS * 32 * 4);
constexpr size_t W_BUQP = W_BIN + (size_t)2304 * 1024 * 2;
constexpr size_t W_BQS = W_BUQP + (size_t)768 * 384 * 2;
constexpr size_t W_BKV = W_BQS + (size_t)2304 * 384 * 2;
constexpr size_t W_BOUT = W_BKV + (size_t)1024 * 256 * 2;
constexpr size_t W_BUP = W_BOUT + (size_t)1024 * 1024 * 2;
constexpr size_t W_BDOWN = W_BUP + (size_t)4096 * 1024 * 2;
constexpr size_t W_HN = W_BDOWN + (size_t)1024 * 4096 * 2;
constexpr size_t W_PROJ = W_HN + (size_t)T * 1024 * 2;
constexpr size_t W_QN = W_PROJ + (size_t)T * 2304 * 2;
constexpr size_t W_CB = W_QN + (size_t)T * 384 * 2;
constexpr size_t W_KP = W_CB + (size_t)T * 256 * 2;
constexpr size_t W_VP = W_KP + (size_t)TP * 768 * 2;
constexpr size_t W_QP = W_VP + (size_t)TP * 512 * 2;
constexpr size_t W_QS = W_QP + (size_t)TP * 768 * 2;
constexpr size_t W_KRS = W_QS + (size_t)TS * 2304 * 2;
constexpr size_t W_BC = W_KRS + (size_t)TS * 32 * 2;
constexpr size_t W_CC = W_BC + (size_t)T * 256 * 2;
constexpr size_t W_XSF = W_CC + (size_t)T * 256 * 2;
constexpr size_t W_DTF = W_XSF + (size_t)T * 512 * 4;
constexpr size_t W_CAT = W_DTF + (size_t)T * 8 * 4;
constexpr size_t W_X1B = W_CAT + (size_t)T * 1024 * 2;
constexpr size_t W_SSQ1 = W_X1B + (size_t)T * 1024 * 2;
constexpr size_t W_SSQ2 = W_SSQ1 + (size_t)T * 16 * 4;
constexpr size_t W_U = W_SSQ2 + (size_t)T * 16 * 4;
constexpr size_t W_X2B = W_U + (size_t)T * 4096 * 2;
constexpr size_t W_STATES = W_X2B + (size_t)T * 1024 * 2;
constexpr size_t W_CHDEC = W_STATES + (size_t)512 * 8192 * 4;
constexpr size_t W_PML = W_CHDEC + 4096;
constexpr size_t W_PO = W_PML + (size_t)128 * 2 * 64 * 2 * 4;
constexpr size_t W_SLAB = W_PO + (size_t)128 * 2 * 64 * 256 * 4;
constexpr size_t W_HPREV = W_SLAB + (size_t)16 * 1024 * 1024 * 4;
constexpr size_t W_SSQS = W_HPREV + (size_t)512 * 8192 * 2;
constexpr size_t W_YRAW = W_SSQS + (size_t)TS * 32 * 4;
constexpr size_t W_END = W_YRAW + (size_t)TP * 512 * 4;

struct P {
    const float *x_p, *x_s, *ckv, *ckr, *st_ssm, *st_conv; const int* pt;
    const float *norm_attn, *w_in, *q_norm, *kv_norm, *w_uq, *w_uk, *w_uv, *conv_w, *conv_b, *dt_bias, *a_log, *d_skip, *ssm_norm, *w_out, *norm_mlp, *w_up, *w_down, *norm_final;
    float* out; unsigned char* ws; int ph_lo, ph_hi;
};

__device__ __forceinline__ float bf2f(unsigned short b) { return __uint_as_float(((unsigned)b) << 16); }
__device__ __forceinline__ float bflo(unsigned w) { return __uint_as_float(w << 16); }
__device__ __forceinline__ float bfhi(unsigned w) { return __uint_as_float(w & 0xffff0000u); }
__device__ __forceinline__ unsigned short f2bf(float f) { return (unsigned short)(cvt_pk_bf16(f, 0.f) & 0xffffu); }
__device__ __forceinline__ float wave_sum(float v) {
#pragma unroll
    for (int o = 32; o; o >>= 1) v += __shfl_xor(v, o);
    return v; }
__device__ __forceinline__ float silu(float v) { return v / (1.f + __expf(-v)); }

__device__ __forceinline__ int inproj_colmap(int n) {
    if (n < 256) return 384 + n; if (n < 640) return n - 256; if (n < 672) return n; if (n < 680) return n + 1536; if (n < 768) return -1; return n - 96; }
struct TJob { bf16_t* dst; const float* src; const float* ks; int ld, K, n0, k0, mode; };
__device__ __forceinline__ TJob tjob(const P& p, int j) {
    unsigned char* ws = p.ws; TJob t; t.ks = nullptr; t.mode = 0;
    if (j < 288) { const int kt = j & 7, nt = j >> 3; t.dst = (bf16_t*)(ws + W_BIN); t.src = p.w_in; t.ld = 2216; t.K = 1024; t.n0 = nt * 64; t.k0 = kt * 128; t.mode = 1; }
    else if (j < 324) { const int q = j - 288, kt = q % 3, nt = q / 3; t.dst = (bf16_t*)(ws + W_BUQP); t.src = p.w_uq; t.ld = 768; t.K = 384; t.n0 = nt * 64; t.k0 = kt * 128; }
    else if (j < 340) { const int q = j - 324, kt = q & 1, h = q >> 1; t.dst = (bf16_t*)(ws + W_BKV) + (size_t)(512 + h * 64) * 256; t.src = p.w_uv + (size_t)h * 16384; t.ld = 64; t.K = 256; t.n0 = 0; t.k0 = kt * 128; }
    else if (j < 468) { const int q = j - 340, kt = q & 7, nt = q >> 3; t.dst = (bf16_t*)(ws + W_BOUT); t.src = p.w_out; t.ld = 1024; t.K = 1024; t.n0 = nt * 64; t.k0 = kt * 128; }
    else if (j < 980) { const int q = j - 468, kt = q & 7, nt = q >> 3; t.dst = (bf16_t*)(ws + W_BUP); t.src = p.w_up; t.ld = 4096; t.K = 1024; t.n0 = nt * 64; t.k0 = kt * 128; t.ks = p.norm_mlp; }
    else { const int q = j - 980, kt = q & 31, nt = q >> 5; t.dst = (bf16_t*)(ws + W_BDOWN); t.src = p.w_down; t.ld = 1024; t.K = 4096; t.n0 = nt * 64; t.k0 = kt * 128; }
    return t;
}
__device__ __forceinline__ void tload(const TJob& t, int tid, float4 (&v)[4]) {
    float sc[4];
#pragma unroll
    for (int i = 0; i < 4; ++i) { const int e = tid + i * 512, kk = e >> 4, n4 = (e & 15) * 4, n = t.n0 + n4, c = t.mode ? inproj_colmap(n) : n;
        v[i] = *(const float4*)(t.src + (size_t)(t.k0 + kk) * t.ld + (c >= 0 ? c : 0)); sc[i] = c >= 0 ? 1.f : 0.f; }
    if (t.ks) {
#pragma unroll
        for (int i = 0; i < 4; ++i) { const int kk = (tid + i * 512) >> 4; sc[i] *= t.ks[t.k0 + kk]; } }
#pragma unroll
    for (int i = 0; i < 4; ++i) { v[i].x *= sc[i]; v[i].y *= sc[i]; v[i].z *= sc[i]; v[i].w *= sc[i]; }
}
__device__ __forceinline__ void tconv_run(const P& p, unsigned char* lds, int j0, int jend, int step) {
    const int tid = pg8::opaque_tid();
    float* tile = (float*)lds; int j = j0; float4 v[4]; TJob cur = tjob(p, j < jend ? j : 0);
    if (j < jend) tload(cur, tid, v);
    while (j < jend) {
        __syncthreads();
#pragma unroll
        for (int i = 0; i < 4; ++i) { const int e = tid + i * 512, kk = e >> 4, n4 = (e & 15) * 4; *(float4*)(tile + kk * 68 + ((n4 + 4 * (kk >> 3)) & 63)) = v[i]; }
        __syncthreads();
        const int jn = j + step; const TJob nxt = tjob(p, jn < jend ? jn : 0);
        if (jn < jend) tload(nxt, tid, v);
#pragma unroll
        for (int i = 0; i < 2; ++i) { const int e = tid + i * 512, nn = e >> 4, kc = (e & 15) * 8; float f[8];
#pragma unroll
            for (int q = 0; q < 8; ++q) f[q] = tile[(kc + q) * 68 + ((nn + 4 * (kc >> 3)) & 63)];
            u32x4 w; w.x = cvt_pk_bf16(f[0], f[1]); w.y = cvt_pk_bf16(f[2], f[3]); w.z = cvt_pk_bf16(f[4], f[5]); w.w = cvt_pk_bf16(f[6], f[7]);
            *(u32x4*)(cur.dst + (size_t)(cur.n0 + nn) * cur.K + cur.k0 + kc) = w; }
        cur = nxt; j = jn; }
    __syncthreads();
}
template <int NT> __device__ __forceinline__ void xprep(const P& p, bf16_t* hn, const float4 (&gn)[4], int t0, int lane) {
    float4 v[NT][4]; float ss[NT];
#pragma unroll
    for (int q = 0; q < NT; ++q) { const int t = t0 + q; const float* xr = t < TP ? p.x_p + (size_t)t * 1024 : p.x_s + (size_t)(t - TP) * 1024;
#pragma unroll
        for (int i = 0; i < 4; ++i) v[q][i] = *(const float4*)(xr + i * 256 + lane * 4); }
#pragma unroll
    for (int q = 0; q < NT; ++q) { ss[q] = 0.f;
#pragma unroll
        for (int i = 0; i < 4; ++i) ss[q] += v[q][i].x * v[q][i].x + v[q][i].y * v[q][i].y + v[q][i].z * v[q][i].z + v[q][i].w * v[q][i].w; }
#pragma unroll
    for (int o = 32; o; o >>= 1) {
#pragma unroll
        for (int q = 0; q < NT; ++q) ss[q] += __shfl_xor(ss[q], o); }
#pragma unroll
    for (int q = 0; q < NT; ++q) { const float rs = rsqrtf(ss[q] * (1.f / 1024.f) + 1e-6f);
#pragma unroll
        for (int i = 0; i < 4; ++i) { u32x2 w; w.x = cvt_pk_bf16(v[q][i].x * rs * gn[i].x, v[q][i].y * rs * gn[i].y); w.y = cvt_pk_bf16(v[q][i].z * rs * gn[i].z, v[q][i].w * rs * gn[i].w);
            *(u32x2*)(hn + (size_t)(t0 + q) * 1024 + i * 256 + lane * 4) = w; } }
}
__device__ __forceinline__ void phase_prep(const P& p, unsigned char* lds) {
    const int tid = pg8::opaque_tid(), lane = tid & 63, wid = tid >> 6, G = gridDim.x;
    unsigned char* ws = p.ws;
    { bf16_t* hn = (bf16_t*)(ws + W_HN); float4 gn[4];
#pragma unroll
      for (int i = 0; i < 4; ++i) gn[i] = *(const float4*)(p.norm_attn + i * 256 + lane * 4);
      for (int g8 = blockIdx.x * 8 + wid; g8 < TP / 8; g8 += G * 8) xprep<8>(p, hn, gn, g8 * 8, lane);
      for (int s1 = blockIdx.x * 8 + wid; s1 < TS; s1 += G * 8) xprep<1>(p, hn, gn, TP + s1, lane); }
    tconv_run(p, lds, (int)blockIdx.x, 340, G);
    { const int job = 255 - (int)blockIdx.x;
      if (job < 96) { const int h = job / 12, k0 = (job % 12) * 32; float* Bl = (float*)lds; float* Al = (float*)(lds + 65536);
        __syncthreads();
#pragma unroll
        for (int i = 0; i < 8; ++i) { const int f = tid + 512 * i; *(float4*)(Bl + f * 4) = *(const float4*)(p.w_uk + (size_t)h * 16384 + f * 4); }
        { const int kk = tid >> 4, d4 = tid & 15; *(float4*)(Al + kk * 68 + 4 * d4) = *(const float4*)(p.w_uq + (size_t)(k0 + kk) * 768 + h * 96 + 4 * d4); }
        __syncthreads();
        const int c = tid & 255, kh = tid >> 8; float acc[16];
#pragma unroll
        for (int q = 0; q < 16; ++q) acc[q] = 0.f;
        for (int d4 = 0; d4 < 16; ++d4) { const float b0 = Bl[(4 * d4) * 256 + c], b1 = Bl[(4 * d4 + 1) * 256 + c], b2 = Bl[(4 * d4 + 2) * 256 + c], b3 = Bl[(4 * d4 + 3) * 256 + c];
#pragma unroll
            for (int q = 0; q < 16; ++q) { const float4 a = *(const float4*)(Al + (kh * 16 + q) * 68 + 4 * d4); acc[q] += a.x * b0 + a.y * b1 + a.z * b2 + a.w * b3; } }
        u32x4 w0, w1; w0.x = cvt_pk_bf16(acc[0], acc[1]); w0.y = cvt_pk_bf16(acc[2], acc[3]); w0.z = cvt_pk_bf16(acc[4], acc[5]); w0.w = cvt_pk_bf16(acc[6], acc[7]);
        w1.x = cvt_pk_bf16(acc[8], acc[9]); w1.y = cvt_pk_bf16(acc[10], acc[11]); w1.z = cvt_pk_bf16(acc[12], acc[13]); w1.w = cvt_pk_bf16(acc[14], acc[15]);
        bf16_t* d = (bf16_t*)(ws + W_BQS) + (size_t)(h * 288 + c) * 384 + k0 + kh * 16; *(u32x4*)d = w0; *(u32x4*)(d + 8) = w1; } }
    const long gtid = (long)blockIdx.x * 512 + tid, gstride = (long)G * 512;
    { bf16_t* d = (bf16_t*)(ws + W_BQS);
      for (long i = gtid; i < 8L * 32 * 384; i += gstride) { const int k = (int)(i % 384), hj = (int)(i / 384), h = hj >> 5, jj = hj & 31;
        d[(size_t)(h * 288 + 256 + jj) * 384 + k] = f2bf(p.w_uq[(size_t)k * 768 + h * 96 + 64 + jj]); } }
    { bf16_t* d = (bf16_t*)(ws + W_BKV); for (long i = gtid; i < 131072 / 2; i += gstride) { const float2 v = *(const float2*)(p.w_uk + 2 * i); *(unsigned*)(d + 2 * i) = cvt_pk_bf16(v.x, v.y); } }
    { float* rt = (float*)(ws + W_ROPE);
      for (long i = gtid; i < (long)NPOS * 16; i += gstride) { const int pi = (int)(i >> 4), fi = (int)(i & 15), pos = pi < 2048 ? pi : 8192 + (pi - 2048);
        const double inv = exp2(-(double)(2 * fi) / 32.0 * 13.287712379549449); double sd, cd; sincos((double)pos * inv, &sd, &cd);
        rt[pi * 32 + fi] = (float)cd; rt[pi * 32 + 16 + fi] = (float)sd; } }
}

__device__ __forceinline__ void phase_thin(const P& p) {
    const int tid = pg8::opaque_tid(), lane = tid & 63, wid = tid >> 6, G = gridDim.x;
    unsigned char* ws = p.ws;
    const bf16_t* projp = (const bf16_t*)(ws + W_PROJ); const float* rope = (const float*)(ws + W_ROPE);
    bf16_t* cb = (bf16_t*)(ws + W_CB); bf16_t* qn = (bf16_t*)(ws + W_QN); bf16_t* Kp = (bf16_t*)(ws + W_KP); bf16_t* krs = (bf16_t*)(ws + W_KRS);
    bf16_t* Bc = (bf16_t*)(ws + W_BC); bf16_t* Cc = (bf16_t*)(ws + W_CC); float* xsf = (float*)(ws + W_XSF); float* dtf = (float*)(ws + W_DTF);
    float cw[4][16], cbias[16];
#pragma unroll
    for (int k = 0; k < 4; ++k)
#pragma unroll
        for (int j = 0; j < 4; ++j) { const float4 v = *(const float4*)(p.conv_w + k * 1024 + 16 * lane + 4 * j); cw[k][4 * j] = v.x; cw[k][4 * j + 1] = v.y; cw[k][4 * j + 2] = v.z; cw[k][4 * j + 3] = v.w; }
#pragma unroll
    for (int j = 0; j < 4; ++j) { const float4 v = *(const float4*)(p.conv_b + 16 * lane + 4 * j); cbias[4 * j] = v.x; cbias[4 * j + 1] = v.y; cbias[4 * j + 2] = v.z; cbias[4 * j + 3] = v.w; }
    const float4 kvn = *(const float4*)(p.kv_norm + 4 * lane);
    float qg[6];
#pragma unroll
    for (int j = 0; j < 6; ++j) qg[j] = p.q_norm[6 * lane + j];
    for (int t = blockIdx.x * 8 + wid; t < T; t += G * 8) {
        const bool pr = t < TP; const int l = pr ? (t & 2047) : ((t - TP) & 7), b = pr ? (t >> 11) : ((t - TP) >> 3), L = pr ? 2048 : 8;
        const bf16_t* row = projp + (size_t)t * 2304;
        { const u32x2 raw = *(const u32x2*)(row + 4 * lane); const float v0 = bflo(raw.x), v1 = bfhi(raw.x), v2 = bflo(raw.y), v3 = bfhi(raw.y);
          const float ss = wave_sum(v0 * v0 + v1 * v1 + v2 * v2 + v3 * v3), rs = rsqrtf(ss * (1.f / 256.f) + 1e-6f);
          const float o0 = v0 * rs * kvn.x, o1 = v1 * rs * kvn.y, o2 = v2 * rs * kvn.z, o3 = v3 * rs * kvn.w;
          float* od = pr ? p.out + O_KV_P + (size_t)t * 256 : p.out + O_KV_S + (size_t)(t - TP) * 256;
          *(float4*)(od + 4 * lane) = make_float4(o0, o1, o2, o3);
          u32x2 w; w.x = cvt_pk_bf16(o0, o1); w.y = cvt_pk_bf16(o2, o3); *(u32x2*)(cb + (size_t)t * 256 + 4 * lane) = w; }
        { const unsigned* qr = (const unsigned*)(row + 256 + 6 * lane); const unsigned r0 = qr[0], r1 = qr[1], r2 = qr[2];
          float q[6] = {bflo(r0), bfhi(r0), bflo(r1), bfhi(r1), bflo(r2), bfhi(r2)};
          float ss = 0.f;
#pragma unroll
          for (int j = 0; j < 6; ++j) ss += q[j] * q[j];
          ss = wave_sum(ss); const float rs = rsqrtf(ss * (1.f / 384.f) + 1e-6f);
          unsigned* qo = (unsigned*)(qn + (size_t)t * 384 + 6 * lane);
          qo[0] = cvt_pk_bf16(q[0] * rs * qg[0], q[1] * rs * qg[1]); qo[1] = cvt_pk_bf16(q[2] * rs * qg[2], q[3] * rs * qg[3]); qo[2] = cvt_pk_bf16(q[4] * rs * qg[4], q[5] * rs * qg[5]); }
        { const int i = lane & 15, pidx = pr ? l : 2048 + l; const float x1 = bf2f(row[640 + i]), x2 = bf2f(row[656 + i]);
          const float c = rope[pidx * 32 + i], s = rope[pidx * 32 + 16 + i];
          const float val = (lane & 16) ? (x2 * c + x1 * s) : (x1 * c - x2 * s); const int e = lane & 31;
          if (lane < 32) { float* od = pr ? p.out + O_KR_P + (size_t)t * 32 : p.out + O_KR_S + (size_t)(t - TP) * 32; od[e] = val; }
          const unsigned short vb = f2bf(val);
          if (pr) {
#pragma unroll
              for (int j = 0; j < 4; ++j) Kp[(size_t)t * 768 + ((lane >> 5) * 4 + j) * 96 + 64 + e] = vb; }
          else if (lane < 32) krs[(size_t)(t - TP) * 32 + e] = vb; }
        if (lane < 8) { const float v = bf2f(row[672 + lane]) + p.dt_bias[lane]; dtf[(size_t)t * 8 + lane] = v > 20.f ? v : log1pf(expf(v)); }
        { float acc[16], xc[16];
#pragma unroll
          for (int j = 0; j < 16; ++j) { acc[j] = cbias[j]; xc[j] = 0.f; }
          u32x4 ra[4], rb[4];
#pragma unroll
          for (int k = 0; k < 4; ++k) { const int lk = l + k - 3; const u32x4* src = (const u32x4*)(projp + (size_t)(lk >= 0 ? t + k - 3 : t) * 2304 + 1280 + 16 * lane); ra[k] = src[0]; rb[k] = src[1]; }
#pragma unroll
          for (int k = 0; k < 4; ++k) { const int lk = l + k - 3; float xv[16]; const u32x4 a = ra[k], c2 = rb[k];
            xv[0] = bflo(a.x); xv[1] = bfhi(a.x); xv[2] = bflo(a.y); xv[3] = bfhi(a.y); xv[4] = bflo(a.z); xv[5] = bfhi(a.z); xv[6] = bflo(a.w); xv[7] = bfhi(a.w);
            xv[8] = bflo(c2.x); xv[9] = bfhi(c2.x); xv[10] = bflo(c2.y); xv[11] = bfhi(c2.y); xv[12] = bflo(c2.z); xv[13] = bfhi(c2.z); xv[14] = bflo(c2.w); xv[15] = bfhi(c2.w);
            if (lk < 0) {
                if (!pr) { const float* src = p.st_conv + ((size_t)b * 3 + (l + k)) * 1024 + 16 * lane;
#pragma unroll
                    for (int j = 0; j < 4; ++j) { const float4 v = *(const float4*)(src + 4 * j); xv[4 * j] = v.x; xv[4 * j + 1] = v.y; xv[4 * j + 2] = v.z; xv[4 * j + 3] = v.w; } }
                else {
#pragma unroll
                    for (int j = 0; j < 16; ++j) xv[j] = 0.f; } }
#pragma unroll
            for (int j = 0; j < 16; ++j) { acc[j] += xv[j] * cw[k][j]; if (k == 3) xc[j] = xv[j]; } }
#pragma unroll
          for (int j = 0; j < 16; ++j) acc[j] = silu(acc[j]);
          if (lane < 32) { float* d = xsf + (size_t)t * 512 + 16 * lane;
#pragma unroll
              for (int j = 0; j < 4; ++j) *(float4*)(d + 4 * j) = make_float4(acc[4 * j], acc[4 * j + 1], acc[4 * j + 2], acc[4 * j + 3]); }
          else { bf16_t* d = (lane < 48 ? Bc + (size_t)t * 256 + 16 * (lane - 32) : Cc + (size_t)t * 256 + 16 * (lane - 48));
              u32x4 w0, w1; w0.x = cvt_pk_bf16(acc[0], acc[1]); w0.y = cvt_pk_bf16(acc[2], acc[3]); w0.z = cvt_pk_bf16(acc[4], acc[5]); w0.w = cvt_pk_bf16(acc[6], acc[7]);
              w1.x = cvt_pk_bf16(acc[8], acc[9]); w1.y = cvt_pk_bf16(acc[10], acc[11]); w1.z = cvt_pk_bf16(acc[12], acc[13]); w1.w = cvt_pk_bf16(acc[14], acc[15]);
              *(u32x4*)d = w0; *(u32x4*)(d + 8) = w1; }
          if (l >= L - 3) { float* d = (pr ? p.out + O_CONV_P : p.out + O_CONV_S) + ((size_t)b * 3 + (l - (L - 3))) * 1024 + 16 * lane;
#pragma unroll
              for (int j = 0; j < 4; ++j) *(float4*)(d + 4 * j) = make_float4(xc[4 * j], xc[4 * j + 1], xc[4 * j + 2], xc[4 * j + 3]); } }
    }
}
struct EpiKV {
    static constexpr bool PERM = true, AFTER_DRAIN = false;
    bf16_t* Kp; bf16_t* Vp;
    __device__ __forceinline__ void operator()(const f32x4 (&acc)[2][2][4][2], const pg8::Unit& u, int wr, int wc, int fr, int fq) const {
        const int row0 = u.pm * 256 + wr * 64 + fr, col = u.pn * 256 + wc * 32 + 8 * fq; const bool km = u.pn < 2;
        bf16_t* base = km ? Kp + (size_t)row0 * 768 + (col >> 6) * 96 + (col & 63) : Vp + (size_t)row0 * 512 + (col - 512);
        const int pitch = km ? 768 : 512, bjo = km ? 192 : 128;
#pragma unroll
        for (int ai = 0; ai < 2; ++ai)
#pragma unroll
            for (int m = 0; m < 4; ++m) { bf16_t* rp = base + (size_t)(ai * 128 + m * 16) * pitch;
#pragma unroll
                for (int bj = 0; bj < 2; ++bj) { const f32x4 v0 = acc[ai][bj][m][0], v1 = acc[ai][bj][m][1];
                    u32x4 w; w.x = cvt_pk_bf16(v0[0], v0[1]); w.y = cvt_pk_bf16(v0[2], v0[3]); w.z = cvt_pk_bf16(v1[0], v1[1]); w.w = cvt_pk_bf16(v1[2], v1[3]);
                    *(u32x4*)(rp + bj * bjo) = w; }
                asm volatile("" ::: "memory"); }
    }
};
template <int HD, int ROPE_OFF, int POS_MODE> struct EpiQ {
    static constexpr bool PERM = false, AFTER_DRAIN = false;
    bf16_t* O; int ldc; const float* rope; float scale;
    __device__ __forceinline__ void operator()(const f32x4 (&acc)[2][2][4][2], const pg8::Unit& u, int wr, int wc, int fr, int fq) const {
        const int row0 = u.pm * 256 + wr * 64 + fr;
#pragma unroll
        for (int bj = 0; bj < 2; ++bj) { const int g32 = u.pn * 256 + bj * 128 + wc * 32; const bool rg = ((g32 % HD) == ROPE_OFF);
#pragma unroll
            for (int ai = 0; ai < 2; ++ai)
#pragma unroll
                for (int m = 0; m < 4; ++m) { const int row = row0 + ai * 128 + m * 16; const int pidx = POS_MODE ? 2048 + (row & 7) : (row & 2047);
                    f32x4 v0 = acc[ai][bj][m][0], v1 = acc[ai][bj][m][1];
                    if (rg) { const f32x4 c = *(const f32x4*)(rope + pidx * 32 + 4 * fq), s = *(const f32x4*)(rope + pidx * 32 + 16 + 4 * fq);
                        const f32x4 r1 = v0 * c - v1 * s, r2 = v1 * c + v0 * s; v0 = r1; v1 = r2; }
                    v0 *= scale; v1 *= scale;
                    bf16_t* dst = O + (size_t)row * ldc + g32 + 4 * fq;
                    u32x2 w0, w1; w0.x = cvt_pk_bf16(v0[0], v0[1]); w0.y = cvt_pk_bf16(v0[2], v0[3]); w1.x = cvt_pk_bf16(v1[0], v1[1]); w1.y = cvt_pk_bf16(v1[2], v1[3]);
                    *(u32x2*)dst = w0; *(u32x2*)(dst + 16) = w1; asm volatile("" ::: "memory"); } }
    }
};

#define MFMA32(a, b, c) __builtin_amdgcn_mfma_f32_32x32x16_bf16((a), (b), (c), 0, 0, 0)
typedef short v4i16_t __attribute__((ext_vector_type(4)));
__device__ __forceinline__ s16x4 tr_read(LAS const unsigned char* p) { return __builtin_bit_cast(s16x4, __builtin_amdgcn_ds_read_tr16_b64_v4i16((LAS v4i16_t*)p)); }
__device__ __forceinline__ bf16x8 lds128(LAS const unsigned char* p) { return *(LAS const bf16x8*)p; }
__device__ __forceinline__ int crow(int r, int hi) { return (r & 3) + 8 * (r >> 2) + 4 * hi; }
__device__ __forceinline__ bf16x8 pack8(const f32x16& x, int s) {
    u32x4 w; w.x = cvt_pk_bf16(x[8 * s], x[8 * s + 1]); w.y = cvt_pk_bf16(x[8 * s + 2], x[8 * s + 3]); w.z = cvt_pk_bf16(x[8 * s + 4], x[8 * s + 5]); w.w = cvt_pk_bf16(x[8 * s + 6], x[8 * s + 7]);
    return __builtin_bit_cast(bf16x8, w); }
__device__ __forceinline__ void glds16(const void* g, LAS unsigned char* l) { __builtin_amdgcn_global_load_lds((const unsigned*)g, (LAS unsigned*)l, 16, 0, 0); }
__device__ __forceinline__ float max16(const f32x16& a) { float m = fmaxf(a[0], a[1]);
#pragma unroll
    for (int r = 2; r < 16; ++r) m = fmaxf(m, a[r]);
    return m; }

constexpr int PA_K = 0, PA_V = 49152, PA_KB = 12288, PA_VB = 8192;
__device__ __forceinline__ void attn_prompt_unit(const bf16_t* Qp, const bf16_t* Kp, const bf16_t* Vp, bf16_t* cat, int b, int h, int qb, LAS unsigned char* lds) {
    const int tid = pg8::opaque_tid(), lane = tid & 63, r32 = lane & 31, hi = lane >> 5; const int wid = __builtin_amdgcn_readfirstlane(tid >> 6);
    const size_t rowbase = (size_t)b * 2048; const int q0 = qb * 256, NT = 4 * qb + 4;
    const int qrow = q0 + wid * 32 + r32, qmin = q0 + wid * 32, qmax = qmin + 31;
    bf16x8 qf[6];
    const bf16_t* Qw = Qp + (rowbase + qrow) * 768 + h * 96 + hi * 8;
    const bf16_t* ksrc = Kp + (rowbase + lane) * 768 + h * 96;
    const bf16_t* vsrc = Vp + (rowbase + 16 * (wid & 3) + (lane >> 2)) * 512 + h * 64 + (wid >> 2) * 32 + (lane & 3) * 8;
#define PA_ISSUE(t, buf) do { const bf16_t* kt_ = ksrc + (size_t)(t) * 64 * 768; \
        glds16(kt_ + wid * 8, lds + PA_K + (buf) * PA_KB + wid * 1024); \
        if (wid < 4) glds16(kt_ + (8 + wid) * 8, lds + PA_K + (buf) * PA_KB + (8 + wid) * 1024); \
        glds16(vsrc + (size_t)(t) * 64 * 512, lds + PA_V + (buf) * PA_VB + wid * 1024); } while (0)
    f32x16 o0, o1;
#pragma unroll
    for (int r = 0; r < 16; ++r) { o0[r] = 0.f; o1[r] = 0.f; }
    float m_run = -INFINITY, l_run = 0.f;
    const int voff = (4 * hi + ((lane & 15) >> 2)) * 64 + ((lane >> 4) & 1) * 32 + (lane & 3) * 8;
    PA_ISSUE(0, 0); PA_ISSUE(1, 1); PA_ISSUE(2, 2);
    asm volatile("global_load_dwordx4 %0, %6, off\n\tglobal_load_dwordx4 %1, %6, off offset:32\n\tglobal_load_dwordx4 %2, %6, off offset:64\n\tglobal_load_dwordx4 %3, %6, off offset:96\n\t"
                 "global_load_dwordx4 %4, %6, off offset:128\n\tglobal_load_dwordx4 %5, %6, off offset:160\n\ts_waitcnt vmcnt(0)"
                 : "=&v"(qf[0]), "=&v"(qf[1]), "=&v"(qf[2]), "=&v"(qf[3]), "=&v"(qf[4]), "=&v"(qf[5]) : "v"(Qw) : "memory");
    __builtin_amdgcn_s_barrier(); asm volatile("" ::: "memory");
    for (int t = 0; t < NT; ++t) { const int buf = t & 3, kbase = t * 64;
        if (t + 3 < NT) PA_ISSUE(t + 3, (t + 3) & 3);
        if (kbase <= qmax) {
            LAS const unsigned char* kb = lds + PA_K + buf * PA_KB + hi * 1024 + r32 * 16;
            f32x16 s0, s1;
#pragma unroll
            for (int r = 0; r < 16; ++r) { s0[r] = 0.f; s1[r] = 0.f; }
#pragma unroll
            for (int d0 = 0; d0 < 6; ++d0) { const bf16x8 k0 = lds128(kb + d0 * 2048), k1 = lds128(kb + d0 * 2048 + 512); s0 = MFMA32(k0, qf[d0], s0); s1 = MFMA32(k1, qf[d0], s1); }
            if (kbase + 63 > qmin) {
#pragma unroll
                for (int r = 0; r < 16; ++r) { const int key = kbase + crow(r, hi); if (key > qrow) s0[r] = -INFINITY; if (key + 32 > qrow) s1[r] = -INFINITY; } }
            float mx = fmaxf(max16(s0), max16(s1)); mx = fmaxf(mx, __shfl_xor(mx, 32));
            const float m_new = fmaxf(m_run, mx), alpha = __builtin_amdgcn_exp2f(m_run - m_new); m_run = m_new;
            float ps = 0.f;
#pragma unroll
            for (int r = 0; r < 16; ++r) { s0[r] = __builtin_amdgcn_exp2f(s0[r] - m_new); s1[r] = __builtin_amdgcn_exp2f(s1[r] - m_new); ps += s0[r] + s1[r]; }
            l_run = l_run * alpha + ps;
            if (__any(alpha != 1.f)) {
#pragma unroll
                for (int r = 0; r < 16; ++r) { o0[r] *= alpha; o1[r] *= alpha; } }
            bf16x8 pf[4]; pf[0] = pack8(s0, 0); pf[1] = pack8(s0, 1); pf[2] = pack8(s1, 0); pf[3] = pack8(s1, 1);
            LAS const unsigned char* vb = lds + PA_V + buf * PA_VB + voff;
            s16x4 tv[16];
#define PA_TR(i, off) asm volatile("ds_read_b64_tr_b16 %0, %1 offset:%2" : "=v"(tv[i]) : "v"(vb), "i"(off))
#define PA_TRW(i) asm volatile("s_waitcnt lgkmcnt(0)" : "+v"(tv[i]), "+v"(tv[i + 1]), "+v"(tv[i + 2]), "+v"(tv[i + 3]), "+v"(tv[i + 4]), "+v"(tv[i + 5]), "+v"(tv[i + 6]), "+v"(tv[i + 7]))
            PA_TR(0, 0); PA_TR(1, 512); PA_TR(2, 4096); PA_TR(3, 4608); PA_TR(4, 1024); PA_TR(5, 1536); PA_TR(6, 5120); PA_TR(7, 5632);
            PA_TRW(0);
            PA_TR(8, 2048); PA_TR(9, 2560); PA_TR(10, 6144); PA_TR(11, 6656); PA_TR(12, 3072); PA_TR(13, 3584); PA_TR(14, 7168); PA_TR(15, 7680);
#pragma unroll
            for (int ks = 0; ks < 2; ++ks) { const bf16x8 va = __builtin_shufflevector(tv[4 * ks], tv[4 * ks + 1], 0, 1, 2, 3, 4, 5, 6, 7), vc = __builtin_shufflevector(tv[4 * ks + 2], tv[4 * ks + 3], 0, 1, 2, 3, 4, 5, 6, 7);
                o0 = MFMA32(va, pf[ks], o0); o1 = MFMA32(vc, pf[ks], o1); }
            PA_TRW(8);
#pragma unroll
            for (int ks = 2; ks < 4; ++ks) { const bf16x8 va = __builtin_shufflevector(tv[4 * ks], tv[4 * ks + 1], 0, 1, 2, 3, 4, 5, 6, 7), vc = __builtin_shufflevector(tv[4 * ks + 2], tv[4 * ks + 3], 0, 1, 2, 3, 4, 5, 6, 7);
                o0 = MFMA32(va, pf[ks], o0); o1 = MFMA32(vc, pf[ks], o1); }
#undef PA_TR
#undef PA_TRW
        }
        { const int rem = NT - 2 - t;
          if (wid < 4) { if (rem >= 2) asm volatile("s_waitcnt vmcnt(6)" ::: "memory"); else if (rem == 1) asm volatile("s_waitcnt vmcnt(3)" ::: "memory"); else asm volatile("s_waitcnt vmcnt(0)" ::: "memory"); }
          else { if (rem >= 2) asm volatile("s_waitcnt vmcnt(4)" ::: "memory"); else if (rem == 1) asm volatile("s_waitcnt vmcnt(2)" ::: "memory"); else asm volatile("s_waitcnt vmcnt(0)" ::: "memory"); } }
        __builtin_amdgcn_s_barrier(); asm volatile("" ::: "memory");
    }
#undef PA_ISSUE
    const float lt = l_run + __shfl_xor(l_run, 32), inv = 1.f / lt;
    bf16_t* orow = cat + (rowbase + qrow) * 1024 + h * 64 + 4 * hi;
#pragma unroll
    for (int g = 0; g < 4; ++g) { u32x2 w0, w1;
        w0.x = cvt_pk_bf16(o0[4 * g] * inv, o0[4 * g + 1] * inv); w0.y = cvt_pk_bf16(o0[4 * g + 2] * inv, o0[4 * g + 3] * inv);
        w1.x = cvt_pk_bf16(o1[4 * g] * inv, o1[4 * g + 1] * inv); w1.y = cvt_pk_bf16(o1[4 * g + 2] * inv, o1[4 * g + 3] * inv);
        *(u32x2*)(orow + 8 * g) = w0; *(u32x2*)(orow + 32 + 8 * g) = w1; }
}
__device__ __forceinline__ void phase_attn_prompt(const P& p, LAS unsigned char* lds) {
    const bf16_t* Qp = (const bf16_t*)(p.ws + W_QP); const bf16_t* Kp = (const bf16_t*)(p.ws + W_KP); const bf16_t* Vp = (const bf16_t*)(p.ws + W_VP); bf16_t* cat = (bf16_t*)(p.ws + W_CAT);
    for (int it = blockIdx.x; it < 256; it += gridDim.x) { const int x = it & 7, kk = it >> 3, bh = x + 8 * (kk >> 2), j = kk & 3;
        attn_prompt_unit(Qp, Kp, Vp, cat, bh >> 3, bh & 7, j, lds);
        attn_prompt_unit(Qp, Kp, Vp, cat, bh >> 3, bh & 7, 7 - j, lds); }
}
template <bool RES_BF16> struct EpiRes {
    static constexpr bool PERM = false, AFTER_DRAIN = false;
    const void* r0; const void* r1; bf16_t* Cb; float* ssq;
    struct RV { f32x4 f[4]; u32x2 h[4]; };
    __device__ __forceinline__ void ld(int row, int col0, f32x4 (&f)[4], u32x2 (&h)[4]) const {
        const size_t ro = (row < TP ? (size_t)row : (size_t)(row - TP)) * 1024 + col0; const void* rb = row < TP ? r0 : r1;
#pragma unroll
        for (int q = 0; q < 4; ++q) { if (RES_BF16) h[q] = *(const u32x2*)((const bf16_t*)rb + ro + (q >> 1) * 128 + (q & 1) * 16); else f[q] = *(const f32x4*)((const float*)rb + ro + (q >> 1) * 128 + (q & 1) * 16); }
    }
    __device__ __forceinline__ void operator()(const f32x4 (&acc)[2][2][4][2], const pg8::Unit& u, int wr, int wc, int fr, int fq) const {
        const int row0 = u.pm * 256 + wr * 64 + fr, col0 = u.pn * 256 + wc * 32 + 4 * fq;
        f32x4 rf[2][4]; u32x2 rh[2][4];
        ld(row0, col0, rf[0], rh[0]);
#pragma unroll
        for (int it = 0; it < 8; ++it) { const int ai = it >> 2, m = it & 3, row = row0 + ai * 128 + m * 16;
            if (it < 7) ld(row0 + ((it + 1) >> 2) * 128 + ((it + 1) & 3) * 16, col0, rf[(it + 1) & 1], rh[(it + 1) & 1]);
            bf16_t* cp = Cb + (size_t)row * 1024 + col0; float ss = 0.f;
#pragma unroll
            for (int q = 0; q < 4; ++q) { const int bj = q >> 1, n = q & 1; f32x4 rv;
                if (RES_BF16) { const u32x2 w = rh[it & 1][q]; rv = (f32x4){bflo(w.x), bfhi(w.x), bflo(w.y), bfhi(w.y)}; } else rv = rf[it & 1][q];
                const f32x4 v = acc[ai][bj][m][n] + rv; ss += v[0] * v[0] + v[1] * v[1] + v[2] * v[2] + v[3] * v[3];
                u32x2 w; w.x = cvt_pk_bf16(v[0], v[1]); w.y = cvt_pk_bf16(v[2], v[3]); *(u32x2*)(cp + bj * 128 + n * 16) = w; }
            ss += __shfl_xor(ss, 16); ss += __shfl_xor(ss, 32);
            if (fq == 0) ssq[(size_t)row * 16 + u.pn * 4 + wc] = ss;
            asm volatile("" ::: "memory"); }
    }
};
struct EpiUp {
    static constexpr bool PERM = true, AFTER_DRAIN = false;
    bf16_t* O; LAS const float* rsl;
    __device__ __forceinline__ void operator()(const f32x4 (&acc)[2][2][4][2], const pg8::Unit& u, int wr, int wc, int fr, int fq) const {
        const int row0 = u.pm * 256 + wr * 64 + fr, col0 = u.pn * 256 + wc * 32 + 8 * fq;
        float r2[8];
#pragma unroll
        for (int it = 0; it < 8; ++it) r2[it] = rsl[wr * 64 + fr + (it >> 2) * 128 + (it & 3) * 16];
#pragma unroll
        for (int ai = 0; ai < 2; ++ai)
#pragma unroll
            for (int m = 0; m < 4; ++m) { const int row = row0 + ai * 128 + m * 16; const float rs2 = r2[ai * 4 + m];
                bf16_t* rp = O + (size_t)row * 4096 + col0;
#pragma unroll
                for (int bj = 0; bj < 2; ++bj) { f32x4 v0 = acc[ai][bj][m][0], v1 = acc[ai][bj][m][1];
#pragma unroll
                    for (int j = 0; j < 4; ++j) { const float p0 = fmaxf(v0[j], 0.f), p1 = fmaxf(v1[j], 0.f); v0[j] = p0 * p0 * rs2; v1[j] = p1 * p1 * rs2; }
                    u32x4 w; w.x = cvt_pk_bf16(v0[0], v0[1]); w.y = cvt_pk_bf16(v0[2], v0[3]); w.z = cvt_pk_bf16(v1[0], v1[1]); w.w = cvt_pk_bf16(v1[2], v1[3]);
                    *(u32x4*)(rp + bj * 128) = w; }
                asm volatile("" ::: "memory"); }
    }
};
struct OneUnit { int pm, pn; bool has;
    __device__ __forceinline__ bool next(int i, pg8::Unit& u) const { if (i > 0 || !has) return false; u.pm = pm; u.pn = pn; return true; }
    __device__ __forceinline__ void a_ready(const pg8::Unit&) const {}
    __device__ __forceinline__ void done(const pg8::Unit&) const {} };
struct EpiSlab {
    static constexpr bool PERM = false, AFTER_DRAIN = false; float* C;
    __device__ __forceinline__ void operator()(const f32x4 (&acc)[2][2][4][2], const pg8::Unit& u, int wr, int wc, int fr, int fq) const {
        float* base = C + (size_t)(u.pm * 256 + wr * 64 + fr) * 1024 + u.pn * 256 + wc * 32 + 4 * fq;
#pragma unroll
        for (int ai = 0; ai < 2; ++ai)
#pragma unroll
            for (int m = 0; m < 4; ++m) { float* rp = base + (size_t)(ai * 128 + m * 16) * 1024;
#pragma unroll
                for (int bj = 0; bj < 2; ++bj)
#pragma unroll
                    for (int n = 0; n < 2; ++n) *(f32x4*)(rp + bj * 128 + n * 16) = acc[ai][bj][m][n];
                asm volatile("" ::: "memory"); }
    }
};
constexpr int NSLAB = 4;
__device__ __forceinline__ void phase_final(const P& p) {
    const int tid = pg8::opaque_tid(), lane = tid & 63, wid = tid >> 6, G = gridDim.x;
    const bf16_t* x2 = (const bf16_t*)(p.ws + W_X2B); const float* ssq = (const float*)(p.ws + W_SSQ2); const bf16_t* x1 = (const bf16_t*)(p.ws + W_X1B); const float* slab = (const float*)(p.ws + W_SLAB);
    float4 g[4];
#pragma unroll
    for (int i = 0; i < 4; ++i) g[i] = *(const float4*)(p.norm_final + i * 256 + lane * 4);
    if (!(wid & 1)) { const int s = blockIdx.x * 4 + (wid >> 1);
        if (s < TS) { f32x4 v[4]; float ss = 0.f;
#pragma unroll
            for (int i = 0; i < 4; ++i) { const u32x2 w = *(const u32x2*)(x1 + (size_t)(TP + s) * 1024 + i * 256 + lane * 4); v[i] = (f32x4){bflo(w.x), bfhi(w.x), bflo(w.y), bfhi(w.y)}; }
#pragma unroll
            for (int sl = 0; sl < NSLAB; ++sl)
#pragma unroll
                for (int i = 0; i < 4; ++i) v[i] += *(const f32x4*)(slab + ((size_t)sl * 1024 + s) * 1024 + i * 256 + lane * 4);
#pragma unroll
            for (int i = 0; i < 4; ++i) ss += v[i][0] * v[i][0] + v[i][1] * v[i][1] + v[i][2] * v[i][2] + v[i][3] * v[i][3];
            ss = wave_sum(ss); const float rs = rsqrtf(ss * (1.f / 1024.f) + 1e-6f); float* o = p.out + O_Y_S + (size_t)s * 1024;
#pragma unroll
            for (int i = 0; i < 4; ++i) *(float4*)(o + i * 256 + lane * 4) = make_float4(v[i][0] * rs * g[i].x, v[i][1] * rs * g[i].y, v[i][2] * rs * g[i].z, v[i][3] * rs * g[i].w); } }
    for (int t4 = (blockIdx.x * 8 + wid) * 4; t4 < TP; t4 += G * 32) {
        u32x2 w[4][4]; float sq[4];
#pragma unroll
        for (int q = 0; q < 4; ++q) { sq[q] = ssq[(size_t)(t4 + q) * 16 + (lane & 15)];
#pragma unroll
            for (int i = 0; i < 4; ++i) w[q][i] = *(const u32x2*)(x2 + (size_t)(t4 + q) * 1024 + i * 256 + lane * 4); }
#pragma unroll
        for (int o = 1; o < 16; o <<= 1) {
#pragma unroll
            for (int q = 0; q < 4; ++q) sq[q] += __shfl_xor(sq[q], o); }
#pragma unroll
        for (int q = 0; q < 4; ++q) { const float rs = rsqrtf(sq[q] * (1.f / 1024.f) + 1e-6f); float* o = p.out + O_Y_P + (size_t)(t4 + q) * 1024;
#pragma unroll
            for (int i = 0; i < 4; ++i) *(float4*)(o + i * 256 + lane * 4) = make_float4(bflo(w[q][i].x) * rs * g[i].x, bfhi(w[q][i].x) * rs * g[i].y, bflo(w[q][i].y) * rs * g[i].z, bfhi(w[q][i].y) * rs * g[i].w); } }
}

__device__ __forceinline__ void phase_ssd_sample(const P& p, LAS unsigned char* lds) {
    const int tid = pg8::opaque_tid(), row = tid >> 1, nh = tid & 1, hh = row >> 6, pp = row & 63, wid = tid >> 6;
    const float* xsf = (const float*)(p.ws + W_XSF); const float* dtf = (const float*)(p.ws + W_DTF); const bf16_t* Bc = (const bf16_t*)(p.ws + W_BC); const bf16_t* Cc = (const bf16_t*)(p.ws + W_CC);
    const bf16_t* projp = (const bf16_t*)(p.ws + W_PROJ); bf16_t* cat = (bf16_t*)(p.ws + W_CAT);
    LAS float* Bl = (LAS float*)lds; LAS float* Cl = Bl + 1024; LAS float* red = Cl + 1024; LAS float* gl = red + 64;
    for (int it = blockIdx.x; it < 256; it += gridDim.x) { const int b = it >> 1, g = it & 1, h = g * 4 + hh; const size_t tb = (size_t)TP + b * 8;
        const float A = -__expf(p.a_log[h]), D = p.d_skip[h], gn = p.ssm_norm[h * 64 + pp];
        const size_t sidx = (((size_t)b * 8 + h) * 64 + pp) * 128 + nh * 64;
        __syncthreads();
        float hs[64];
#pragma unroll
        for (int j = 0; j < 16; ++j) { const float4 v = *(const float4*)(p.st_ssm + sidx + 4 * j); hs[4 * j] = v.x; hs[4 * j + 1] = v.y; hs[4 * j + 2] = v.z; hs[4 * j + 3] = v.w; }
        float dtc = dtf[tb * 8 + h], xc = xsf[tb * 512 + h * 64 + pp], zc = bf2f(projp[tb * 2304 + 768 + h * 64 + pp]);
        if (tid < 256) { const int c = tid & 127, tok = c >> 4, chk = c & 15; const bf16_t* src = (tid < 128 ? Bc : Cc) + (tb + tok) * 256 + g * 128 + 8 * chk; const u32x4 w = *(const u32x4*)src;
            LAS float* d = (tid < 128 ? Bl : Cl) + tok * 128 + 8 * chk;
            *(LAS f32x4*)d = (f32x4){bflo(w.x), bfhi(w.x), bflo(w.y), bfhi(w.y)}; *(LAS f32x4*)(d + 4) = (f32x4){bflo(w.z), bfhi(w.z), bflo(w.w), bfhi(w.w)}; }
        __syncthreads();
#pragma unroll 1
        for (int l = 0; l < 8; ++l) { const int ln = l < 7 ? l + 1 : 7;
            const float dtn = dtf[(tb + ln) * 8 + h], xn = xsf[(tb + ln) * 512 + h * 64 + pp], zn = bf2f(projp[(tb + ln) * 2304 + 768 + h * 64 + pp]);
            const float da = __expf(dtc * A), cf = dtc * xc; float yp = 0.f; LAS const float* bp = Bl + l * 128 + nh * 64; LAS const float* cp = Cl + l * 128 + nh * 64;
#pragma unroll
            for (int j = 0; j < 16; ++j) { const f32x4 bv = *(LAS const f32x4*)(bp + 4 * j), cv = *(LAS const f32x4*)(cp + 4 * j);
#pragma unroll
                for (int e = 0; e < 4; ++e) { hs[4 * j + e] = da * hs[4 * j + e] + cf * bv[e]; yp += cv[e] * hs[4 * j + e]; } }
            const float y = yp + __shfl_xor(yp, 1) + D * xc; gl[l * 512 + tid] = y * silu(zc);
            dtc = dtn; xc = xn; zc = zn; }
        float gv[8];
        { float ss[8];
#pragma unroll
          for (int l = 0; l < 8; ++l) { gv[l] = gl[l * 512 + tid]; ss[l] = nh == 0 ? gv[l] * gv[l] : 0.f; }
#pragma unroll
          for (int o = 32; o; o >>= 1) {
#pragma unroll
              for (int l = 0; l < 8; ++l) ss[l] += __shfl_xor(ss[l], o); }
          if ((tid & 63) < 8) { float v = ss[0];
#pragma unroll
              for (int l = 1; l < 8; ++l) v = ((tid & 63) == l) ? ss[l] : v;
              red[wid * 8 + (tid & 63)] = v; } }
        __syncthreads();
        if (nh == 0) {
#pragma unroll
            for (int l = 0; l < 8; ++l) { float tot = 0.f;
#pragma unroll
                for (int w = 0; w < 8; ++w) tot += red[w * 8 + l];
                cat[(tb + l) * 1024 + 512 + h * 64 + pp] = f2bf(gv[l] * rsqrtf(tot * (1.f / 256.f) + 1e-6f) * gn); } }
        float* so = p.out + O_SSM_S + sidx;
#pragma unroll
        for (int j = 0; j < 16; ++j) *(float4*)(so + 4 * j) = make_float4(hs[4 * j], hs[4 * j + 1], hs[4 * j + 2], hs[4 * j + 3]);
    }
}
constexpr int SS_CS = 0, SS_DT = 4096, SS_XW = 8192, SS_B1 = 8192 + 32768;
constexpr int SS_H = 8192, SS_BT = 8192 + 32768, SS_XD = SS_BT + 16384;
__device__ __forceinline__ unsigned off_b(unsigned row, unsigned ch) { return 256u * row + 16u * (ch ^ (((row & 3) << 2) | ((row >> 2) & 3))); }
__device__ __forceinline__ bf16x8 trpair(LAS const unsigned char* p) { const s16x4 a = tr_read(p), b = tr_read(p + 512); return __builtin_shufflevector(a, b, 0, 1, 2, 3, 4, 5, 6, 7); }
__device__ __forceinline__ void ssd_cumsum(const P& p, int t0, int g, int wid, int lane, LAS unsigned char* lds) {
    if (wid < 4) { const int h = g * 4 + wid; const float A2 = -__expf(p.a_log[h]) * 1.4426950408889634f; const float* dtf = (const float*)(p.ws + W_DTF);
        float d[4], s[4];
#pragma unroll
        for (int j = 0; j < 4; ++j) d[j] = dtf[(size_t)(t0 + 4 * lane + j) * 8 + h];
        s[0] = d[0] * A2; s[1] = s[0] + d[1] * A2; s[2] = s[1] + d[2] * A2; s[3] = s[2] + d[3] * A2;
        float incl = s[3];
#pragma unroll
        for (int o = 1; o < 64; o <<= 1) { const float v = __shfl_up(incl, o); if (lane >= o) incl += v; }
        const float ex = incl - s[3];
        *(LAS f32x4*)(lds + SS_CS + wid * 1024 + lane * 16) = (f32x4){ex + s[0], ex + s[1], ex + s[2], ex + s[3]};
        *(LAS f32x4*)(lds + SS_DT + wid * 1024 + lane * 16) = (f32x4){d[0], d[1], d[2], d[3]}; }
}
__device__ __forceinline__ void phase_ssd_pass1(const P& p, LAS unsigned char* lds) {
    const int tid = pg8::opaque_tid(), lane = tid & 63, r32 = lane & 31, hi = lane >> 5; const int wid = __builtin_amdgcn_readfirstlane(tid >> 6);
    const float* xsf = (const float*)(p.ws + W_XSF); const bf16_t* Bc = (const bf16_t*)(p.ws + W_BC); float* states = (float*)(p.ws + W_STATES); float* chdec = (float*)(p.ws + W_CHDEC);
    const int voff = (4 * hi + ((lane & 15) >> 2)) * 64 + ((lane >> 4) & 1) * 32 + (lane & 3) * 8;
    LAS const float* cs = (LAS const float*)(lds + SS_CS); LAS const float* dtl = (LAS const float*)(lds + SS_DT);
    for (int it = blockIdx.x; it < 128; it += gridDim.x) { const int b = it >> 4, g = (it >> 3) & 1, c = it & 7, t0 = b * 2048 + c * 256;
        __syncthreads();
        ssd_cumsum(p, t0, g, wid, lane, lds);
        __syncthreads();
        if (tid < 4) chdec[(b * 8 + g * 4 + tid) * 8 + c] = cs[tid * 256 + 255];
        f32x16 acc[4];
#pragma unroll
        for (int nb = 0; nb < 4; ++nb)
#pragma unroll
            for (int r = 0; r < 16; ++r) acc[nb][r] = 0.f;
        for (int ls = 0; ls < 4; ++ls) {
            __syncthreads();
#pragma unroll
            for (int i = 0; i < 8; ++i) { const int f = tid + 512 * i, l = f >> 6, c4 = f & 63, hl = c4 >> 4;
                const float4 v = *(const float4*)(xsf + (size_t)(t0 + 64 * ls + l) * 512 + g * 256 + 4 * c4);
                const float w = __builtin_amdgcn_exp2f(cs[hl * 256 + 255] - cs[hl * 256 + 64 * ls + l]) * dtl[hl * 256 + 64 * ls + l];
                u32x2 o; o.x = cvt_pk_bf16(v.x * w, v.y * w); o.y = cvt_pk_bf16(v.z * w, v.w * w);
                *(LAS u32x2*)(lds + SS_XW + (c4 >> 3) * 4096 + l * 64 + (c4 & 7) * 8) = o; }
#pragma unroll
            for (int i = 0; i < 2; ++i) { const int q = tid + 512 * i, l = q >> 4, ch = q & 15;
                const u32x4 v = *(const u32x4*)(Bc + (size_t)(t0 + 64 * ls + l) * 256 + g * 128 + 8 * ch);
                *(LAS u32x4*)(lds + SS_B1 + (ch >> 2) * 4096 + l * 64 + (ch & 3) * 16) = v; }
            __syncthreads();
#pragma unroll
            for (int ks = 0; ks < 4; ++ks) { const bf16x8 a = trpair(lds + SS_XW + wid * 4096 + voff + ks * 1024);
#pragma unroll
                for (int nb = 0; nb < 4; ++nb) { const bf16x8 bb = trpair(lds + SS_B1 + nb * 4096 + voff + ks * 1024); acc[nb] = MFMA32(a, bb, acc[nb]); } }
        }
        float* so = states + ((size_t)((b * 8 + g * 4 + (wid >> 1)) * 8 + c)) * 8192;
#pragma unroll
        for (int nb = 0; nb < 4; ++nb)
#pragma unroll
            for (int r = 0; r < 16; ++r) so[(32 * (wid & 1) + crow(r, hi)) * 128 + 32 * nb + r32] = acc[nb][r];
    }
}
__device__ __forceinline__ void phase_ssd_scan(const P& p) {
    const int gt = (int)blockIdx.x * 512 + pg8::opaque_tid(); if (gt >= 131072) return;
    const int bh = gt >> 11, rem = gt & 2047, pp = rem >> 5, n4 = rem & 31;
    const float* sb = (const float*)(p.ws + W_STATES) + (size_t)bh * 8 * 8192 + pp * 128 + 4 * n4; const float* cd = (const float*)(p.ws + W_CHDEC) + bh * 8;
    bf16_t* hp = (bf16_t*)(p.ws + W_HPREV) + (size_t)bh * 8 * 8192 + pp * 128 + 4 * n4;
    f32x4 v[8];
#pragma unroll
    for (int c = 0; c < 8; ++c) v[c] = *(const f32x4*)(sb + (size_t)c * 8192);
    f32x4 H = (f32x4){0.f, 0.f, 0.f, 0.f};
#pragma unroll
    for (int c = 0; c < 8; ++c) { u32x2 o; o.x = cvt_pk_bf16(H[0], H[1]); o.y = cvt_pk_bf16(H[2], H[3]); *(u32x2*)(hp + (size_t)c * 8192) = o; H = H * __builtin_amdgcn_exp2f(cd[c]) + v[c]; }
    *(f32x4*)(p.out + O_SSM_P + ((size_t)bh * 64 + pp) * 128 + 4 * n4) = H;
}
constexpr int S2_B = 8192, S2_H = 8192 + 65536, S2_XD = S2_H + 16384;
__device__ __forceinline__ void phase_ssd_pass2(const P& p, LAS unsigned char* lds) {
    const int tid = pg8::opaque_tid(), lane = tid & 63, r32 = lane & 31, hi = lane >> 5; const int wid = __builtin_amdgcn_readfirstlane(tid >> 6);
    const float* xsf = (const float*)(p.ws + W_XSF); const bf16_t* Bc = (const bf16_t*)(p.ws + W_BC); const bf16_t* Cc = (const bf16_t*)(p.ws + W_CC);
    const bf16_t* projp = (const bf16_t*)(p.ws + W_PROJ); bf16_t* cat = (bf16_t*)(p.ws + W_CAT); float* yraw = (float*)(p.ws + W_YRAW);
    const int voff = (4 * hi + ((lane & 15) >> 2)) * 64 + ((lane >> 4) & 1) * 32 + (lane & 3) * 8;
    LAS const float* cs = (LAS const float*)(lds + SS_CS); LAS const float* dtl = (LAS const float*)(lds + SS_DT);
    for (int it = (int)blockIdx.x - 128; it >= 0 && it < 128; it += 128) { const int b = it >> 4, g = (it >> 3) & 1, c = it & 7, t0 = b * 2048 + c * 256;
        const int ll = 32 * wid + r32; const size_t tl = (size_t)t0 + ll;
        __syncthreads();
        ssd_cumsum(p, t0, g, wid, lane, lds);
#pragma unroll
        for (int i = 0; i < 8; ++i) { const int q = tid + 512 * i, s = q >> 4, ch = q & 15;
            const u32x4 v = *(const u32x4*)(Bc + (size_t)(t0 + s) * 256 + g * 128 + 8 * ch);
            *(LAS u32x4*)(lds + S2_B + (s >> 6) * 16384 + off_b(s & 63, ch)) = v; }
        bf16x8 Cf[8];
#pragma unroll
        for (int ks = 0; ks < 8; ++ks) Cf[ks] = *(const bf16x8*)(Cc + tl * 256 + g * 128 + 16 * ks + 8 * hi);
        float4 xq[8]; u32x4 hq[2];
#define S2_FETCH(hh) do { const int h_ = g * 4 + (hh); \
            _Pragma("unroll") for (int i_ = 0; i_ < 8; ++i_) { const int f_ = tid + 512 * i_; xq[i_] = *(const float4*)(xsf + (size_t)(t0 + (f_ >> 4)) * 512 + h_ * 64 + 4 * (f_ & 15)); } \
            if (c > 0) { const bf16_t* hs_ = (const bf16_t*)(p.ws + W_HPREV) + ((size_t)(b * 8 + h_) * 8 + c) * 8192; \
                _Pragma("unroll") for (int i_ = 0; i_ < 2; ++i_) { const int q_ = tid + 512 * i_; hq[i_] = *(const u32x4*)(hs_ + (q_ >> 4) * 128 + 8 * (q_ & 15)); } } } while (0)
        S2_FETCH(0);
        for (int hd = 0; hd < 4; ++hd) { const int h = g * 4 + hd;
            __syncthreads();
            if (c > 0) {
#pragma unroll
                for (int i = 0; i < 2; ++i) { const int q = tid + 512 * i, pp = q >> 4, ch = q & 15; *(LAS u32x4*)(lds + S2_H + off_b(pp, ch)) = hq[i]; } }
#pragma unroll
            for (int i = 0; i < 8; ++i) { const int f = tid + 512 * i, s = f >> 4, c4 = f & 15;
                const float4 v = xq[i]; const float w = dtl[hd * 256 + s];
                u32x2 o; o.x = cvt_pk_bf16(v.x * w, v.y * w); o.y = cvt_pk_bf16(v.z * w, v.w * w);
                *(LAS u32x2*)(lds + S2_XD + (s >> 6) * 8192 + (c4 >> 3) * 4096 + (s & 63) * 64 + (c4 & 7) * 8) = o; }
            if (hd < 3) S2_FETCH(hd + 1);
            f32x16 acc[2];
#pragma unroll
            for (int q = 0; q < 2; ++q)
#pragma unroll
                for (int r = 0; r < 16; ++r) acc[q][r] = 0.f;
            __syncthreads();
            if (c > 0) {
#pragma unroll
                for (int pb = 0; pb < 2; ++pb)
#pragma unroll
                    for (int ks = 0; ks < 8; ++ks) { const bf16x8 a = lds128(lds + S2_H + off_b(32 * pb + r32, 2 * ks + hi)); acc[pb] = MFMA32(a, Cf[ks], acc[pb]); }
                const float e = __builtin_amdgcn_exp2f(cs[hd * 256 + ll]);
#pragma unroll
                for (int r = 0; r < 16; ++r) { acc[0][r] *= e; acc[1][r] *= e; } }
            LAS const float* ch = cs + hd * 256; const float cl = ch[ll];
            for (int kt = 0; kt <= (wid >> 1); ++kt) {
                f32x16 s0, s1;
#pragma unroll
                for (int r = 0; r < 16; ++r) { s0[r] = 0.f; s1[r] = 0.f; }
                LAS const unsigned char* bt = lds + S2_B + kt * 16384;
#pragma unroll
                for (int ks = 0; ks < 8; ++ks) { const bf16x8 a0 = lds128(bt + off_b(r32, 2 * ks + hi)), a1 = lds128(bt + off_b(32 + r32, 2 * ks + hi));
                    s0 = MFMA32(a0, Cf[ks], s0); s1 = MFMA32(a1, Cf[ks], s1); }
#pragma unroll
                for (int g4 = 0; g4 < 4; ++g4) { const int sb = 64 * kt + 8 * g4 + 4 * hi; const f32x4 ca = *(LAS const f32x4*)(ch + sb), cb2 = *(LAS const f32x4*)(ch + sb + 32);
#pragma unroll
                    for (int j = 0; j < 4; ++j) { const int r = 4 * g4 + j;
                        s0[r] = (sb + j <= ll) ? s0[r] * __builtin_amdgcn_exp2f(cl - ca[j]) : 0.f;
                        s1[r] = (sb + 32 + j <= ll) ? s1[r] * __builtin_amdgcn_exp2f(cl - cb2[j]) : 0.f; } }
                bf16x8 pf[4]; pf[0] = pack8(s0, 0); pf[1] = pack8(s0, 1); pf[2] = pack8(s1, 0); pf[3] = pack8(s1, 1);
#pragma unroll
                for (int pb = 0; pb < 2; ++pb)
#pragma unroll
                    for (int ks = 0; ks < 4; ++ks) { const bf16x8 a = trpair(lds + S2_XD + kt * 8192 + pb * 4096 + voff + ks * 1024); acc[pb] = MFMA32(a, pf[ks], acc[pb]); }
            }
            __syncthreads();
            { LAS float* ex = (LAS float*)(lds + S2_XD) + wid * 1152;
              int lt8 = lane >> 3; asm volatile("" : "+v"(lt8));
#pragma unroll
                for (int pb = 0; pb < 2; ++pb) {
#pragma unroll
                    for (int g4 = 0; g4 < 4; ++g4) *(LAS f32x4*)(ex + r32 * 36 + 8 * g4 + 4 * hi) = (f32x4){acc[pb][4 * g4], acc[pb][4 * g4 + 1], acc[pb][4 * g4 + 2], acc[pb][4 * g4 + 3]};
#pragma unroll
                    for (int i = 0; i < 4; ++i) { const int tok = 8 * i + lt8, pc = lane & 7; const size_t tg = (size_t)t0 + 32 * wid + tok;
                        *(f32x4*)(yraw + tg * 512 + h * 64 + 32 * pb + 4 * pc) = *(LAS const f32x4*)(ex + tok * 36 + 4 * pc); } } }
        }
#undef S2_FETCH
        asm volatile("s_waitcnt vmcnt(0)" ::: "memory"); __syncthreads();
        { const int ch = g * 256 + 4 * lane; const float D = p.d_skip[g * 4 + (lane >> 4)]; const float4 gn = *(const float4*)(p.ssm_norm + ch);
          for (int i = 0; i < 4; ++i) { f32x4 yv[8]; float4 xv[8]; u32x2 zr[8]; float gg[8][4], ss[8];
#pragma unroll
              for (int q = 0; q < 8; ++q) { const size_t tg = (size_t)t0 + 32 * wid + 8 * i + q; yv[q] = *(const f32x4*)(yraw + tg * 512 + ch); xv[q] = *(const float4*)(xsf + tg * 512 + ch); zr[q] = *(const u32x2*)(projp + tg * 2304 + 768 + ch); }
#pragma unroll
              for (int q = 0; q < 8; ++q) { gg[q][0] = (yv[q][0] + D * xv[q].x) * silu(bflo(zr[q].x)); gg[q][1] = (yv[q][1] + D * xv[q].y) * silu(bfhi(zr[q].x)); gg[q][2] = (yv[q][2] + D * xv[q].z) * silu(bflo(zr[q].y)); gg[q][3] = (yv[q][3] + D * xv[q].w) * silu(bfhi(zr[q].y));
                  ss[q] = gg[q][0] * gg[q][0] + gg[q][1] * gg[q][1] + gg[q][2] * gg[q][2] + gg[q][3] * gg[q][3]; }
#pragma unroll
              for (int o = 32; o; o >>= 1) {
#pragma unroll
                  for (int q = 0; q < 8; ++q) ss[q] += __shfl_xor(ss[q], o); }
#pragma unroll
              for (int q = 0; q < 8; ++q) { const size_t tg = (size_t)t0 + 32 * wid + 8 * i + q; const float rs = rsqrtf(ss[q] * (1.f / 256.f) + 1e-6f);
                  u32x2 o; o.x = cvt_pk_bf16(gg[q][0] * rs * gn.x, gg[q][1] * rs * gn.y); o.y = cvt_pk_bf16(gg[q][2] * rs * gn.z, gg[q][3] * rs * gn.w); *(u32x2*)(cat + tg * 1024 + 512 + ch) = o; } } }
    }
}
constexpr int SA_Q = 0, SA_T = 36864, SA_TB = 36864, SA_ROPE = 32768, SA_NP0 = 32;
__device__ __forceinline__ void attn_sample_item(const P& p, int b, int split, LAS unsigned char* lds) {
    const int tid = pg8::opaque_tid(), lane = tid & 63, r32 = lane & 31, hi = lane >> 5; const int wid = __builtin_amdgcn_readfirstlane(tid >> 6);
    const bool loader = wid >= 4; const int qb = wid & 1, kb = (wid >> 1) & 1, ltid = tid & 255;
    const bf16_t* Qs = (const bf16_t*)(p.ws + W_QS);
    __syncthreads();
    for (int idx = tid; idx < 2304; idx += 512) { const int qrow = idx / 36, ch = idx % 36;
        *(LAS u32x4*)(lds + SA_Q + ch * 1024 + qrow * 16) = *(const u32x4*)(Qs + (size_t)(b * 64 + qrow) * 288 + 8 * ch); }
    const int pg0 = split ? SA_NP0 : 0, nreal = 2 * (split ? 64 - SA_NP0 : SA_NP0), ntiles = nreal + (split ? 1 : 0);
    const int lw4 = ltid >> 6, ld4 = ltid & 63, lch = (ld4 & 31) >> 1, lbase = (ld4 >> 5) * 16384 + 256 * lw4 + 8 * (ld4 & 1), lrope = SA_ROPE + ((ltid & 7) >> 1) * 1024 + (ltid >> 3) * 16 + (ltid & 1) * 8;
#define SA_LOAD(st, t) do { const int pg_ = p.pt[b * 64 + pg0 + ((t) >> 1)]; const float* kv_ = p.ckv + ((size_t)pg_ * 128 + ((t) & 1) * 64) * 256; const float* kr_ = p.ckr + ((size_t)pg_ * 128 + ((t) & 1) * 64) * 32; \
        _Pragma("unroll") for (int i_ = 0; i_ < 16; ++i_) st[i_] = __builtin_nontemporal_load((const f32x4*)(kv_ + (size_t)(ltid + 256 * i_) * 4)); \
        st[16] = __builtin_nontemporal_load((const f32x4*)(kr_ + (size_t)ltid * 4)); st[17] = __builtin_nontemporal_load((const f32x4*)(kr_ + (size_t)(ltid + 256) * 4)); } while (0)
#define SA_WRITE(st, buf) do { LAS unsigned char* tb_ = lds + SA_T + (buf) * SA_TB; int lb_ = lbase, lc_ = lch; asm volatile("" : "+v"(lb_), "+v"(lc_)); \
        _Pragma("unroll") for (int i_ = 0; i_ < 16; ++i_) { u32x2 o_; o_.x = cvt_pk_bf16(st[i_][0], st[i_][1]); o_.y = cvt_pk_bf16(st[i_][2], st[i_][3]); \
            *(LAS u32x2*)(tb_ + lb_ + 1024 * i_ + 16 * (lc_ ^ ((lw4 << 2) | (i_ & 3)))) = o_; } \
        _Pragma("unroll") for (int j_ = 0; j_ < 2; ++j_) { u32x2 o_; o_.x = cvt_pk_bf16(st[16 + j_][0], st[16 + j_][1]); o_.y = cvt_pk_bf16(st[16 + j_][2], st[16 + j_][3]); *(LAS u32x2*)(tb_ + lrope + 512 * j_) = o_; } } while (0)
#define SA_STAGE_NEW(buf) do { LAS unsigned char* tn_ = lds + SA_T + (buf) * SA_TB;     \
        { const int key_ = ltid >> 5, c32_ = ltid & 31; *(LAS u32x4*)(tn_ + (c32_ >> 4) * 16384 + off_b(key_, c32_ & 15)) = *(const u32x4*)((const bf16_t*)(p.ws + W_CB) + (size_t)(TP + b * 8 + key_) * 256 + 8 * c32_); } \
        if (ltid < 32) { const int key_ = ltid >> 2, pc_ = ltid & 3; *(LAS u32x4*)(tn_ + SA_ROPE + pc_ * 1024 + key_ * 16) = *(const u32x4*)((const bf16_t*)(p.ws + W_KRS) + (size_t)(b * 8 + key_) * 32 + 8 * pc_); } } while (0)
    const int q4 = (lane & 15) >> 2, p4 = lane & 3, blk = (lane >> 4) & 1, lq = 4 * qb + (r32 >> 3);
    const int kxor = ((r32 & 3) << 2) | ((r32 >> 2) & 3), krow = 256 * (32 * kb + r32), txl = (q4 << 2) | hi, trow = 256 * (32 * kb + 4 * hi + q4) + 8 * (p4 & 1);
#define SA_COMPUTE(t, buf) do { LAS const unsigned char* tb = lds + SA_T + (buf) * SA_TB; int kx_ = kxor, txl_ = txl, txh_ = txl + 2, krow_ = krow, trow_ = trow; asm volatile("" : "+v"(kx_), "+v"(txl_), "+v"(txh_), "+v"(krow_), "+v"(trow_)); \
        f32x16 s; \
        _Pragma("unroll") for (int r = 0; r < 16; ++r) s[r] = 0.f; \
        _Pragma("unroll") for (int ks = 0; ks < 16; ++ks) { const bf16x8 a = lds128(tb + (ks >> 3) * 16384 + krow_ + 16 * ((2 * (ks & 7) + hi) ^ kx_)), bq = lds128(lds + SA_Q + (2 * ks + hi) * 1024 + (32 * qb + r32) * 16); s = MFMA32(a, bq, s); if ((ks & 3) == 3) __builtin_amdgcn_sched_barrier(0); } \
        _Pragma("unroll") for (int ks = 16; ks < 18; ++ks) { const bf16x8 a = lds128(tb + SA_ROPE + (2 * (ks - 16) + hi) * 1024 + (32 * kb + r32) * 16), bq = lds128(lds + SA_Q + (2 * ks + hi) * 1024 + (32 * qb + r32) * 16); s = MFMA32(a, bq, s); } \
        if ((t) == nreal) { _Pragma("unroll") for (int r = 0; r < 16; ++r) { const int key = 32 * kb + crow(r, hi); if (key >= 8 || key > lq) s[r] = -INFINITY; } } \
        float mx = max16(s); mx = fmaxf(mx, __shfl_xor(mx, 32)); \
        const float m_new = fmaxf(m_run, mx), alpha = __builtin_amdgcn_exp2f(m_run - m_new); m_run = m_new; \
        float ps = 0.f; \
        _Pragma("unroll") for (int r = 0; r < 16; ++r) { s[r] = __builtin_amdgcn_exp2f(s[r] - m_new); ps += s[r]; } \
        l_run = l_run * alpha + ps; \
        if (__any(alpha != 1.f)) { _Pragma("unroll") for (int d = 0; d < 8; ++d) _Pragma("unroll") for (int r = 0; r < 16; ++r) o[d][r] *= alpha; } \
        bf16x8 pf[2]; pf[0] = pack8(s, 0); pf[1] = pack8(s, 1); \
        _Pragma("unroll") for (int sx = 0; sx < 2; ++sx) _Pragma("unroll") for (int db = 0; db < 8; ++db) { const int ch = 4 * (db & 3) + 2 * blk + (p4 >> 1); \
                const s16x4 lo = tr_read(tb + (db >> 2) * 16384 + trow_ + 4096 * sx + 16 * (ch ^ txl_)), hh = tr_read(tb + (db >> 2) * 16384 + trow_ + 4096 * sx + 2048 + 16 * (ch ^ txh_)); \
                const bf16x8 a = __builtin_shufflevector(lo, hh, 0, 1, 2, 3, 4, 5, 6, 7); o[db] = MFMA32(a, pf[sx], o[db]); if ((db & 3) == 3) __builtin_amdgcn_sched_barrier(0); } } while (0)
    if (loader) {
        f32x4 stA[18], stB[18];
        SA_LOAD(stA, 0); SA_LOAD(stB, 1); SA_WRITE(stA, 0);
        __syncthreads();
        for (int t = 0; t < ntiles; t += 2) {
            if (t + 2 < nreal) SA_LOAD(stA, t + 2);
            if (t + 1 < nreal) SA_WRITE(stB, 1); else if (t + 1 < ntiles) SA_STAGE_NEW(1);
            __syncthreads();
            if (t + 1 >= ntiles) break;
            if (t + 3 < nreal) SA_LOAD(stB, t + 3);
            if (t + 2 < nreal) SA_WRITE(stA, 0); else if (t + 2 < ntiles) SA_STAGE_NEW(0);
            __syncthreads(); }
        __syncthreads();
    } else {
    f32x16 o[8];
#pragma unroll
    for (int d = 0; d < 8; ++d)
#pragma unroll
        for (int r = 0; r < 16; ++r) o[d][r] = 0.f;
    float m_run = -INFINITY, l_run = 0.f;
        __syncthreads();
        for (int t = 0; t < ntiles; t += 2) {
            SA_COMPUTE(t, 0);
            __syncthreads();
            if (t + 1 >= ntiles) break;
            SA_COMPUTE(t + 1, 1);
            __syncthreads(); }
        const float l_tot = l_run + __shfl_xor(l_run, 32);
        LAS float* xo = (LAS float*)(lds + SA_T) + qb * 8192; LAS float* xs = (LAS float*)(lds + SA_T + 65536) + qb * 128;
        if (kb == 1) {
#pragma unroll
            for (int d = 0; d < 8; ++d)
#pragma unroll
                for (int r = 0; r < 16; ++r) xo[(d * 16 + r) * 64 + lane] = o[d][r];
            xs[lane] = m_run; xs[64 + lane] = l_tot; }
        __syncthreads();
        if (kb == 0) { const float m1 = xs[lane], l1 = xs[64 + lane], m = fmaxf(m_run, m1), w0 = __builtin_amdgcn_exp2f(m_run - m), w1 = __builtin_amdgcn_exp2f(m1 - m), l = l_tot * w0 + l1 * w1;
            float* po = (float*)(p.ws + W_PO) + ((size_t)(b * 2 + split) * 64 + 32 * qb + r32) * 256 + 4 * hi;
#pragma unroll
            for (int d = 0; d < 8; ++d)
#pragma unroll
                for (int g4 = 0; g4 < 4; ++g4) { float4 v;
                    v.x = o[d][4 * g4] * w0 + xo[(d * 16 + 4 * g4) * 64 + lane] * w1; v.y = o[d][4 * g4 + 1] * w0 + xo[(d * 16 + 4 * g4 + 1) * 64 + lane] * w1;
                    v.z = o[d][4 * g4 + 2] * w0 + xo[(d * 16 + 4 * g4 + 2) * 64 + lane] * w1; v.w = o[d][4 * g4 + 3] * w0 + xo[(d * 16 + 4 * g4 + 3) * 64 + lane] * w1;
                    *(float4*)(po + 32 * d + 8 * g4) = v; }
            if (hi == 0) { float* pm = (float*)(p.ws + W_PML) + ((size_t)(b * 2 + split) * 64 + 32 * qb + r32) * 2; pm[0] = m; pm[1] = l; } }
    }
#undef SA_LOAD
#undef SA_WRITE
#undef SA_STAGE_NEW
#undef SA_COMPUTE
}
__device__ __forceinline__ void phase_attn_sample(const P& p, LAS unsigned char* lds) {
    for (int it = blockIdx.x; it < 256; it += gridDim.x) attn_sample_item(p, it >> 1, it & 1, lds);
}
__device__ __forceinline__ void phase_sample_combine(const P& p, LAS unsigned char* lds) {
    const int tid = pg8::opaque_tid(); LAS float* ol = (LAS float*)lds;
    const float* po = (const float*)(p.ws + W_PO); const float* pm = (const float*)(p.ws + W_PML); bf16_t* cat = (bf16_t*)(p.ws + W_CAT);
    for (int b = blockIdx.x; b < 128; b += gridDim.x) {
        __syncthreads();
        { const int row = tid >> 3, seg = tid & 7; const float m0 = pm[((size_t)(b * 2) * 64 + row) * 2], l0 = pm[((size_t)(b * 2) * 64 + row) * 2 + 1], m1 = pm[((size_t)(b * 2 + 1) * 64 + row) * 2], l1 = pm[((size_t)(b * 2 + 1) * 64 + row) * 2 + 1];
          const float m = fmaxf(m0, m1), w0 = __builtin_amdgcn_exp2f(m0 - m), w1 = __builtin_amdgcn_exp2f(m1 - m), li = 1.f / (l0 * w0 + l1 * w1);
#pragma unroll
          for (int j = 0; j < 8; ++j) { const float4 a = *(const float4*)(po + ((size_t)(b * 2) * 64 + row) * 256 + seg * 32 + 4 * j), c = *(const float4*)(po + ((size_t)(b * 2 + 1) * 64 + row) * 256 + seg * 32 + 4 * j);
              *(LAS f32x4*)(ol + ((row & 7) * 8 + (row >> 3)) * 260 + seg * 32 + 4 * j) = (f32x4){(a.x * w0 + c.x * w1) * li, (a.y * w0 + c.y * w1) * li, (a.z * w0 + c.z * w1) * li, (a.w * w0 + c.w * w1) * li}; } }
        __syncthreads();
        { const int h = tid >> 6, l = (tid >> 3) & 7, v0 = (tid & 7) * 8; const float* wv = p.w_uv + (size_t)h * 16384 + v0; LAS const float* orow = ol + (h * 8 + l) * 260; float acc[8];
#pragma unroll
          for (int j = 0; j < 8; ++j) acc[j] = 0.f;
#pragma unroll 8
          for (int r = 0; r < 256; ++r) { const float ov = orow[r]; const float4 a = *(const float4*)(wv + r * 64), c = *(const float4*)(wv + r * 64 + 4);
              acc[0] += ov * a.x; acc[1] += ov * a.y; acc[2] += ov * a.z; acc[3] += ov * a.w; acc[4] += ov * c.x; acc[5] += ov * c.y; acc[6] += ov * c.z; acc[7] += ov * c.w; }
          u32x4 w; w.x = cvt_pk_bf16(acc[0], acc[1]); w.y = cvt_pk_bf16(acc[2], acc[3]); w.z = cvt_pk_bf16(acc[4], acc[5]); w.w = cvt_pk_bf16(acc[6], acc[7]);
          *(u32x4*)(cat + (size_t)(TP + b * 8 + l) * 1024 + h * 64 + v0) = w; }
    }
}
constexpr int SG_BUF = 65536;
template <class Epi> __device__ __forceinline__ void sg_tile(LAS unsigned char* lds, const bf16_t* A, int lda, const bf16_t* Bt, int ldb, int K, int m0, int n0, const Epi& E) {
    const int tid = pg8::opaque_tid(), lane = tid & 63, fr = lane & 15, fq = lane >> 4; const int wid = __builtin_amdgcn_readfirstlane(tid >> 6), wr = wid >> 2, wc = wid & 3;
    const int nch = K >> 7;
    unsigned voffA[2], voffB[2];
#pragma unroll
    for (int i = 0; i < 2; ++i) { int R, C; pg8::stage_rc(tid * 16 + i * 8192, R, C); voffA[i] = (unsigned)(R * lda + C) * 2u; voffB[i] = (unsigned)(R * ldb + C) * 2u; }
    const char* gA = (const char*)(A + (size_t)m0 * lda); const char* gB = (const char*)(Bt + (size_t)n0 * ldb);
    const int aoff = pg8::lds_byte(wr * 64 + fr, fq * 8), boff = pg8::lds_byte(wc * 32 + fr, fq * 8);
    f32x4 acc[4][2];
#pragma unroll
    for (int m = 0; m < 4; ++m)
#pragma unroll
        for (int n = 0; n < 2; ++n) acc[m][n] = (f32x4){0.f, 0.f, 0.f, 0.f};
#define SG_ISSUE(c, buf) do { _Pragma("unroll") for (int kt_ = 0; kt_ < 2; ++kt_) _Pragma("unroll") for (int i_ = 0; i_ < 2; ++i_) { \
        glds16(gA + (size_t)(2 * (c) + kt_) * 128 + voffA[i_], lds + (buf) * SG_BUF + kt_ * 32768 + wid * 1024 + i_ * 8192); \
        glds16(gB + (size_t)(2 * (c) + kt_) * 128 + voffB[i_], lds + (buf) * SG_BUF + kt_ * 32768 + 16384 + wid * 1024 + i_ * 8192); } } while (0)
    __syncthreads();
    SG_ISSUE(0, 0);
    asm volatile("s_waitcnt vmcnt(0)" ::: "memory"); __syncthreads();
    for (int c = 0; c < nch; ++c) { const int buf = c & 1;
        if (c + 1 < nch) SG_ISSUE(c + 1, buf ^ 1);
#pragma unroll
        for (int kt = 0; kt < 2; ++kt) { LAS const unsigned char* ab = lds + buf * SG_BUF + kt * 32768 + aoff; LAS const unsigned char* bb = lds + buf * SG_BUF + kt * 32768 + 16384 + boff;
            bf16x8 At[4][2], Bf[2][2];
#pragma unroll
            for (int n = 0; n < 2; ++n)
#pragma unroll
                for (int k = 0; k < 2; ++k) Bf[n][k] = lds128(bb + n * 2048 + k * 1024);
#pragma unroll
            for (int m = 0; m < 4; ++m)
#pragma unroll
                for (int k = 0; k < 2; ++k) At[m][k] = lds128(ab + m * 2048 + k * 1024);
#pragma unroll
            for (int m = 0; m < 4; ++m)
#pragma unroll
                for (int n = 0; n < 2; ++n)
#pragma unroll
                    for (int k = 0; k < 2; ++k) acc[m][n] = __builtin_amdgcn_mfma_f32_16x16x32_bf16(Bf[n][k], At[m][k], acc[m][n], 0, 0, 0); }
        asm volatile("s_waitcnt vmcnt(0)" ::: "memory"); __syncthreads();
    }
#undef SG_ISSUE
    E(acc, m0 + wr * 64 + fr, n0 + wc * 32 + 4 * fq, (n0 >> 7) * 4 + wc, fq);
}
struct SgRes {
    const float* xs; bf16_t* Cb; float* ssqS;
    __device__ __forceinline__ void operator()(const f32x4 (&acc)[4][2], int row0, int col0, int slot, int fq) const {
#pragma unroll
        for (int m = 0; m < 4; ++m) { const int row = row0 + 16 * m; float ss = 0.f;
#pragma unroll
            for (int n = 0; n < 2; ++n) { const int col = col0 + 16 * n; const f32x4 v = acc[m][n] + *(const f32x4*)(xs + (size_t)row * 1024 + col); ss += v[0] * v[0] + v[1] * v[1] + v[2] * v[2] + v[3] * v[3];
                u32x2 w; w.x = cvt_pk_bf16(v[0], v[1]); w.y = cvt_pk_bf16(v[2], v[3]); *(u32x2*)(Cb + (size_t)(TP + row) * 1024 + col) = w; }
            ss += __shfl_xor(ss, 16); ss += __shfl_xor(ss, 32); if (fq == 0) ssqS[(size_t)row * 32 + slot] = ss; } }
};
struct SgUp {
    bf16_t* O; const float* ssqS;
    __device__ __forceinline__ void operator()(const f32x4 (&acc)[4][2], int row0, int col0, int slot, int fq) const {
#pragma unroll
        for (int m = 0; m < 4; ++m) { const int row = row0 + 16 * m; const f32x4* sp = (const f32x4*)(ssqS + (size_t)row * 32); f32x4 t = sp[0];
#pragma unroll
            for (int q = 1; q < 8; ++q) t += sp[q];
            const float rs = rsqrtf((t[0] + t[1] + t[2] + t[3]) * (1.f / 1024.f) + 1e-6f), rs2 = rs * rs;
#pragma unroll
            for (int n = 0; n < 2; ++n) { float v[4];
#pragma unroll
                for (int j = 0; j < 4; ++j) { const float q = fmaxf(acc[m][n][j], 0.f); v[j] = q * q * rs2; }
                u32x2 w; w.x = cvt_pk_bf16(v[0], v[1]); w.y = cvt_pk_bf16(v[2], v[3]); *(u32x2*)(O + (size_t)(TP + row) * 4096 + col0 + 16 * n) = w; } } }
};
struct SgSlab {
    float* C;
    __device__ __forceinline__ void operator()(const f32x4 (&acc)[4][2], int row0, int col0, int slot, int fq) const {
#pragma unroll
        for (int m = 0; m < 4; ++m)
#pragma unroll
            for (int n = 0; n < 2; ++n) *(f32x4*)(C + (size_t)(row0 + 16 * m) * 1024 + col0 + 16 * n) = acc[m][n]; }
};
#ifndef REP_P0
#define REP_P0 1
#endif
#ifndef REP_P1
#define REP_P1 1
#endif
#ifndef REP_P2
#define REP_P2 1
#endif
#ifndef REP_P6
#define REP_P6 1
#endif
#ifndef REP_P7
#define REP_P7 1
#endif
#ifndef REP_P8
#define REP_P8 1
#endif
#ifndef REP_P9
#define REP_P9 1
#endif
#ifndef REP_CB
#define REP_CB 1
#endif
#ifndef REP_TC
#define REP_TC 1
#endif
#ifndef REP_AP
#define REP_AP 1
#endif
#ifndef REP_AS
#define REP_AS 1
#endif
#ifndef REP_S2
#define REP_S2 1
#endif
#ifndef REP_SS
#define REP_SS 1
#endif
#ifndef REP_S1
#define REP_S1 1
#endif
__global__ void __launch_bounds__(512, 2) mega(P p) {
    extern __shared__ __attribute__((aligned(16))) unsigned char lds[];
    LAS unsigned char* ldsl = (LAS unsigned char*)lds;
    if (threadIdx.x < 4) ((volatile LAS unsigned*)(ldsl + LDS_XB))[threadIdx.x] = 0u;
    __syncthreads();
    XcdBarrier bar = xcd_barrier_post((unsigned*)(p.ws + W_CTL), (volatile LAS unsigned*)(ldsl + LDS_XB));
    const int lo = p.ph_lo, hi = p.ph_hi;
#define IN(k) (lo <= (k) && (k) < hi)
#ifdef PROF_SEAM
    unsigned long long prof_t0 = __builtin_amdgcn_s_memrealtime(), prof_tk = 0ull;
#define SEAM(k) do { if (IN(k) && IN((k) + 1)) xcd_barrier(bar); if ((k) == PROF_SEAM) prof_tk = __builtin_amdgcn_s_memrealtime(); } while (0)
#else
#define SEAM(k) do { if (IN(k) && IN((k) + 1)) xcd_barrier(bar); } while (0)
#endif
    if (IN(0)) { for (int rep_ = 0; rep_ < REP_P0; ++rep_) { __syncthreads(); phase_prep(p, lds); } }
    SEAM(0);
    if (IN(1)) for (int rep_ = 0; rep_ < REP_P1; ++rep_) { pg8::Gemm g{(const bf16_t*)(p.ws + W_HN), (const bf16_t*)(p.ws + W_BIN), T, 2304, 1024}; pg8::StaticOrder S; S.init(T, 2304, gridDim.x, (int)blockIdx.x);
        pg8::EpiBf16<0> E{(bf16_t*)(p.ws + W_PROJ), 2304, nullptr, 0, 0}; pg8::gemm_phase<pg8::EpiBf16<0>, pg8::StaticOrder>(ldsl, g, S, E, nullptr);
        if (blockIdx.x >= 100) tconv_run(p, lds, 340 + (int)blockIdx.x - 100, 1120, 156); }
    SEAM(1);
    if (IN(2)) { for (int rep_ = 0; rep_ < REP_P2; ++rep_) phase_thin(p); }
    SEAM(2);
    if (IN(3)) {
        const float qscale = 0.14724418f;
        const bf16_t* qn = (const bf16_t*)(p.ws + W_QN); const float* rope = (const float*)(p.ws + W_ROPE);
        if (blockIdx.x < 128) { for (int rep_ = 0; rep_ < REP_S1; ++rep_) phase_ssd_pass1(p, ldsl); __syncthreads(); }
        else { pg8::Gemm g{(const bf16_t*)(p.ws + W_CB), (const bf16_t*)(p.ws + W_BKV), TP, 1024, 256}; pg8::StaticOrder S; S.init(TP, 1024, 128, (int)blockIdx.x - 128);
          EpiKV E{(bf16_t*)(p.ws + W_KP), (bf16_t*)(p.ws + W_VP)}; pg8::gemm_phase<EpiKV, pg8::StaticOrder>(ldsl, g, S, E, nullptr); }
        asm volatile("" ::: "memory"); __builtin_amdgcn_sched_barrier(0);
        { pg8::Gemm g{qn, (const bf16_t*)(p.ws + W_BUQP), TP, 768, 384}; pg8::StaticOrder S; S.init(TP, 768, gridDim.x, (int)blockIdx.x);
          EpiQ<96, 64, 0> E{(bf16_t*)(p.ws + W_QP), 768, rope, qscale}; pg8::gemm_phase<EpiQ<96, 64, 0>, pg8::StaticOrder>(ldsl, g, S, E, nullptr); }
        asm volatile("" ::: "memory"); __builtin_amdgcn_sched_barrier(0);
        { pg8::Gemm g{qn + (size_t)TP * 384, (const bf16_t*)(p.ws + W_BQS), TS, 2304, 384}; pg8::StaticOrder S; S.init(TS, 2304, gridDim.x, (int)((blockIdx.x + 64) & 255));
          EpiQ<288, 256, 1> E{(bf16_t*)(p.ws + W_QS), 2304, rope, qscale}; pg8::gemm_phase<EpiQ<288, 256, 1>, pg8::StaticOrder>(ldsl, g, S, E, nullptr); }
    }
    SEAM(3);
    if (IN(5)) { const bool odd = (blockIdx.x >> 3) & 1;
        phase_ssd_scan(p);
        if (odd) { for (int rep_ = 0; rep_ < REP_AS; ++rep_) phase_attn_sample(p, ldsl); }
        for (int rep_ = 0; rep_ < REP_AP; ++rep_) phase_attn_prompt(p, ldsl);
        __syncthreads();
        for (int rep_ = 0; rep_ < REP_SS; ++rep_) phase_ssd_sample(p, ldsl);
        if (!odd) { for (int rep_ = 0; rep_ < REP_AS; ++rep_) phase_attn_sample(p, ldsl); } }
    SEAM(5);
    if (IN(6)) { if (blockIdx.x < 128) { phase_sample_combine(p, ldsl); tconv_run(p, lds, 1120 + (int)blockIdx.x, 1492, 128); }
        else { for (int rep_ = 0; rep_ < REP_S2; ++rep_) phase_ssd_pass2(p, ldsl); } }
    SEAM(6);
    if (IN(7)) for (int rep_ = 0; rep_ < REP_P6; ++rep_) { const bf16_t* catp = (const bf16_t*)(p.ws + W_CAT); const bf16_t* Bo = (const bf16_t*)(p.ws + W_BOUT);
        { pg8::Gemm g{catp, Bo, TP, 1024, 1024}; pg8::StaticOrder S; S.init(TP, 1024, gridDim.x, (int)blockIdx.x);
          EpiRes<false> E{p.x_p, p.x_s, (bf16_t*)(p.ws + W_X1B), (float*)(p.ws + W_SSQ1)}; pg8::gemm_phase<EpiRes<false>, pg8::StaticOrder>(ldsl, g, S, E, nullptr); }
        if (blockIdx.x >= 192) { const int c_ = (int)blockIdx.x - 192; SgRes E{p.x_s, (bf16_t*)(p.ws + W_X1B), (float*)(p.ws + W_SSQS)};
            sg_tile(ldsl, catp + (size_t)TP * 1024, 1024, Bo, 1024, 1024, (c_ >> 3) * 128, (c_ & 7) * 128, E); } }
    SEAM(7);
    if (IN(8)) for (int rep_ = 0; rep_ < REP_P7; ++rep_) { const bf16_t* x1b = (const bf16_t*)(p.ws + W_X1B); const bf16_t* Bu = (const bf16_t*)(p.ws + W_BUP);
        { pg8::Gemm g{x1b, Bu, TP, 4096, 1024}; pg8::StaticOrder S; S.init(TP, 4096, gridDim.x, (int)blockIdx.x);
          LAS float* rsl = (LAS float*)(ldsl + 131072);
          { pg8::Unit u0; S.next(0, u0); const int t_ = pg8::opaque_tid();
            if (t_ < 256) { const f32x4* sp = (const f32x4*)((const float*)(p.ws + W_SSQ1) + (size_t)(u0.pm * 256 + t_) * 16); const f32x4 a = sp[0], b = sp[1], c = sp[2], d = sp[3];
                const float tot = (a[0] + a[1] + a[2] + a[3]) + (b[0] + b[1] + b[2] + b[3]) + (c[0] + c[1] + c[2] + c[3]) + (d[0] + d[1] + d[2] + d[3]);
                const float rs = rsqrtf(tot * (1.f / 1024.f) + 1e-6f); rsl[t_] = rs * rs; }
            __syncthreads(); }
          EpiUp E{(bf16_t*)(p.ws + W_U), rsl}; pg8::gemm_phase<EpiUp, pg8::StaticOrder>(ldsl, g, S, E, nullptr); }
        { const int c_ = (int)blockIdx.x & 255; SgUp E{(bf16_t*)(p.ws + W_U), (const float*)(p.ws + W_SSQS)};
          sg_tile(ldsl, x1b + (size_t)TP * 1024, 1024, Bu, 1024, 1024, (c_ >> 5) * 128, (c_ & 31) * 128, E); } }
    SEAM(8);
    if (IN(9)) for (int rep_ = 0; rep_ < REP_P8; ++rep_) { const bf16_t* U = (const bf16_t*)(p.ws + W_U); const bf16_t* Bd = (const bf16_t*)(p.ws + W_BDOWN); const bf16_t* x1 = (const bf16_t*)(p.ws + W_X1B);
        { pg8::Gemm g{U, Bd, TP, 1024, 4096}; pg8::StaticOrder S; S.init(TP, 1024, gridDim.x, (int)blockIdx.x);
          EpiRes<true> E{x1, x1, (bf16_t*)(p.ws + W_X2B), (float*)(p.ws + W_SSQ2)}; pg8::gemm_phase<EpiRes<true>, pg8::StaticOrder>(ldsl, g, S, E, nullptr); }
        { const int c_ = (int)blockIdx.x & 255, sl = c_ & 3, tile = c_ >> 2; SgSlab E{(float*)(p.ws + W_SLAB) + (size_t)sl * 1024 * 1024};
          sg_tile(ldsl, U + (size_t)TP * 4096 + sl * 1024, 4096, Bd + sl * 1024, 4096, 1024, (tile >> 3) * 128, (tile & 7) * 128, E); } }
    SEAM(9);
    if (IN(10)) { for (int rep_ = 0; rep_ < REP_P9; ++rep_) phase_final(p); }
#ifdef PROF_SEAM
    if (blockIdx.x == 0 && threadIdx.x == 0) { const unsigned long long te = __builtin_amdgcn_s_memrealtime(), wait = (prof_tk - prof_t0) * 8ull;
        while (__builtin_amdgcn_s_memrealtime() - te < wait) __builtin_amdgcn_s_sleep(8); }
#endif
#ifdef PROF_SEC
    if (blockIdx.x == 135 && threadIdx.x == 0) { const unsigned long long te = __builtin_amdgcn_s_memrealtime(), wait = *(volatile unsigned long long*)(p.ws + W_CTL + 8192) * 32ull;
        while (__builtin_amdgcn_s_memrealtime() - te < wait) __builtin_amdgcn_s_sleep(8); }
#endif
#undef IN
#undef SEAM
}

static void fill_params(P& p, void* const* d_in, float* out, unsigned char* ws) {
    p.x_p = (const float*)d_in[0]; p.x_s = (const float*)d_in[1]; p.ckv = (const float*)d_in[2]; p.ckr = (const float*)d_in[3]; p.st_ssm = (const float*)d_in[4]; p.st_conv = (const float*)d_in[5];
    p.pt = (const int*)d_in[6]; p.norm_attn = (const float*)d_in[7]; p.w_in = (const float*)d_in[8]; p.q_norm = (const float*)d_in[9]; p.kv_norm = (const float*)d_in[10]; p.w_uq = (const float*)d_in[11];
    p.w_uk = (const float*)d_in[12]; p.w_uv = (const float*)d_in[13]; p.conv_w = (const float*)d_in[14]; p.conv_b = (const float*)d_in[15]; p.dt_bias = (const float*)d_in[16]; p.a_log = (const float*)d_in[17];
    p.d_skip = (const float*)d_in[18]; p.ssm_norm = (const float*)d_in[19]; p.w_out = (const float*)d_in[20]; p.norm_mlp = (const float*)d_in[21]; p.w_up = (const float*)d_in[22]; p.w_down = (const float*)d_in[23];
    p.norm_final = (const float*)d_in[24]; p.out = out; p.ws = ws;
}
static bool launch(void* const* d_in, float* out, unsigned char* ws, int ph_lo, int ph_hi, hipStream_t stream) {
    static int ready = 0;
    if (!ready) {
        if (hipFuncSetAttribute((const void*)mega, hipFuncAttributeMaxDynamicSharedMemorySize, LDS_BYTES) != hipSuccess) { fprintf(stderr, "mk: hipFuncSetAttribute failed\n"); ready = -1; }
        else { int per_cu = 0; if (hipOccupancyMaxActiveBlocksPerMultiprocessor(&per_cu, (const void*)mega, 512, LDS_BYTES) != hipSuccess || per_cu < 1) fprintf(stderr, "mk: occupancy query says %d\n", per_cu); (void)hipGetLastError(); ready = 1; }
    }
    if (ready < 0) return false;
    hipMemsetAsync(ws + W_CTL, 0, 16384, stream);
    P p{}; fill_params(p, d_in, out, ws); p.ph_lo = ph_lo; p.ph_hi = ph_hi;
    hipLaunchKernelGGL(mega, dim3(256), dim3(512), LDS_BYTES, stream, p);
    return hipPeekAtLastError() == hipSuccess;
}
}
extern "C" void kernel_launch(void* const* d_in, const int* in_sizes, int n_in, void* d_out, int out_size, void* d_ws, size_t ws_size, hipStream_t stream) {
    if (n_in != 25 || out_size != (int)mk::O_TOTAL || ws_size < mk::W_END) { fprintf(stderr, "kernel_launch: unexpected shapes (n_in %d, out %d, ws %zu)\n", n_in, out_size, ws_size); return; }
    mk::launch(d_in, (float*)d_out, (unsigned char*)d_ws, 0, 11, stream);
}
```

```cpp
#include <hip/hip_runtime.h>
#include <cstdio>
#include <cstdint>
#define XB_TMO      128
#define XB_XCNT(j)  (256  + 64 * (j))
#define XB_XSUB(j)  (1280 + 64 * (j))
#define XB_XGEN(j)  (2304 + 64 * (j))
#define XB_TOP      3328
#define XB_TOPGEN   3392
#define XCD_BAR_WORDS 3456
#define XB_SPIN_CAP (1u << 18)
#define LAS __attribute__((address_space(3)))

__device__ __forceinline__ unsigned xb_ld(unsigned* p)              { return __hip_atomic_load(p, __ATOMIC_RELAXED, __HIP_MEMORY_SCOPE_AGENT); }
__device__ __forceinline__ unsigned xb_add(unsigned* p, unsigned v) { return __hip_atomic_fetch_add(p, v, __ATOMIC_RELAXED, __HIP_MEMORY_SCOPE_AGENT); }
__device__ __forceinline__ unsigned xb_xcc_id() { return (unsigned)__builtin_amdgcn_s_getreg((3 << 11) | 20) & 0xFu; }
#define XB_SPIN(cond, bar) do { unsigned _sp = 0; while (cond) { __builtin_amdgcn_s_sleep(1); \
    if ((++_sp & 255u) == 0u) { if (xb_ld(&(bar)[XB_TMO])) break; if (_sp > XB_SPIN_CAP) { atomicAdd(&(bar)[XB_TMO], 1u); break; } } } } while (0)

struct XcdBarrier {
    unsigned* bar; unsigned x;
    volatile LAS unsigned* st;
};

__device__ __forceinline__ XcdBarrier xcd_barrier_post(unsigned* bar, volatile LAS unsigned* st) {
    XcdBarrier b; b.bar = bar; b.x = xb_xcc_id(); b.st = st;
    if (threadIdx.x == 0) (void)xb_add(&bar[XB_XCNT(b.x)], 1u);
    return b;
}
__device__ __forceinline__ void xcd_barrier_complete(unsigned* bar, unsigned x, unsigned& nloc, unsigned& nx) {
    const unsigned G = gridDim.x * gridDim.y * gridDim.z;
    unsigned sum, cnt, mine, sp = 0u;
    for (;;) {
        sum = 0u; cnt = 0u; mine = 0u;
#pragma unroll
        for (unsigned j = 0; j < 16; ++j) { const unsigned c = xb_ld(&bar[XB_XCNT(j)]); sum += c; cnt += (c > 0u) ? 1u : 0u; mine = (j == x) ? c : mine; }
        if (sum == G) break;
        __builtin_amdgcn_s_sleep(1);
        if ((++sp & 255u) == 0u) { if (xb_ld(&bar[XB_TMO])) break; if (sp > XB_SPIN_CAP) { atomicAdd(&bar[XB_TMO], 1u); break; } }
    }
    nloc = mine > 0u ? mine : 1u; nx = cnt > 0u ? cnt : 1u;
}

__device__ __forceinline__ void xcd_barrier(const XcdBarrier& b) {
    asm volatile("s_waitcnt vmcnt(0)" ::: "memory");
    __syncthreads();
    if (threadIdx.x == 0) {
        unsigned* bar = b.bar;
        __builtin_amdgcn_s_waitcnt(0);
        unsigned nloc = b.st[0], nx = b.st[1];
        if (nloc == 0u) { xcd_barrier_complete(bar, b.x, nloc, nx); b.st[0] = nloc; b.st[1] = nx; }
        const unsigned old = xb_add(&bar[XB_XSUB(b.x)], 1u);
        const unsigned gen = old / nloc;
        if (old + 1u == (gen + 1u) * nloc) {
            __builtin_amdgcn_fence(__ATOMIC_RELEASE, "agent");
            asm volatile("s_waitcnt vmcnt(0)" ::: "memory");
            const unsigned og = xb_add(&bar[XB_TOP], 1u);
            const unsigned tg = og / nx;
            if (og + 1u == (tg + 1u) * nx) xb_add(&bar[XB_TOPGEN], 1u);
            else XB_SPIN(xb_ld(&bar[XB_TOPGEN]) == tg, bar);
            __builtin_amdgcn_fence(__ATOMIC_ACQUIRE, "agent");
            xb_add(&bar[XB_XGEN(b.x)], 1u);
            asm volatile("s_waitcnt vmcnt(0)" ::: "memory");
        } else {
            XB_SPIN(xb_ld(&bar[XB_XGEN(b.x)]) == gen, bar);
            __builtin_amdgcn_fence(__ATOMIC_ACQUIRE, "agent");
            asm volatile("s_waitcnt vmcnt(0)" ::: "memory");
        }
    }
    __syncthreads();
}
namespace pg8 {
__device__ __forceinline__ int opaque_tid() { int t; asm volatile("v_mov_b32 %0, %1" : "=v"(t) : "v"((int)threadIdx.x)); return t; }
#define PG8_LAS __attribute__((address_space(3)))
typedef unsigned short bf16_t;
typedef short bf16x8 __attribute__((ext_vector_type(8)));
typedef float f32x4 __attribute__((ext_vector_type(4)));
typedef unsigned u32x4 __attribute__((ext_vector_type(4)));
constexpr int BM = 256, BK = 64, HALF = 128, HTB = HALF * BK * 2  , STAGE_BYTES = 8 * HTB, NXCD = 8, WGM = 8;

__host__ __device__ __forceinline__ int lds_byte(int r, int c) { const int st = (r >> 4) * 2 + (c >> 5), rr = r & 15, cc = c & 31, ob = rr * 64 + cc * 2; return st * 1024 + (ob ^ (((ob >> 9) & 1) << 5)); }
__host__ __device__ __forceinline__ void stage_rc(int b, int& R, int& C) { const int st = b / 1024, sb = b % 1024, swz = sb ^ (((sb >> 9) & 1) << 5); R = (st >> 1) * 16 + swz / 64; C = (st & 1) * 32 + (swz % 64) / 2; }
__host__ __device__ __forceinline__ int perm32(int rho) { const int n = rho >> 4, i = rho & 15; return 8 * (i >> 2) + 4 * n + (i & 3); }

struct Unit { int pm, pn; };
struct Gemm { const bf16_t* A; const bf16_t* Bt; int M, N, K; int ldk = 0; };

struct StaticOrder {
    int nM, nN, nwg, G, c;
    __host__ __device__ __forceinline__ void init(int M, int N, int G_, int c_) { nM = M / BM; nN = N / BM; nwg = nM * nN; G = G_; c = c_; }
    __host__ __device__ __forceinline__ bool next(int i, Unit& u) const {
        const long L = (long)i * G + c; if (L >= nwg) return false;
        int wgid = (int)L; { const int q = nwg / NXCD, r = nwg % NXCD, xcd = wgid % NXCD, off = wgid / NXCD; wgid = (xcd < r ? xcd * (q + 1) : r * (q + 1) + (xcd - r) * q) + off; }
        const int nig = WGM * nN, gid = wgid / nig, fm = gid * WGM, gsz = (nM - fm) < WGM ? (nM - fm) : WGM;
        u.pm = fm + ((wgid % nig) % gsz); u.pn = (wgid % nig) / gsz; return true;
    }
    __device__ __forceinline__ void a_ready(const Unit&) const {}
    __device__ __forceinline__ void done(const Unit&) const {}
};

__device__ __forceinline__ unsigned cvt_pk_bf16(float lo, float hi) { unsigned r; asm volatile("v_cvt_pk_bf16_f32 %0, %1, %2" : "=v"(r) : "v"(lo), "v"(hi)); return r; }
typedef float f32x2 __attribute__((ext_vector_type(2)));

struct EpiF32 {
    static constexpr bool PERM = false, AFTER_DRAIN = false;
    float* C; int ldc; const float* bias;
    __device__ __forceinline__ void operator()(const f32x4 (&acc)[2][2][4][2], const Unit& u, int wr, int wc, int fr, int fq) const {
        const int row0 = u.pm * BM + wr * 64 + fr, col0 = u.pn * BM + wc * 32 + 4 * fq;
        f32x4 bv[2][2];
#pragma unroll
        for (int bj = 0; bj < 2; ++bj)
#pragma unroll
            for (int n = 0; n < 2; ++n) bv[bj][n] = bias ? *(const f32x4*)(bias + col0 + bj * HALF + n * 16) : (f32x4){0.f, 0.f, 0.f, 0.f};
#pragma unroll
        for (int ai = 0; ai < 2; ++ai)
#pragma unroll
            for (int m = 0; m < 4; ++m) { float* rowp = C + (size_t)(row0 + ai * HALF + m * 16) * ldc + col0;
#pragma unroll
                for (int bj = 0; bj < 2; ++bj)
#pragma unroll
                    for (int n = 0; n < 2; ++n) *(f32x4*)(rowp + bj * HALF + n * 16) = acc[ai][bj][m][n] + bv[bj][n]; }
    }
};
template <int ACT  > struct EpiBf16 {
    static constexpr bool PERM = true, AFTER_DRAIN = false;
    bf16_t* O; int ldc; const float* bias; int split_cols; size_t split_stride;
    __device__ __forceinline__ void operator()(const f32x4 (&acc)[2][2][4][2], const Unit& u, int wr, int wc, int fr, int fq) const {
        const int row0 = u.pm * BM + wr * 64 + fr; int colt = u.pn * BM; bf16_t* base = O;
        if (split_cols) { const int t = colt / split_cols; base += (size_t)t * split_stride; colt -= t * split_cols; }
        const int col0 = colt + wc * 32 + 8 * fq, bcol0 = u.pn * BM + wc * 32 + 8 * fq;
        f32x4 bv[2][2];
#pragma unroll
        for (int bj = 0; bj < 2; ++bj)
#pragma unroll
            for (int n = 0; n < 2; ++n) bv[bj][n] = bias ? *(const f32x4*)(bias + bcol0 + bj * HALF + 4 * n) : (f32x4){0.f, 0.f, 0.f, 0.f};
#pragma unroll
        for (int ai = 0; ai < 2; ++ai)
#pragma unroll
            for (int m = 0; m < 4; ++m) { bf16_t* rowp = base + (size_t)(row0 + ai * HALF + m * 16) * ldc + col0;
#pragma unroll
                for (int bj = 0; bj < 2; ++bj) { f32x4 v0 = acc[ai][bj][m][0] + bv[bj][0], v1 = acc[ai][bj][m][1] + bv[bj][1];
                    u32x4 w; w.x = cvt_pk_bf16(v0[0], v0[1]); w.y = cvt_pk_bf16(v0[2], v0[3]); w.z = cvt_pk_bf16(v1[0], v1[1]); w.w = cvt_pk_bf16(v1[2], v1[3]);
                    *(u32x4*)(rowp + bj * HALF) = w; } }
    }
};

template <class Epi, class Sched, bool STAMP = false>
__device__ __forceinline__ void gemm_phase(PG8_LAS unsigned char* lds, const Gemm g, const Sched& S, const Epi& E, unsigned long long* stamps) {
    const int tid = opaque_tid(), wid = __builtin_amdgcn_readfirstlane(tid >> 6), lane = tid & 63, wr = wid >> 2, wc = wid & 3, fr = lane & 15, fq = lane >> 4;
    const int nt = g.K / BK, K = g.ldk ? g.ldk : g.K;
    int ts_lo = 0, ts_hi = 0, nts = 0; const unsigned long long rt_entry = STAMP ? (unsigned long long)wall_clock64() : 0ull;
#define PG8_STAMP() do { if (STAMP && wid == 0 && nts < 64) { const unsigned long long _c = (unsigned long long)clock64(); \
        ts_lo = (lane == nts) ? (int)(unsigned)_c : ts_lo; ts_hi = (lane == nts) ? (int)(unsigned)(_c >> 32) : ts_hi; ++nts; } } while (0)
    PG8_STAMP();
    unsigned voffA[2], voffB[2];
#pragma unroll
    for (int i = 0; i < 2; ++i) { int R, C; stage_rc(tid * 16 + i * 8192, R, C); const int Rb = Epi::PERM ? ((R & ~31) + perm32(R & 31)) : R;
        voffA[i] = (unsigned)(R * K + C) * 2u; voffB[i] = (unsigned)(Rb * K + C) * 2u; }
    const size_t kstep = (size_t)(BK * 2);
    const size_t hstep = (size_t)HALF * K * 2;
    const size_t tstep = 2 * hstep;
    const unsigned ldsw = (unsigned)wid * 1024u;
    const int aoff = lds_byte(wr * 64 + fr, fq * 8), boff = lds_byte(wc * 32 + fr, fq * 8);
#define PG8_SA(b, h) (((b) * 2 + (h)) * HTB)
#define PG8_SB(b, h) ((4 + (b) * 2 + (h)) * HTB)
#define PG8_STAGE(bufoff, gbase, voff) do { _Pragma("unroll") for (int _i = 0; _i < 2; ++_i) \
        __builtin_amdgcn_global_load_lds((const unsigned*)((const char*)(gbase) + (voff)[_i]), (PG8_LAS unsigned*)(lds + (bufoff) + ldsw + _i * 8192), 16, 0, 0); } while (0)
#define PG8_LDA(dst, b, h) do { _Pragma("unroll") for (int m = 0; m < 4; ++m) _Pragma("unroll") for (int k = 0; k < 2; ++k) dst[m][k] = *(const PG8_LAS bf16x8*)(lds + PG8_SA(b, h) + aoff + m * 2048 + k * 1024); } while (0)
#define PG8_LDB(dst, b, h) do { _Pragma("unroll") for (int n = 0; n < 2; ++n) _Pragma("unroll") for (int k = 0; k < 2; ++k) dst[n][k] = *(const PG8_LAS bf16x8*)(lds + PG8_SB(b, h) + boff + n * 2048 + k * 1024); } while (0)
#define PG8_MMA(ai, bj, At, Bt) do { __builtin_amdgcn_s_setprio(1); _Pragma("unroll") for (int m = 0; m < 4; ++m) _Pragma("unroll") for (int n = 0; n < 2; ++n) _Pragma("unroll") for (int k = 0; k < 2; ++k) \
        acc[ai][bj][m][n] = __builtin_amdgcn_mfma_f32_16x16x32_bf16(Bt[n][k], At[m][k], acc[ai][bj][m][n], 0, 0, 0); __builtin_amdgcn_s_setprio(0); } while (0)
#define PG8_WAIT_V(n) asm volatile("s_waitcnt vmcnt(" #n ")" ::: "memory")
#define PG8_WAIT_L(n) asm volatile("s_waitcnt lgkmcnt(" #n ")" ::: "memory")
#define PG8_BAR __builtin_amdgcn_s_barrier()
#define PG8_SCHED __builtin_amdgcn_sched_barrier(0)
    Unit cur, nxt; int ui = 0;
    if (!S.next(0, cur)) return;
    f32x4 acc[2][2][4][2];
#pragma unroll
    for (int a = 0; a < 2; ++a)
#pragma unroll
        for (int b = 0; b < 2; ++b)
#pragma unroll
            for (int m = 0; m < 4; ++m)
#pragma unroll
                for (int n = 0; n < 2; ++n) acc[a][b][m][n] = (f32x4){0.f, 0.f, 0.f, 0.f};
    bf16x8 At[4][2], B0[2][2], B1[2][2];
    const char* cA = (const char*)g.A + (size_t)cur.pm * tstep; const char* cB = (const char*)g.Bt + (size_t)cur.pn * tstep;
    S.a_ready(cur);
    PG8_STAGE(PG8_SB(0, 0), cB, voffB); PG8_STAGE(PG8_SA(0, 0), cA, voffA); PG8_STAGE(PG8_SB(0, 1), cB + hstep, voffB); PG8_STAGE(PG8_SA(0, 1), cA + hstep, voffA);
    if (wr == 1) PG8_BAR;
    PG8_WAIT_V(4); PG8_BAR;
    PG8_STAGE(PG8_SB(1, 0), cB + kstep, voffB); PG8_STAGE(PG8_SA(1, 0), cA + kstep, voffA); PG8_STAGE(PG8_SB(1, 1), cB + hstep + kstep, voffB);
    PG8_WAIT_V(6); PG8_BAR;
    PG8_STAMP();
    for (;;) {
        const bool has_next = S.next(ui + 1, nxt);
        const char* nA = has_next ? (const char*)g.A + (size_t)nxt.pm * tstep : cA; const char* nB = has_next ? (const char*)g.Bt + (size_t)nxt.pn * tstep : cB;
        for (int t = 0; t < nt; t += 2) {
            const bool last = (t == nt - 2);
            const char* a1 = cA + (size_t)(t + 1) * kstep;
            const char* a2 = last ? nA : cA + (size_t)(t + 2) * kstep; const char* b2 = last ? nB : cB + (size_t)(t + 2) * kstep;
            const char* a3 = a2 + kstep; const char* b3 = b2 + kstep;
            if (last && has_next) S.a_ready(nxt);
            PG8_LDB(B0, 0, 0); PG8_SCHED; PG8_LDA(At, 0, 0); PG8_STAGE(PG8_SA(1, 1), a1 + hstep, voffA);
            PG8_WAIT_L(8); PG8_BAR; PG8_WAIT_L(0); PG8_MMA(0, 0, At, B0); PG8_BAR; PG8_SCHED;
            PG8_LDB(B1, 0, 1); PG8_STAGE(PG8_SB(0, 0), b2, voffB);
            PG8_BAR; PG8_WAIT_L(0); PG8_MMA(0, 1, At, B1); PG8_BAR;
            PG8_LDA(At, 0, 1); PG8_STAGE(PG8_SA(0, 0), a2, voffA);
            PG8_BAR; PG8_WAIT_L(0); PG8_MMA(1, 0, At, B0); PG8_BAR; PG8_SCHED;
            PG8_STAGE(PG8_SB(0, 1), b2 + hstep, voffB);
            PG8_WAIT_V(6); PG8_BAR; PG8_MMA(1, 1, At, B1); PG8_BAR;
            PG8_LDB(B0, 1, 0); PG8_SCHED; PG8_LDA(At, 1, 0); PG8_STAGE(PG8_SA(0, 1), a2 + hstep, voffA);
            PG8_WAIT_L(8); PG8_BAR; PG8_WAIT_L(0); PG8_MMA(0, 0, At, B0); PG8_BAR; PG8_SCHED;
            PG8_LDB(B1, 1, 1); PG8_STAGE(PG8_SB(1, 0), b3, voffB);
            PG8_BAR; PG8_WAIT_L(0); PG8_MMA(0, 1, At, B1); PG8_BAR;
            PG8_LDA(At, 1, 1); PG8_STAGE(PG8_SA(1, 0), a3, voffA);
            PG8_BAR; PG8_WAIT_L(0); PG8_MMA(1, 0, At, B0); PG8_BAR; PG8_SCHED;
            PG8_STAGE(PG8_SB(1, 1), b3 + hstep, voffB);
            PG8_WAIT_V(6); PG8_BAR; PG8_MMA(1, 1, At, B1); PG8_BAR;
        }
        PG8_STAMP();
        if constexpr (!Epi::AFTER_DRAIN) { E(acc, cur, wr, wc, fr, fq); S.done(cur); }
        PG8_STAMP();
        if (!has_next) break;
#pragma unroll
        for (int a = 0; a < 2; ++a)
#pragma unroll
            for (int b = 0; b < 2; ++b)
#pragma unroll
                for (int m = 0; m < 4; ++m)
#pragma unroll
                    for (int n = 0; n < 2; ++n) acc[a][b][m][n] = (f32x4){0.f, 0.f, 0.f, 0.f};
        cur = nxt; cA = nA; cB = nB; ++ui;
    }
    PG8_WAIT_V(0);
    if (wr == 0) PG8_BAR;
    PG8_BAR;
    if constexpr (Epi::AFTER_DRAIN) { E.fused(acc, cur, wr, wc, fr, fq, lds, wid, lane); S.done(cur); }
    PG8_STAMP();
    if (STAMP && wid == 0) { stamps[lane] = lane < nts ? (((unsigned long long)(unsigned)ts_hi << 32) | (unsigned)ts_lo) : 0ull;
        if (lane == 62) stamps[62] = rt_entry; if (lane == 63) stamps[63] = (unsigned long long)wall_clock64(); }
#undef PG8_STAMP
#undef PG8_SA
#undef PG8_SB
#undef PG8_STAGE
#undef PG8_LDA
#undef PG8_LDB
#undef PG8_MMA
#undef PG8_WAIT_V
#undef PG8_WAIT_L
#undef PG8_BAR
#undef PG8_SCHED
}
}
namespace mk {
using pg8::bf16_t; using pg8::bf16x8; using pg8::f32x4; using pg8::u32x4; using pg8::cvt_pk_bf16;
typedef float f32x16 __attribute__((ext_vector_type(16)));
typedef short s16x4 __attribute__((ext_vector_type(4)));
typedef unsigned u32x2 __attribute__((ext_vector_type(2)));
constexpr int T = 17408, TP = 16384, TS = 1024, NPOS = 2056;
constexpr long O_Y_P = 0, O_Y_S = 16777216, O_KV_P = 17825792, O_KR_P = 22020096, O_SSM_P = 22544384, O_CONV_P = 23068672,
               O_KV_S = 23093248, O_KR_S = 23355392, O_SSM_S = 23388160, O_CONV_S = 31776768, O_TOTAL = 32169984;
constexpr int LDS_BYTES = 147456;
constexpr int LDS_XB = LDS_BYTES - 16;

constexpr size_t al(size_t x) { return (x + 255) & ~(size_t)255; }
constexpr size_t W_CTL = 0;
constexpr size_t W_ROPE = 16384;
constexpr size_t W_BIN = W_ROPE + al((size_t)NPOS * 32 * 4);
constexpr size_t W_BUQP = W_BIN + (size_t)2304 * 1024 * 2;
constexpr size_t W_BQS = W_BUQP + (size_t)768 * 384 * 2;
constexpr size_t W_BKV = W_BQS + (size_t)2304 * 384 * 2;
constexpr size_t W_BOUT = W_BKV + (size_t)1024 * 256 * 2;
constexpr size_t W_BUP = W_BOUT + (size_t)1024 * 1024 * 2;
constexpr size_t W_BDOWN = W_BUP + (size_t)4096 * 1024 * 2;
constexpr size_t W_HN = W_BDOWN + (size_t)1024 * 4096 * 2;
constexpr size_t W_PROJ = W_HN + (size_t)T * 1024 * 2;
constexpr size_t W_QN = W_PROJ + (size_t)T * 2304 * 2;
constexpr size_t W_CB = W_QN + (size_t)T * 384 * 2;
constexpr size_t W_KP = W_CB + (size_t)T * 256 * 2;
constexpr size_t W_VP = W_KP + (size_t)TP * 768 * 2;
constexpr size_t W_QP = W_VP + (size_t)TP * 512 * 2;
constexpr size_t W_QS = W_QP + (size_t)TP * 768 * 2;
constexpr size_t W_KRS = W_QS + (size_t)TS * 2304 * 2;
constexpr size_t W_BC = W_KRS + (size_t)TS * 32 * 2;
constexpr size_t W_CC = W_BC + (size_t)T * 256 * 2;
constexpr size_t W_XSF = W_CC + (size_t)T * 256 * 2;
constexpr size_t W_DTF = W_XSF + (size_t)T * 512 * 4;
constexpr size_t W_CAT = W_DTF + (size_t)T * 8 * 4;
constexpr size_t W_X1B = W_CAT + (size_t)T * 1024 * 2;
constexpr size_t W_SSQ1 = W_X1B + (size_t)T * 1024 * 2;
constexpr size_t W_SSQ2 = W_SSQ1 + (size_t)T * 16 * 4;
constexpr size_t W_U = W_SSQ2 + (size_t)T * 16 * 4;
constexpr size_t W_X2B = W_U + (size_t)T * 4096 * 2;
constexpr size_t W_STATES = W_X2B + (size_t)T * 1024 * 2;
constexpr size_t W_CHDEC = W_STATES + (size_t)512 * 8192 * 4;
constexpr size_t W_PML = W_CHDEC + 4096;
constexpr size_t W_PO = W_PML + (size_t)128 * 2 * 64 * 2 * 4;
constexpr size_t W_SLAB = W_PO + (size_t)128 * 2 * 64 * 256 * 4;
constexpr size_t W_HPREV = W_SLAB + (size_t)16 * 1024 * 1024 * 4;
constexpr size_t W_SSQS = W_HPREV + (size_t)512 * 8192 * 2;
constexpr size_t W_YRAW = W_SSQS + (size_t)TS * 32 * 4;
constexpr size_t W_END = W_YRAW + (size_t)TP * 512 * 4;

struct P {
    const float *x_p, *x_s, *ckv, *ckr, *st_ssm, *st_conv; const int* pt;
    const float *norm_attn, *w_in, *q_norm, *kv_norm, *w_uq, *w_uk, *w_uv, *conv_w, *conv_b, *dt_bias, *a_log, *d_skip, *ssm_norm, *w_out, *norm_mlp, *w_up, *w_down, *norm_final;
    float* out; unsigned char* ws; int ph_lo, ph_hi;
};

__device__ __forceinline__ float bf2f(unsigned short b) { return __uint_as_float(((unsigned)b) << 16); }
__device__ __forceinline__ float bflo(unsigned w) { return __uint_as_float(w << 16); }
__device__ __forceinline__ float bfhi(unsigned w) { return __uint_as_float(w & 0xffff0000u); }
__device__ __forceinline__ unsigned short f2bf(float f) { return (unsigned short)(cvt_pk_bf16(f, 0.f) & 0xffffu); }
__device__ __forceinline__ float wave_sum(float v) {
#pragma unroll
    for (int o = 32; o; o >>= 1) v += __shfl_xor(v, o);
    return v; }
__device__ __forceinline__ float silu(float v) { return v / (1.f + __expf(-v)); }

__device__ __forceinline__ int inproj_colmap(int n) {
    if (n < 256) return 384 + n; if (n < 640) return n - 256; if (n < 672) return n; if (n < 680) return n + 1536; if (n < 768) return -1; return n - 96; }
struct TJob { bf16_t* dst; const float* src; const float* ks; int ld, K, n0, k0, mode; };
__device__ __forceinline__ TJob tjob(const P& p, int j) {
    unsigned char* ws = p.ws; TJob t; t.ks = nullptr; t.mode = 0;
    if (j < 288) { const int kt = j & 7, nt = j >> 3; t.dst = (bf16_t*)(ws + W_BIN); t.src = p.w_in; t.ld = 2216; t.K = 1024; t.n0 = nt * 64; t.k0 = kt * 128; t.mode = 1; }
    else if (j < 324) { const int q = j - 288, kt = q % 3, nt = q / 3; t.dst = (bf16_t*)(ws + W_BUQP); t.src = p.w_uq; t.ld = 768; t.K = 384; t.n0 = nt * 64; t.k0 = kt * 128; }
    else if (j < 340) { const int q = j - 324, kt = q & 1, h = q >> 1; t.dst = (bf16_t*)(ws + W_BKV) + (size_t)(512 + h * 64) * 256; t.src = p.w_uv + (size_t)h * 16384; t.ld = 64; t.K = 256; t.n0 = 0; t.k0 = kt * 128; }
    else if (j < 468) { const int q = j - 340, kt = q & 7, nt = q >> 3; t.dst = (bf16_t*)(ws + W_BOUT); t.src = p.w_out; t.ld = 1024; t.K = 1024; t.n0 = nt * 64; t.k0 = kt * 128; }
    else if (j < 980) { const int q = j - 468, kt = q & 7, nt = q >> 3; t.dst = (bf16_t*)(ws + W_BUP); t.src = p.w_up; t.ld = 4096; t.K = 1024; t.n0 = nt * 64; t.k0 = kt * 128; t.ks = p.norm_mlp; }
    else { const int q = j - 980, kt = q & 31, nt = q >> 5; t.dst = (bf16_t*)(ws + W_BDOWN); t.src = p.w_down; t.ld = 1024; t.K = 4096; t.n0 = nt * 64; t.k0 = kt * 128; }
    return t;
}
__device__ __forceinline__ void tload(const TJob& t, int tid, float4 (&v)[4]) {
    float sc[4];
#pragma unroll
    for (int i = 0; i < 4; ++i) { const int e = tid + i * 512, kk = e >> 4, n4 = (e & 15) * 4, n = t.n0 + n4, c = t.mode ? inproj_colmap(n) : n;
        v[i] = *(const float4*)(t.src + (size_t)(t.k0 + kk) * t.ld + (c >= 0 ? c : 0)); sc[i] = c >= 0 ? 1.f : 0.f; }
    if (t.ks) {
#pragma unroll
        for (int i = 0; i < 4; ++i) { const int kk = (tid + i * 512) >> 4; sc[i] *= t.ks[t.k0 + kk]; } }
#pragma unroll
    for (int i = 0; i < 4; ++i) { v[i].x *= sc[i]; v[i].y *= sc[i]; v[i].z *= sc[i]; v[i].w *= sc[i]; }
}
__device__ __forceinline__ void tconv_run(const P& p, unsigned char* lds, int j0, int jend, int step) {
    const int tid = pg8::opaque_tid();
    float* tile = (float*)lds; int j = j0; float4 v[4]; TJob cur = tjob(p, j < jend ? j : 0);
    if (j < jend) tload(cur, tid, v);
    while (j < jend) {
        __syncthreads();
#pragma unroll
        for (int i = 0; i < 4; ++i) { const int e = tid + i * 512, kk = e >> 4, n4 = (e & 15) * 4; *(float4*)(tile + kk * 68 + ((n4 + 4 * (kk >> 3)) & 63)) = v[i]; }
        __syncthreads();
        const int jn = j + step; const TJob nxt = tjob(p, jn < jend ? jn : 0);
        if (jn < jend) tload(nxt, tid, v);
#pragma unroll
        for (int i = 0; i < 2; ++i) { const int e = tid + i * 512, nn = e >> 4, kc = (e & 15) * 8; float f[8];
#pragma unroll
            for (int q = 0; q < 8; ++q) f[q] = tile[(kc + q) * 68 + ((nn + 4 * (kc >> 3)) & 63)];
            u32x4 w; w.x = cvt_pk_bf16(f[0], f[1]); w.y = cvt_pk_bf16(f[2], f[3]); w.z = cvt_pk_bf16(f[4], f[5]); w.w = cvt_pk_bf16(f[6], f[7]);
            *(u32x4*)(cur.dst + (size_t)(cur.n0 + nn) * cur.K + cur.k0 + kc) = w; }
        cur = nxt; j = jn; }
    __syncthreads();
}
template <int NT> __device__ __forceinline__ void xprep(const P& p, bf16_t* hn, const float4 (&gn)[4], int t0, int lane) {
    float4 v[NT][4]; float ss[NT];
#pragma unroll
    for (int q = 0; q < NT; ++q) { const int t = t0 + q; const float* xr = t < TP ? p.x_p + (size_t)t * 1024 : p.x_s + (size_t)(t - TP) * 1024;
#pragma unroll
        for (int i = 0; i < 4; ++i) v[q][i] = *(const float4*)(xr + i * 256 + lane * 4); }
#pragma unroll
    for (int q = 0; q < NT; ++q) { ss[q] = 0.f;
#pragma unroll
        for (int i = 0; i < 4; ++i) ss[q] += v[q][i].x * v[q][i].x + v[q][i].y * v[q][i].y + v[q][i].z * v[q][i].z + v[q][i].w * v[q][i].w; }
#pragma unroll
    for (int o = 32; o; o >>= 1) {
#pragma unroll
        for (int q = 0; q < NT; ++q) ss[q] += __shfl_xor(ss[q], o); }
#pragma unroll
    for (int q = 0; q < NT; ++q) { const float rs = rsqrtf(ss[q] * (1.f / 1024.f) + 1e-6f);
#pragma unroll
        for (int i = 0; i < 4; ++i) { u32x2 w; w.x = cvt_pk_bf16(v[q][i].x * rs * gn[i].x, v[q][i].y * rs * gn[i].y); w.y = cvt_pk_bf16(v[q][i].z * rs * gn[i].z, v[q][i].w * rs * gn[i].w);
            *(u32x2*)(hn + (size_t)(t0 + q) * 1024 + i * 256 + lane * 4) = w; } }
}
__device__ __forceinline__ void phase_prep(const P& p, unsigned char* lds) {
    const int tid = pg8::opaque_tid(), lane = tid & 63, wid = tid >> 6, G = gridDim.x;
    unsigned char* ws = p.ws;
    { bf16_t* hn = (bf16_t*)(ws + W_HN); float4 gn[4];
#pragma unroll
      for (int i = 0; i < 4; ++i) gn[i] = *(const float4*)(p.norm_attn + i * 256 + lane * 4);
      for (int g8 = blockIdx.x * 8 + wid; g8 < TP / 8; g8 += G * 8) xprep<8>(p, hn, gn, g8 * 8, lane);
      for (int s1 = blockIdx.x * 8 + wid; s1 < TS; s1 += G * 8) xprep<1>(p, hn, gn, TP + s1, lane); }
    tconv_run(p, lds, (int)blockIdx.x, 340, G);
    { const int job = 255 - (int)blockIdx.x;
      if (job < 96) { const int h = job / 12, k0 = (job % 12) * 32; float* Bl = (float*)lds; float* Al = (float*)(lds + 65536);
        __syncthreads();
#pragma unroll
        for (int i = 0; i < 8; ++i) { const int f = tid + 512 * i; *(float4*)(Bl + f * 4) = *(const float4*)(p.w_uk + (size_t)h * 16384 + f * 4); }
        { const int kk = tid >> 4, d4 = tid & 15; *(float4*)(Al + kk * 68 + 4 * d4) = *(const float4*)(p.w_uq + (size_t)(k0 + kk) * 768 + h * 96 + 4 * d4); }
        __syncthreads();
        const int c = tid & 255, kh = tid >> 8; float acc[16];
#pragma unroll
        for (int q = 0; q < 16; ++q) acc[q] = 0.f;
        for (int d4 = 0; d4 < 16; ++d4) { const float b0 = Bl[(4 * d4) * 256 + c], b1 = Bl[(4 * d4 + 1) * 256 + c], b2 = Bl[(4 * d4 + 2) * 256 + c], b3 = Bl[(4 * d4 + 3) * 256 + c];
#pragma unroll
            for (int q = 0; q < 16; ++q) { const float4 a = *(const float4*)(Al + (kh * 16 + q) * 68 + 4 * d4); acc[q] += a.x * b0 + a.y * b1 + a.z * b2 + a.w * b3; } }
        u32x4 w0, w1; w0.x = cvt_pk_bf16(acc[0], acc[1]); w0.y = cvt_pk_bf16(acc[2], acc[3]); w0.z = cvt_pk_bf16(acc[4], acc[5]); w0.w = cvt_pk_bf16(acc[6], acc[7]);
        w1.x = cvt_pk_bf16(acc[8], acc[9]); w1.y = cvt_pk_bf16(acc[10], acc[11]); w1.z = cvt_pk_bf16(acc[12], acc[13]); w1.w = cvt_pk_bf16(acc[14], acc[15]);
        bf16_t* d = (bf16_t*)(ws + W_BQS) + (size_t)(h * 288 + c) * 384 + k0 + kh * 16; *(u32x4*)d = w0; *(u32x4*)(d + 8) = w1; } }
    const long gtid = (long)blockIdx.x * 512 + tid, gstride = (long)G * 512;
    { bf16_t* d = (bf16_t*)(ws + W_BQS);
      for (long i = gtid; i < 8L * 32 * 384; i += gstride) { const int k = (int)(i % 384), hj = (int)(i / 384), h = hj >> 5, jj = hj & 31;
        d[(size_t)(h * 288 + 256 + jj) * 384 + k] = f2bf(p.w_uq[(size_t)k * 768 + h * 96 + 64 + jj]); } }
    { bf16_t* d = (bf16_t*)(ws + W_BKV); for (long i = gtid; i < 131072 / 2; i += gstride) { const float2 v = *(const float2*)(p.w_uk + 2 * i); *(unsigned*)(d + 2 * i) = cvt_pk_bf16(v.x, v.y); } }
    { float* rt = (float*)(ws + W_ROPE);
      for (long i = gtid; i < (long)NPOS * 16; i += gstride) { const int pi = (int)(i >> 4), fi = (int)(i & 15), pos = pi < 2048 ? pi : 8192 + (pi - 2048);
        const double inv = exp2(-(double)(2 * fi) / 32.0 * 13.287712379549449); double sd, cd; sincos((double)pos * inv, &sd, &cd);
        rt[pi * 32 + fi] = (float)cd; rt[pi * 32 + 16 + fi] = (float)sd; } }
}

__device__ __forceinline__ void phase_thin(const P& p) {
    const int tid = pg8::opaque_tid(), lane = tid & 63, wid = tid >> 6, G = gridDim.x;
    unsigned char* ws = p.ws;
    const bf16_t* projp = (const bf16_t*)(ws + W_PROJ); const float* rope = (const float*)(ws + W_ROPE);
    bf16_t* cb = (bf16_t*)(ws + W_CB); bf16_t* qn = (bf16_t*)(ws + W_QN); bf16_t* Kp = (bf16_t*)(ws + W_KP); bf16_t* krs = (bf16_t*)(ws + W_KRS);
    bf16_t* Bc = (bf16_t*)(ws + W_BC); bf16_t* Cc = (bf16_t*)(ws + W_CC); float* xsf = (float*)(ws + W_XSF); float* dtf = (float*)(ws + W_DTF);
    float cw[4][16], cbias[16];
#pragma unroll
    for (int k = 0; k < 4; ++k)
#pragma unroll
        for (int j = 0; j < 4; ++j) { const float4 v = *(const float4*)(p.conv_w + k * 1024 + 16 * lane + 4 * j); cw[k][4 * j] = v.x; cw[k][4 * j + 1] = v.y; cw[k][4 * j + 2] = v.z; cw[k][4 * j + 3] = v.w; }
#pragma unroll
    for (int j = 0; j < 4; ++j) { const float4 v = *(const float4*)(p.conv_b + 16 * lane + 4 * j); cbias[4 * j] = v.x; cbias[4 * j + 1] = v.y; cbias[4 * j + 2] = v.z; cbias[4 * j + 3] = v.w; }
    const float4 kvn = *(const float4*)(p.kv_norm + 4 * lane);
    float qg[6];
#pragma unroll
    for (int j = 0; j < 6; ++j) qg[j] = p.q_norm[6 * lane + j];
    for (int t = blockIdx.x * 8 + wid; t < T; t += G * 8) {
        const bool pr = t < TP; const int l = pr ? (t & 2047) : ((t - TP) & 7), b = pr ? (t >> 11) : ((t - TP) >> 3), L = pr ? 2048 : 8;
        const bf16_t* row = projp + (size_t)t * 2304;
        { const u32x2 raw = *(const u32x2*)(row + 4 * lane); const float v0 = bflo(raw.x), v1 = bfhi(raw.x), v2 = bflo(raw.y), v3 = bfhi(raw.y);
          const float ss = wave_sum(v0 * v0 + v1 * v1 + v2 * v2 + v3 * v3), rs = rsqrtf(ss * (1.f / 256.f) + 1e-6f);
          const float o0 = v0 * rs * kvn.x, o1 = v1 * rs * kvn.y, o2 = v2 * rs * kvn.z, o3 = v3 * rs * kvn.w;
          float* od = pr ? p.out + O_KV_P + (size_t)t * 256 : p.out + O_KV_S + (size_t)(t - TP) * 256;
          *(float4*)(od + 4 * lane) = make_float4(o0, o1, o2, o3);
          u32x2 w; w.x = cvt_pk_bf16(o0, o1); w.y = cvt_pk_bf16(o2, o3); *(u32x2*)(cb + (size_t)t * 256 + 4 * lane) = w; }
        { const unsigned* qr = (const unsigned*)(row + 256 + 6 * lane); const unsigned r0 = qr[0], r1 = qr[1], r2 = qr[2];
          float q[6] = {bflo(r0), bfhi(r0), bflo(r1), bfhi(r1), bflo(r2), bfhi(r2)};
          float ss = 0.f;
#pragma unroll
          for (int j = 0; j < 6; ++j) ss += q[j] * q[j];
          ss = wave_sum(ss); const float rs = rsqrtf(ss * (1.f / 384.f) + 1e-6f);
          unsigned* qo = (unsigned*)(qn + (size_t)t * 384 + 6 * lane);
          qo[0] = cvt_pk_bf16(q[0] * rs * qg[0], q[1] * rs * qg[1]); qo[1] = cvt_pk_bf16(q[2] * rs * qg[2], q[3] * rs * qg[3]); qo[2] = cvt_pk_bf16(q[4] * rs * qg[4], q[5] * rs * qg[5]); }
        { const int i = lane & 15, pidx = pr ? l : 2048 + l; const float x1 = bf2f(row[640 + i]), x2 = bf2f(row[656 + i]);
          const float c = rope[pidx * 32 + i], s = rope[pidx * 32 + 16 + i];
          const float val = (lane & 16) ? (x2 * c + x1 * s) : (x1 * c - x2 * s); const int e = lane & 31;
          if (lane < 32) { float* od = pr ? p.out + O_KR_P + (size_t)t * 32 : p.out + O_KR_S + (size_t)(t - TP) * 32; od[e] = val; }
          const unsigned short vb = f2bf(val);
          if (pr) {
#pragma unroll
              for (int j = 0; j < 4; ++j) Kp[(size_t)t * 768 + ((lane >> 5) * 4 + j) * 96 + 64 + e] = vb; }
          else if (lane < 32) krs[(size_t)(t - TP) * 32 + e] = vb; }
        if (lane < 8) { const float v = bf2f(row[672 + lane]) + p.dt_bias[lane]; dtf[(size_t)t * 8 + lane] = v > 20.f ? v : log1pf(expf(v)); }
        { float acc[16], xc[16];
#pragma unroll
          for (int j = 0; j < 16; ++j) { acc[j] = cbias[j]; xc[j] = 0.f; }
          u32x4 ra[4], rb[4];
#pragma unroll
          for (int k = 0; k < 4; ++k) { const int lk = l + k - 3; const u32x4* src = (const u32x4*)(projp + (size_t)(lk >= 0 ? t + k - 3 : t) * 2304 + 1280 + 16 * lane); ra[k] = src[0]; rb[k] = src[1]; }
#pragma unroll
          for (int k = 0; k < 4; ++k) { const int lk = l + k - 3; float xv[16]; const u32x4 a = ra[k], c2 = rb[k];
            xv[0] = bflo(a.x); xv[1] = bfhi(a.x); xv[2] = bflo(a.y); xv[3] = bfhi(a.y); xv[4] = bflo(a.z); xv[5] = bfhi(a.z); xv[6] = bflo(a.w); xv[7] = bfhi(a.w);
            xv[8] = bflo(c2.x); xv[9] = bfhi(c2.x); xv[10] = bflo(c2.y); xv[11] = bfhi(c2.y); xv[12] = bflo(c2.z); xv[13] = bfhi(c2.z); xv[14] = bflo(c2.w); xv[15] = bfhi(c2.w);
            if (lk < 0) {
                if (!pr) { const float* src = p.st_conv + ((size_t)b * 3 + (l + k)) * 1024 + 16 * lane;
#pragma unroll
                    for (int j = 0; j < 4; ++j) { const float4 v = *(const float4*)(src + 4 * j); xv[4 * j] = v.x; xv[4 * j + 1] = v.y; xv[4 * j + 2] = v.z; xv[4 * j + 3] = v.w; } }
                else {
#pragma unroll
                    for (int j = 0; j < 16; ++j) xv[j] = 0.f; } }
#pragma unroll
            for (int j = 0; j < 16; ++j) { acc[j] += xv[j] * cw[k][j]; if (k == 3) xc[j] = xv[j]; } }
#pragma unroll
          for (int j = 0; j < 16; ++j) acc[j] = silu(acc[j]);
          if (lane < 32) { float* d = xsf + (size_t)t * 512 + 16 * lane;
#pragma unroll
              for (int j = 0; j < 4; ++j) *(float4*)(d + 4 * j) = make_float4(acc[4 * j], acc[4 * j + 1], acc[4 * j + 2], acc[4 * j + 3]); }
          else { bf16_t* d = (lane < 48 ? Bc + (size_t)t * 256 + 16 * (lane - 32) : Cc + (size_t)t * 256 + 16 * (lane - 48));
              u32x4 w0, w1; w0.x = cvt_pk_bf16(acc[0], acc[1]); w0.y = cvt_pk_bf16(acc[2], acc[3]); w0.z = cvt_pk_bf16(acc[4], acc[5]); w0.w = cvt_pk_bf16(acc[6], acc[7]);
              w1.x = cvt_pk_bf16(acc[8], acc[9]); w1.y = cvt_pk_bf16(acc[10], acc[11]); w1.z = cvt_pk_bf16(acc[12], acc[13]); w1.w = cvt_pk_bf16(acc[14], acc[15]);
              *(u32x4*)d = w0; *(u32x4*)(d + 8) = w1; }
          if (l >= L - 3) { float* d = (pr ? p.out + O_CONV_P : p.out + O_CONV_S) + ((size_t)b * 3 + (l - (L - 3))) * 1024 + 16 * lane;
#pragma unroll
              for (int j = 0; j < 4; ++j) *(float4*)(d + 4 * j) = make_float4(xc[4 * j], xc[4 * j + 1], xc[4 * j + 2], xc[4 * j + 3]); } }
    }
}
struct EpiKV {
    static constexpr bool PERM = true, AFTER_DRAIN = false;
    bf16_t* Kp; bf16_t* Vp;
    __device__ __forceinline__ void operator()(const f32x4 (&acc)[2][2][4][2], const pg8::Unit& u, int wr, int wc, int fr, int fq) const {
        const int row0 = u.pm * 256 + wr * 64 + fr, col = u.pn * 256 + wc * 32 + 8 * fq; const bool km = u.pn < 2;
        bf16_t* base = km ? Kp + (size_t)row0 * 768 + (col >> 6) * 96 + (col & 63) : Vp + (size_t)row0 * 512 + (col - 512);
        const int pitch = km ? 768 : 512, bjo = km ? 192 : 128;
#pragma unroll
        for (int ai = 0; ai < 2; ++ai)
#pragma unroll
            for (int m = 0; m < 4; ++m) { bf16_t* rp = base + (size_t)(ai * 128 + m * 16) * pitch;
#pragma unroll
                for (int bj = 0; bj < 2; ++bj) { const f32x4 v0 = acc[ai][bj][m][0], v1 = acc[ai][bj][m][1];
                    u32x4 w; w.x = cvt_pk_bf16(v0[0], v0[1]); w.y = cvt_pk_bf16(v0[2], v0[3]); w.z = cvt_pk_bf16(v1[0], v1[1]); w.w = cvt_pk_bf16(v1[2], v1[3]);
                    *(u32x4*)(rp + bj * bjo) = w; }
                asm volatile("" ::: "memory"); }
    }
};
template <int HD, int ROPE_OFF, int POS_MODE> struct EpiQ {
    static constexpr bool PERM = false, AFTER_DRAIN = false;
    bf16_t* O; int ldc; const float* rope; float scale;
    __device__ __forceinline__ void operator()(const f32x4 (&acc)[2][2][4][2], const pg8::Unit& u, int wr, int wc, int fr, int fq) const {
        const int row0 = u.pm * 256 + wr * 64 + fr;
#pragma unroll
        for (int bj = 0; bj < 2; ++bj) { const int g32 = u.pn * 256 + bj * 128 + wc * 32; const bool rg = ((g32 % HD) == ROPE_OFF);
#pragma unroll
            for (int ai = 0; ai < 2; ++ai)
#pragma unroll
                for (int m = 0; m < 4; ++m) { const int row = row0 + ai * 128 + m * 16; const int pidx = POS_MODE ? 2048 + (row & 7) : (row & 2047);
                    f32x4 v0 = acc[ai][bj][m][0], v1 = acc[ai][bj][m][1];
                    if (rg) { const f32x4 c = *(const f32x4*)(rope + pidx * 32 + 4 * fq), s = *(const f32x4*)(rope + pidx * 32 + 16 + 4 * fq);
                        const f32x4 r1 = v0 * c - v1 * s, r2 = v1 * c + v0 * s; v0 = r1; v1 = r2; }
                    v0 *= scale; v1 *= scale;
                    bf16_t* dst = O + (size_t)row * ldc + g32 + 4 * fq;
                    u32x2 w0, w1; w0.x = cvt_pk_bf16(v0[0], v0[1]); w0.y = cvt_pk_bf16(v0[2], v0[3]); w1.x = cvt_pk_bf16(v1[0], v1[1]); w1.y = cvt_pk_bf16(v1[2], v1[3]);
                    *(u32x2*)dst = w0; *(u32x2*)(dst + 16) = w1; asm volatile("" ::: "memory"); } }
    }
};

#define MFMA32(a, b, c) __builtin_amdgcn_mfma_f32_32x32x16_bf16((a), (b), (c), 0, 0, 0)
typedef short v4i16_t __attribute__((ext_vector_type(4)));
__device__ __forceinline__ s16x4 tr_read(LAS const unsigned char* p) { return __builtin_bit_cast(s16x4, __builtin_amdgcn_ds_read_tr16_b64_v4i16((LAS v4i16_t*)p)); }
__device__ __forceinline__ bf16x8 lds128(LAS const unsigned char* p) { return *(LAS const bf16x8*)p; }
__device__ __forceinline__ int crow(int r, int hi) { return (r & 3) + 8 * (r >> 2) + 4 * hi; }
__device__ __forceinline__ bf16x8 pack8(const f32x16& x, int s) {
    u32x4 w; w.x = cvt_pk_bf16(x[8 * s], x[8 * s + 1]); w.y = cvt_pk_bf16(x[8 * s + 2], x[8 * s + 3]); w.z = cvt_pk_bf16(x[8 * s + 4], x[8 * s + 5]); w.w = cvt_pk_bf16(x[8 * s + 6], x[8 * s + 7]);
    return __builtin_bit_cast(bf16x8, w); }
__device__ __forceinline__ void glds16(const void* g, LAS unsigned char* l) { __builtin_amdgcn_global_load_lds((const unsigned*)g, (LAS unsigned*)l, 16, 0, 0); }
__device__ __forceinline__ float max16(const f32x16& a) { float m = fmaxf(a[0], a[1]);
#pragma unroll
    for (int r = 2; r < 16; ++r) m = fmaxf(m, a[r]);
    return m; }

constexpr int PA_K = 0, PA_V = 49152, PA_KB = 12288, PA_VB = 8192;
__device__ __forceinline__ void attn_prompt_unit(const bf16_t* Qp, const bf16_t* Kp, const bf16_t* Vp, bf16_t* cat, int b, int h, int qb, LAS unsigned char* lds) {
    const int tid = pg8::opaque_tid(), lane = tid & 63, r32 = lane & 31, hi = lane >> 5; const int wid = __builtin_amdgcn_readfirstlane(tid >> 6);
    const size_t rowbase = (size_t)b * 2048; const int q0 = qb * 256, NT = 4 * qb + 4;
    const int qrow = q0 + wid * 32 + r32, qmin = q0 + wid * 32, qmax = qmin + 31;
    bf16x8 qf[6];
    const bf16_t* Qw = Qp + (rowbase + qrow) * 768 + h * 96 + hi * 8;
    const bf16_t* ksrc = Kp + (rowbase + lane) * 768 + h * 96;
    const bf16_t* vsrc = Vp + (rowbase + 16 * (wid & 3) + (lane >> 2)) * 512 + h * 64 + (wid >> 2) * 32 + (lane & 3) * 8;
#define PA_ISSUE(t, buf) do { const bf16_t* kt_ = ksrc + (size_t)(t) * 64 * 768; \
        glds16(kt_ + wid * 8, lds + PA_K + (buf) * PA_KB + wid * 1024); \
        if (wid < 4) glds16(kt_ + (8 + wid) * 8, lds + PA_K + (buf) * PA_KB + (8 + wid) * 1024); \
        glds16(vsrc + (size_t)(t) * 64 * 512, lds + PA_V + (buf) * PA_VB + wid * 1024); } while (0)
    f32x16 o0, o1;
#pragma unroll
    for (int r = 0; r < 16; ++r) { o0[r] = 0.f; o1[r] = 0.f; }
    float m_run = -INFINITY, l_run = 0.f;
    const int voff = (4 * hi + ((lane & 15) >> 2)) * 64 + ((lane >> 4) & 1) * 32 + (lane & 3) * 8;
    PA_ISSUE(0, 0); PA_ISSUE(1, 1); PA_ISSUE(2, 2);
    asm volatile("global_load_dwordx4 %0, %6, off\n\tglobal_load_dwordx4 %1, %6, off offset:32\n\tglobal_load_dwordx4 %2, %6, off offset:64\n\tglobal_load_dwordx4 %3, %6, off offset:96\n\t"
                 "global_load_dwordx4 %4, %6, off offset:128\n\tglobal_load_dwordx4 %5, %6, off offset:160\n\ts_waitcnt vmcnt(0)"
                 : "=&v"(qf[0]), "=&v"(qf[1]), "=&v"(qf[2]), "=&v"(qf[3]), "=&v"(qf[4]), "=&v"(qf[5]) : "v"(Qw) : "memory");
    __builtin_amdgcn_s_barrier(); asm volatile("" ::: "memory");
    for (int t = 0; t < NT; ++t) { const int buf = t & 3, kbase = t * 64;
        if (t + 3 < NT) PA_ISSUE(t + 3, (t + 3) & 3);
        if (kbase <= qmax) {
            LAS const unsigned char* kb = lds + PA_K + buf * PA_KB + hi * 1024 + r32 * 16;
            f32x16 s0, s1;
#pragma unroll
            for (int r = 0; r < 16; ++r) { s0[r] = 0.f; s1[r] = 0.f; }
#pragma unroll
            for (int d0 = 0; d0 < 6; ++d0) { const bf16x8 k0 = lds128(kb + d0 * 2048), k1 = lds128(kb + d0 * 2048 + 512); s0 = MFMA32(k0, qf[d0], s0); s1 = MFMA32(k1, qf[d0], s1); }
            if (kbase + 63 > qmin) {
#pragma unroll
                for (int r = 0; r < 16; ++r) { const int key = kbase + crow(r, hi); if (key > qrow) s0[r] = -INFINITY; if (key + 32 > qrow) s1[r] = -INFINITY; } }
            float mx = fmaxf(max16(s0), max16(s1)); mx = fmaxf(mx, __shfl_xor(mx, 32));
            const float m_new = fmaxf(m_run, mx), alpha = __builtin_amdgcn_exp2f(m_run - m_new); m_run = m_new;
            float ps = 0.f;
#pragma unroll
            for (int r = 0; r < 16; ++r) { s0[r] = __builtin_amdgcn_exp2f(s0[r] - m_new); s1[r] = __builtin_amdgcn_exp2f(s1[r] - m_new); ps += s0[r] + s1[r]; }
            l_run = l_run * alpha + ps;
            if (__any(alpha != 1.f)) {
#pragma unroll
                for (int r = 0; r < 16; ++r) { o0[r] *= alpha; o1[r] *= alpha; } }
            bf16x8 pf[4]; pf[0] = pack8(s0, 0); pf[1] = pack8(s0, 1); pf[2] = pack8(s1, 0); pf[3] = pack8(s1, 1);
            LAS const unsigned char* vb = lds + PA_V + buf * PA_VB + voff;
            s16x4 tv[16];
#define PA_TR(i, off) asm volatile("ds_read_b64_tr_b16 %0, %1 offset:%2" : "=v"(tv[i]) : "v"(vb), "i"(off))
#define PA_TRW(i) asm volatile("s_waitcnt lgkmcnt(0)" : "+v"(tv[i]), "+v"(tv[i + 1]), "+v"(tv[i + 2]), "+v"(tv[i + 3]), "+v"(tv[i + 4]), "+v"(tv[i + 5]), "+v"(tv[i + 6]), "+v"(tv[i + 7]))
            PA_TR(0, 0); PA_TR(1, 512); PA_TR(2, 4096); PA_TR(3, 4608); PA_TR(4, 1024); PA_TR(5, 1536); PA_TR(6, 5120); PA_TR(7, 5632);
            PA_TRW(0);
            PA_TR(8, 2048); PA_TR(9, 2560); PA_TR(10, 6144); PA_TR(11, 6656); PA_TR(12, 3072); PA_TR(13, 3584); PA_TR(14, 7168); PA_TR(15, 7680);
#pragma unroll
            for (int ks = 0; ks < 2; ++ks) { const bf16x8 va = __builtin_shufflevector(tv[4 * ks], tv[4 * ks + 1], 0, 1, 2, 3, 4, 5, 6, 7), vc = __builtin_shufflevector(tv[4 * ks + 2], tv[4 * ks + 3], 0, 1, 2, 3, 4, 5, 6, 7);
                o0 = MFMA32(va, pf[ks], o0); o1 = MFMA32(vc, pf[ks], o1); }
            PA_TRW(8);
#pragma unroll
            for (int ks = 2; ks < 4; ++ks) { const bf16x8 va = __builtin_shufflevector(tv[4 * ks], tv[4 * ks + 1], 0, 1, 2, 3, 4, 5, 6, 7), vc = __builtin_shufflevector(tv[4 * ks + 2], tv[4 * ks + 3], 0, 1, 2, 3, 4, 5, 6, 7);
                o0 = MFMA32(va, pf[ks], o0); o1 = MFMA32(vc, pf[ks], o1); }
#undef PA_TR
#undef PA_TRW
        }
        { const int rem = NT - 2 - t;
          if (wid < 4) { if (rem >= 2) asm volatile("s_waitcnt vmcnt(6)" ::: "memory"); else if (rem == 1) asm volatile("s_waitcnt vmcnt(3)" ::: "memory"); else asm volatile("s_waitcnt vmcnt(0)" ::: "memory"); }
          else { if (rem >= 2) asm volatile("s_waitcnt vmcnt(4)" ::: "memory"); else if (rem == 1) asm volatile("s_waitcnt vmcnt(2)" ::: "memory"); else asm volatile("s_waitcnt vmcnt(0)" ::: "memory"); } }
        __builtin_amdgcn_s_barrier(); asm volatile("" ::: "memory");
    }
#undef PA_ISSUE
    const float lt = l_run + __shfl_xor(l_run, 32), inv = 1.f / lt;
    bf16_t* orow = cat + (rowbase + qrow) * 1024 + h * 64 + 4 * hi;
#pragma unroll
    for (int g = 0; g < 4; ++g) { u32x2 w0, w1;
        w0.x = cvt_pk_bf16(o0[4 * g] * inv, o0[4 * g + 1] * inv); w0.y = cvt_pk_bf16(o0[4 * g + 2] * inv, o0[4 * g + 3] * inv);
        w1.x = cvt_pk_bf16(o1[4 * g] * inv, o1[4 * g + 1] * inv); w1.y = cvt_pk_bf16(o1[4 * g + 2] * inv, o1[4 * g + 3] * inv);
        *(u32x2*)(orow + 8 * g) = w0; *(u32x2*)(orow + 32 + 8 * g) = w1; }
}
__device__ __forceinline__ void phase_attn_prompt(const P& p, LAS unsigned char* lds) {
    const bf16_t* Qp = (const bf16_t*)(p.ws + W_QP); const bf16_t* Kp = (const bf16_t*)(p.ws + W_KP); const bf16_t* Vp = (const bf16_t*)(p.ws + W_VP); bf16_t* cat = (bf16_t*)(p.ws + W_CAT);
    __syncthreads();
    for (int it = blockIdx.x; it < 256; it += gridDim.x) { const int x = it & 7, kk = it >> 3, bh = x + 8 * (kk >> 2), j = kk & 3;
        attn_prompt_unit(Qp, Kp, Vp, cat, bh >> 3, bh & 7, j, lds);
        attn_prompt_unit(Qp, Kp, Vp, cat, bh >> 3, bh & 7, 7 - j, lds); }
}
template <bool RES_BF16> struct EpiRes {
    static constexpr bool PERM = false, AFTER_DRAIN = false;
    const void* r0; const void* r1; bf16_t* Cb; float* ssq;
    struct RV { f32x4 f[4]; u32x2 h[4]; };
    __device__ __forceinline__ void ld(int row, int col0, f32x4 (&f)[4], u32x2 (&h)[4]) const {
        const size_t ro = (row < TP ? (size_t)row : (size_t)(row - TP)) * 1024 + col0; const void* rb = row < TP ? r0 : r1;
#pragma unroll
        for (int q = 0; q < 4; ++q) { if (RES_BF16) h[q] = *(const u32x2*)((const bf16_t*)rb + ro + (q >> 1) * 128 + (q & 1) * 16); else f[q] = *(const f32x4*)((const float*)rb + ro + (q >> 1) * 128 + (q & 1) * 16); }
    }
    __device__ __forceinline__ void operator()(const f32x4 (&acc)[2][2][4][2], const pg8::Unit& u, int wr, int wc, int fr, int fq) const {
        const int row0 = u.pm * 256 + wr * 64 + fr, col0 = u.pn * 256 + wc * 32 + 4 * fq;
        f32x4 rf[2][4]; u32x2 rh[2][4];
        ld(row0, col0, rf[0], rh[0]);
#pragma unroll
        for (int it = 0; it < 8; ++it) { const int ai = it >> 2, m = it & 3, row = row0 + ai * 128 + m * 16;
            if (it < 7) ld(row0 + ((it + 1) >> 2) * 128 + ((it + 1) & 3) * 16, col0, rf[(it + 1) & 1], rh[(it + 1) & 1]);
            bf16_t* cp = Cb + (size_t)row * 1024 + col0; float ss = 0.f;
#pragma unroll
            for (int q = 0; q < 4; ++q) { const int bj = q >> 1, n = q & 1; f32x4 rv;
                if (RES_BF16) { const u32x2 w = rh[it & 1][q]; rv = (f32x4){bflo(w.x), bfhi(w.x), bflo(w.y), bfhi(w.y)}; } else rv = rf[it & 1][q];
                const f32x4 v = acc[ai][bj][m][n] + rv; ss += v[0] * v[0] + v[1] * v[1] + v[2] * v[2] + v[3] * v[3];
                u32x2 w; w.x = cvt_pk_bf16(v[0], v[1]); w.y = cvt_pk_bf16(v[2], v[3]); *(u32x2*)(cp + bj * 128 + n * 16) = w; }
            ss += __shfl_xor(ss, 16); ss += __shfl_xor(ss, 32);
            if (fq == 0) ssq[(size_t)row * 16 + u.pn * 4 + wc] = ss;
            asm volatile("" ::: "memory"); }
    }
};
struct EpiUp {
    static constexpr bool PERM = true, AFTER_DRAIN = false;
    bf16_t* O; LAS const float* rsl;
    __device__ __forceinline__ void operator()(const f32x4 (&acc)[2][2][4][2], const pg8::Unit& u, int wr, int wc, int fr, int fq) const {
        const int row0 = u.pm * 256 + wr * 64 + fr, col0 = u.pn * 256 + wc * 32 + 8 * fq;
        float r2[8];
#pragma unroll
        for (int it = 0; it < 8; ++it) r2[it] = rsl[wr * 64 + fr + (it >> 2) * 128 + (it & 3) * 16];
#pragma unroll
        for (int ai = 0; ai < 2; ++ai)
#pragma unroll
            for (int m = 0; m < 4; ++m) { const int row = row0 + ai * 128 + m * 16; const float rs2 = r2[ai * 4 + m];
                bf16_t* rp = O + (size_t)row * 4096 + col0;
#pragma unroll
                for (int bj = 0; bj < 2; ++bj) { f32x4 v0 = acc[ai][bj][m][0], v1 = acc[ai][bj][m][1];
#pragma unroll
                    for (int j = 0; j < 4; ++j) { const float p0 = fmaxf(v0[j], 0.f), p1 = fmaxf(v1[j], 0.f); v0[j] = p0 * p0 * rs2; v1[j] = p1 * p1 * rs2; }
                    u32x4 w; w.x = cvt_pk_bf16(v0[0], v0[1]); w.y = cvt_pk_bf16(v0[2], v0[3]); w.z = cvt_pk_bf16(v1[0], v1[1]); w.w = cvt_pk_bf16(v1[2], v1[3]);
                    *(u32x4*)(rp + bj * 128) = w; }
                asm volatile("" ::: "memory"); }
    }
};
struct OneUnit { int pm, pn; bool has;
    __device__ __forceinline__ bool next(int i, pg8::Unit& u) const { if (i > 0 || !has) return false; u.pm = pm; u.pn = pn; return true; }
    __device__ __forceinline__ void a_ready(const pg8::Unit&) const {}
    __device__ __forceinline__ void done(const pg8::Unit&) const {} };
struct EpiSlab {
    static constexpr bool PERM = false, AFTER_DRAIN = false; float* C;
    __device__ __forceinline__ void operator()(const f32x4 (&acc)[2][2][4][2], const pg8::Unit& u, int wr, int wc, int fr, int fq) const {
        float* base = C + (size_t)(u.pm * 256 + wr * 64 + fr) * 1024 + u.pn * 256 + wc * 32 + 4 * fq;
#pragma unroll
        for (int ai = 0; ai < 2; ++ai)
#pragma unroll
            for (int m = 0; m < 4; ++m) { float* rp = base + (size_t)(ai * 128 + m * 16) * 1024;
#pragma unroll
                for (int bj = 0; bj < 2; ++bj)
#pragma unroll
                    for (int n = 0; n < 2; ++n) *(f32x4*)(rp + bj * 128 + n * 16) = acc[ai][bj][m][n];
                asm volatile("" ::: "memory"); }
    }
};
constexpr int NSLAB = 4;
__device__ __forceinline__ void phase_final(const P& p) {
    const int tid = pg8::opaque_tid(), lane = tid & 63, wid = tid >> 6, G = gridDim.x;
    const bf16_t* x2 = (const bf16_t*)(p.ws + W_X2B); const float* ssq = (const float*)(p.ws + W_SSQ2); const bf16_t* x1 = (const bf16_t*)(p.ws + W_X1B); const float* slab = (const float*)(p.ws + W_SLAB);
    float4 g[4];
#pragma unroll
    for (int i = 0; i < 4; ++i) g[i] = *(const float4*)(p.norm_final + i * 256 + lane * 4);
    if (!(wid & 1)) { const int s = blockIdx.x * 4 + (wid >> 1);
        if (s < TS) { f32x4 v[4]; float ss = 0.f;
#pragma unroll
            for (int i = 0; i < 4; ++i) { const u32x2 w = *(const u32x2*)(x1 + (size_t)(TP + s) * 1024 + i * 256 + lane * 4); v[i] = (f32x4){bflo(w.x), bfhi(w.x), bflo(w.y), bfhi(w.y)}; }
#pragma unroll
            for (int sl = 0; sl < NSLAB; ++sl)
#pragma unroll
                for (int i = 0; i < 4; ++i) v[i] += *(const f32x4*)(slab + ((size_t)sl * 1024 + s) * 1024 + i * 256 + lane * 4);
#pragma unroll
            for (int i = 0; i < 4; ++i) ss += v[i][0] * v[i][0] + v[i][1] * v[i][1] + v[i][2] * v[i][2] + v[i][3] * v[i][3];
            ss = wave_sum(ss); const float rs = rsqrtf(ss * (1.f / 1024.f) + 1e-6f); float* o = p.out + O_Y_S + (size_t)s * 1024;
#pragma unroll
            for (int i = 0; i < 4; ++i) *(float4*)(o + i * 256 + lane * 4) = make_float4(v[i][0] * rs * g[i].x, v[i][1] * rs * g[i].y, v[i][2] * rs * g[i].z, v[i][3] * rs * g[i].w); } }
    for (int t4 = (blockIdx.x * 8 + wid) * 4; t4 < TP; t4 += G * 32) {
        u32x2 w[4][4]; float sq[4];
#pragma unroll
        for (int q = 0; q < 4; ++q) { sq[q] = ssq[(size_t)(t4 + q) * 16 + (lane & 15)];
#pragma unroll
            for (int i = 0; i < 4; ++i) w[q][i] = *(const u32x2*)(x2 + (size_t)(t4 + q) * 1024 + i * 256 + lane * 4); }
#pragma unroll
        for (int o = 1; o < 16; o <<= 1) {
#pragma unroll
            for (int q = 0; q < 4; ++q) sq[q] += __shfl_xor(sq[q], o); }
#pragma unroll
        for (int q = 0; q < 4; ++q) { const float rs = rsqrtf(sq[q] * (1.f / 1024.f) + 1e-6f); float* o = p.out + O_Y_P + (size_t)(t4 + q) * 1024;
#pragma unroll
            for (int i = 0; i < 4; ++i) *(float4*)(o + i * 256 + lane * 4) = make_float4(bflo(w[q][i].x) * rs * g[i].x, bfhi(w[q][i].x) * rs * g[i].y, bflo(w[q][i].y) * rs * g[i].z, bfhi(w[q][i].y) * rs * g[i].w); } }
}

__device__ __forceinline__ void phase_ssd_sample(const P& p, LAS unsigned char* lds) {
    const int tid = pg8::opaque_tid(), row = tid >> 1, nh = tid & 1, hh = row >> 6, pp = row & 63, wid = tid >> 6;
    const float* xsf = (const float*)(p.ws + W_XSF); const float* dtf = (const float*)(p.ws + W_DTF); const bf16_t* Bc = (const bf16_t*)(p.ws + W_BC); const bf16_t* Cc = (const bf16_t*)(p.ws + W_CC);
    const bf16_t* projp = (const bf16_t*)(p.ws + W_PROJ); bf16_t* cat = (bf16_t*)(p.ws + W_CAT);
    LAS float* Bl = (LAS float*)lds; LAS float* Cl = Bl + 1024; LAS float* red = Cl + 1024; LAS float* gl = red + 64;
    for (int it = blockIdx.x; it < 256; it += gridDim.x) { const int b = it >> 1, g = it & 1, h = g * 4 + hh; const size_t tb = (size_t)TP + b * 8;
        const float A = -__expf(p.a_log[h]), D = p.d_skip[h], gn = p.ssm_norm[h * 64 + pp];
        const size_t sidx = (((size_t)b * 8 + h) * 64 + pp) * 128 + nh * 64;
        __syncthreads();
        float hs[64];
#pragma unroll
        for (int j = 0; j < 16; ++j) { const float4 v = *(const float4*)(p.st_ssm + sidx + 4 * j); hs[4 * j] = v.x; hs[4 * j + 1] = v.y; hs[4 * j + 2] = v.z; hs[4 * j + 3] = v.w; }
        float dtc = dtf[tb * 8 + h], xc = xsf[tb * 512 + h * 64 + pp], zc = bf2f(projp[tb * 2304 + 768 + h * 64 + pp]);
        if (tid < 256) { const int c = tid & 127, tok = c >> 4, chk = c & 15; const bf16_t* src = (tid < 128 ? Bc : Cc) + (tb + tok) * 256 + g * 128 + 8 * chk; const u32x4 w = *(const u32x4*)src;
            LAS float* d = (tid < 128 ? Bl : Cl) + tok * 128 + 8 * chk;
            *(LAS f32x4*)d = (f32x4){bflo(w.x), bfhi(w.x), bflo(w.y), bfhi(w.y)}; *(LAS f32x4*)(d + 4) = (f32x4){bflo(w.z), bfhi(w.z), bflo(w.w), bfhi(w.w)}; }
        __syncthreads();
#pragma unroll 1
        for (int l = 0; l < 8; ++l) { const int ln = l < 7 ? l + 1 : 7;
            const float dtn = dtf[(tb + ln) * 8 + h], xn = xsf[(tb + ln) * 512 + h * 64 + pp], zn = bf2f(projp[(tb + ln) * 2304 + 768 + h * 64 + pp]);
            const float da = __expf(dtc * A), cf = dtc * xc; float yp = 0.f; LAS const float* bp = Bl + l * 128 + nh * 64; LAS const float* cp = Cl + l * 128 + nh * 64;
#pragma unroll
            for (int j = 0; j < 16; ++j) { const f32x4 bv = *(LAS const f32x4*)(bp + 4 * j), cv = *(LAS const f32x4*)(cp + 4 * j);
#pragma unroll
                for (int e = 0; e < 4; ++e) { hs[4 * j + e] = da * hs[4 * j + e] + cf * bv[e]; yp += cv[e] * hs[4 * j + e]; } }
            const float y = yp + __shfl_xor(yp, 1) + D * xc; gl[l * 512 + tid] = y * silu(zc);
            dtc = dtn; xc = xn; zc = zn; }
        float gv[8];
        { float ss[8];
#pragma unroll
          for (int l = 0; l < 8; ++l) { gv[l] = gl[l * 512 + tid]; ss[l] = nh == 0 ? gv[l] * gv[l] : 0.f; }
#pragma unroll
          for (int o = 32; o; o >>= 1) {
#pragma unroll
              for (int l = 0; l < 8; ++l) ss[l] += __shfl_xor(ss[l], o); }
          if ((tid & 63) < 8) { float v = ss[0];
#pragma unroll
              for (int l = 1; l < 8; ++l) v = ((tid & 63) == l) ? ss[l] : v;
              red[wid * 8 + (tid & 63)] = v; } }
        __syncthreads();
        if (nh == 0) {
#pragma unroll
            for (int l = 0; l < 8; ++l) { float tot = 0.f;
#pragma unroll
                for (int w = 0; w < 8; ++w) tot += red[w * 8 + l];
                cat[(tb + l) * 1024 + 512 + h * 64 + pp] = f2bf(gv[l] * rsqrtf(tot * (1.f / 256.f) + 1e-6f) * gn); } }
        float* so = p.out + O_SSM_S + sidx;
#pragma unroll
        for (int j = 0; j < 16; ++j) *(float4*)(so + 4 * j) = make_float4(hs[4 * j], hs[4 * j + 1], hs[4 * j + 2], hs[4 * j + 3]);
    }
}
constexpr int SS_CS = 0, SS_DT = 4096, SS_XW = 8192, SS_B1 = 8192 + 32768;
constexpr int SS_H = 8192, SS_BT = 8192 + 32768, SS_XD = SS_BT + 16384;
__device__ __forceinline__ unsigned off_b(unsigned row, unsigned ch) { return 256u * row + 16u * (ch ^ (((row & 3) << 2) | ((row >> 2) & 3))); }
__device__ __forceinline__ bf16x8 trpair(LAS const unsigned char* p) { const s16x4 a = tr_read(p), b = tr_read(p + 512); return __builtin_shufflevector(a, b, 0, 1, 2, 3, 4, 5, 6, 7); }
__device__ __forceinline__ void ssd_cumsum(const P& p, int t0, int g, int wid, int lane, LAS unsigned char* lds) {
    if (wid < 4) { const int h = g * 4 + wid; const float A2 = -__expf(p.a_log[h]) * 1.4426950408889634f; const float* dtf = (const float*)(p.ws + W_DTF);
        float d[4], s[4];
#pragma unroll
        for (int j = 0; j < 4; ++j) d[j] = dtf[(size_t)(t0 + 4 * lane + j) * 8 + h];
        s[0] = d[0] * A2; s[1] = s[0] + d[1] * A2; s[2] = s[1] + d[2] * A2; s[3] = s[2] + d[3] * A2;
        float incl = s[3];
#pragma unroll
        for (int o = 1; o < 64; o <<= 1) { const float v = __shfl_up(incl, o); if (lane >= o) incl += v; }
        const float ex = incl - s[3];
        *(LAS f32x4*)(lds + SS_CS + wid * 1024 + lane * 16) = (f32x4){ex + s[0], ex + s[1], ex + s[2], ex + s[3]};
        *(LAS f32x4*)(lds + SS_DT + wid * 1024 + lane * 16) = (f32x4){d[0], d[1], d[2], d[3]}; }
}
__device__ __forceinline__ void phase_ssd_pass1(const P& p, LAS unsigned char* lds) {
    const int tid = pg8::opaque_tid(), lane = tid & 63, r32 = lane & 31, hi = lane >> 5; const int wid = __builtin_amdgcn_readfirstlane(tid >> 6);
    const float* xsf = (const float*)(p.ws + W_XSF); const bf16_t* Bc = (const bf16_t*)(p.ws + W_BC); float* states = (float*)(p.ws + W_STATES); float* chdec = (float*)(p.ws + W_CHDEC);
    const int voff = (4 * hi + ((lane & 15) >> 2)) * 64 + ((lane >> 4) & 1) * 32 + (lane & 3) * 8;
    LAS const float* cs = (LAS const float*)(lds + SS_CS); LAS const float* dtl = (LAS const float*)(lds + SS_DT);
    for (int it = blockIdx.x; it < 128; it += gridDim.x) { const int b = it >> 4, g = (it >> 3) & 1, c = it & 7, t0 = b * 2048 + c * 256;
        __syncthreads();
        ssd_cumsum(p, t0, g, wid, lane, lds);
        __syncthreads();
        if (tid < 4) chdec[(b * 8 + g * 4 + tid) * 8 + c] = cs[tid * 256 + 255];
        f32x16 acc[4];
#pragma unroll
        for (int nb = 0; nb < 4; ++nb)
#pragma unroll
            for (int r = 0; r < 16; ++r) acc[nb][r] = 0.f;
        for (int ls = 0; ls < 4; ++ls) {
            __syncthreads();
#pragma unroll
            for (int i = 0; i < 8; ++i) { const int f = tid + 512 * i, l = f >> 6, c4 = f & 63, hl = c4 >> 4;
                const float4 v = *(const float4*)(xsf + (size_t)(t0 + 64 * ls + l) * 512 + g * 256 + 4 * c4);
                const float w = __builtin_amdgcn_exp2f(cs[hl * 256 + 255] - cs[hl * 256 + 64 * ls + l]) * dtl[hl * 256 + 64 * ls + l];
                u32x2 o; o.x = cvt_pk_bf16(v.x * w, v.y * w); o.y = cvt_pk_bf16(v.z * w, v.w * w);
                *(LAS u32x2*)(lds + SS_XW + (c4 >> 3) * 4096 + l * 64 + (c4 & 7) * 8) = o; }
#pragma unroll
            for (int i = 0; i < 2; ++i) { const int q = tid + 512 * i, l = q >> 4, ch = q & 15;
                const u32x4 v = *(const u32x4*)(Bc + (size_t)(t0 + 64 * ls + l) * 256 + g * 128 + 8 * ch);
                *(LAS u32x4*)(lds + SS_B1 + (ch >> 2) * 4096 + l * 64 + (ch & 3) * 16) = v; }
            __syncthreads();
#pragma unroll
            for (int ks = 0; ks < 4; ++ks) { const bf16x8 a = trpair(lds + SS_XW + wid * 4096 + voff + ks * 1024);
#pragma unroll
                for (int nb = 0; nb < 4; ++nb) { const bf16x8 bb = trpair(lds + SS_B1 + nb * 4096 + voff + ks * 1024); acc[nb] = MFMA32(a, bb, acc[nb]); } }
        }
        float* so = states + ((size_t)((b * 8 + g * 4 + (wid >> 1)) * 8 + c)) * 8192;
#pragma unroll
        for (int nb = 0; nb < 4; ++nb)
#pragma unroll
            for (int r = 0; r < 16; ++r) so[(32 * (wid & 1) + crow(r, hi)) * 128 + 32 * nb + r32] = acc[nb][r];
    }
}
__device__ __forceinline__ void phase_ssd_scan(const P& p) {
    const int gt = (int)blockIdx.x * 512 + pg8::opaque_tid(); if (gt >= 131072) return;
    const int bh = gt >> 11, rem = gt & 2047, pp = rem >> 5, n4 = rem & 31;
    const float* sb = (const float*)(p.ws + W_STATES) + (size_t)bh * 8 * 8192 + pp * 128 + 4 * n4; const float* cd = (const float*)(p.ws + W_CHDEC) + bh * 8;
    bf16_t* hp = (bf16_t*)(p.ws + W_HPREV) + (size_t)bh * 8 * 8192 + pp * 128 + 4 * n4;
    f32x4 v[8];
#pragma unroll
    for (int c = 0; c < 8; ++c) v[c] = *(const f32x4*)(sb + (size_t)c * 8192);
    f32x4 H = (f32x4){0.f, 0.f, 0.f, 0.f};
#pragma unroll
    for (int c = 0; c < 8; ++c) { u32x2 o; o.x = cvt_pk_bf16(H[0], H[1]); o.y = cvt_pk_bf16(H[2], H[3]); *(u32x2*)(hp + (size_t)c * 8192) = o; H = H * __builtin_amdgcn_exp2f(cd[c]) + v[c]; }
    *(f32x4*)(p.out + O_SSM_P + ((size_t)bh * 64 + pp) * 128 + 4 * n4) = H;
}
constexpr int S2_B = 8192, S2_H = 8192 + 65536, S2_XD = S2_H + 16384;
__device__ __forceinline__ void phase_ssd_pass2(const P& p, LAS unsigned char* lds) {
    const int tid = pg8::opaque_tid(), lane = tid & 63, r32 = lane & 31, hi = lane >> 5; const int wid = __builtin_amdgcn_readfirstlane(tid >> 6);
    const float* xsf = (const float*)(p.ws + W_XSF); const bf16_t* Bc = (const bf16_t*)(p.ws + W_BC); const bf16_t* Cc = (const bf16_t*)(p.ws + W_CC);
    const bf16_t* projp = (const bf16_t*)(p.ws + W_PROJ); bf16_t* cat = (bf16_t*)(p.ws + W_CAT); float* yraw = (float*)(p.ws + W_YRAW);
    const int voff = (4 * hi + ((lane & 15) >> 2)) * 64 + ((lane >> 4) & 1) * 32 + (lane & 3) * 8;
    LAS const float* cs = (LAS const float*)(lds + SS_CS); LAS const float* dtl = (LAS const float*)(lds + SS_DT);
    for (int it = (int)blockIdx.x - 128; it >= 0 && it < 128; it += 128) { const int b = it >> 4, g = (it >> 3) & 1, c = it & 7, t0 = b * 2048 + c * 256;
        const int ll = 32 * wid + r32; const size_t tl = (size_t)t0 + ll;
        __syncthreads();
        ssd_cumsum(p, t0, g, wid, lane, lds);
#pragma unroll
        for (int i = 0; i < 8; ++i) { const int q = tid + 512 * i, s = q >> 4, ch = q & 15;
            const u32x4 v = *(const u32x4*)(Bc + (size_t)(t0 + s) * 256 + g * 128 + 8 * ch);
            *(LAS u32x4*)(lds + S2_B + (s >> 6) * 16384 + off_b(s & 63, ch)) = v; }
        bf16x8 Cf[8];
#pragma unroll
        for (int ks = 0; ks < 8; ++ks) Cf[ks] = *(const bf16x8*)(Cc + tl * 256 + g * 128 + 16 * ks + 8 * hi);
        float4 xq[8]; u32x4 hq[2];
#define S2_FETCH(hh) do { const int h_ = g * 4 + (hh); \
            _Pragma("unroll") for (int i_ = 0; i_ < 8; ++i_) { const int f_ = tid + 512 * i_; xq[i_] = *(const float4*)(xsf + (size_t)(t0 + (f_ >> 4)) * 512 + h_ * 64 + 4 * (f_ & 15)); } \
            if (c > 0) { const bf16_t* hs_ = (const bf16_t*)(p.ws + W_HPREV) + ((size_t)(b * 8 + h_) * 8 + c) * 8192; \
                _Pragma("unroll") for (int i_ = 0; i_ < 2; ++i_) { const int q_ = tid + 512 * i_; hq[i_] = *(const u32x4*)(hs_ + (q_ >> 4) * 128 + 8 * (q_ & 15)); } } } while (0)
        S2_FETCH(0);
        for (int hd = 0; hd < 4; ++hd) { const int h = g * 4 + hd;
            __syncthreads();
            if (c > 0) {
#pragma unroll
                for (int i = 0; i < 2; ++i) { const int q = tid + 512 * i, pp = q >> 4, ch = q & 15; *(LAS u32x4*)(lds + S2_H + off_b(pp, ch)) = hq[i]; } }
#pragma unroll
            for (int i = 0; i < 8; ++i) { const int f = tid + 512 * i, s = f >> 4, c4 = f & 15;
                const float4 v = xq[i]; const float w = dtl[hd * 256 + s];
                u32x2 o; o.x = cvt_pk_bf16(v.x * w, v.y * w); o.y = cvt_pk_bf16(v.z * w, v.w * w);
                *(LAS u32x2*)(lds + S2_XD + (s >> 6) * 8192 + (c4 >> 3) * 4096 + (s & 63) * 64 + (c4 & 7) * 8) = o; }
            if (hd < 3) S2_FETCH(hd + 1);
            f32x16 acc[2];
#pragma unroll
            for (int q = 0; q < 2; ++q)
#pragma unroll
                for (int r = 0; r < 16; ++r) acc[q][r] = 0.f;
            __syncthreads();
            if (c > 0) {
#pragma unroll
                for (int pb = 0; pb < 2; ++pb)
#pragma unroll
                    for (int ks = 0; ks < 8; ++ks) { const bf16x8 a = lds128(lds + S2_H + off_b(32 * pb + r32, 2 * ks + hi)); acc[pb] = MFMA32(a, Cf[ks], acc[pb]); }
                const float e = __builtin_amdgcn_exp2f(cs[hd * 256 + ll]);
#pragma unroll
                for (int r = 0; r < 16; ++r) { acc[0][r] *= e; acc[1][r] *= e; } }
            LAS const float* ch = cs + hd * 256; const float cl = ch[ll];
            for (int kt = 0; kt <= (wid >> 1); ++kt) {
                f32x16 s0, s1;
#pragma unroll
                for (int r = 0; r < 16; ++r) { s0[r] = 0.f; s1[r] = 0.f; }
                LAS const unsigned char* bt = lds + S2_B + kt * 16384;
#pragma unroll
                for (int ks = 0; ks < 8; ++ks) { const bf16x8 a0 = lds128(bt + off_b(r32, 2 * ks + hi)), a1 = lds128(bt + off_b(32 + r32, 2 * ks + hi));
                    s0 = MFMA32(a0, Cf[ks], s0); s1 = MFMA32(a1, Cf[ks], s1); }
#pragma unroll
                for (int g4 = 0; g4 < 4; ++g4) { const int sb = 64 * kt + 8 * g4 + 4 * hi; const f32x4 ca = *(LAS const f32x4*)(ch + sb), cb2 = *(LAS const f32x4*)(ch + sb + 32);
#pragma unroll
                    for (int j = 0; j < 4; ++j) { const int r = 4 * g4 + j;
                        s0[r] = (sb + j <= ll) ? s0[r] * __builtin_amdgcn_exp2f(cl - ca[j]) : 0.f;
                        s1[r] = (sb + 32 + j <= ll) ? s1[r] * __builtin_amdgcn_exp2f(cl - cb2[j]) : 0.f; } }
                bf16x8 pf[4]; pf[0] = pack8(s0, 0); pf[1] = pack8(s0, 1); pf[2] = pack8(s1, 0); pf[3] = pack8(s1, 1);
#pragma unroll
                for (int pb = 0; pb < 2; ++pb)
#pragma unroll
                    for (int ks = 0; ks < 4; ++ks) { const bf16x8 a = trpair(lds + S2_XD + kt * 8192 + pb * 4096 + voff + ks * 1024); acc[pb] = MFMA32(a, pf[ks], acc[pb]); }
            }
            __syncthreads();
            { LAS float* ex = (LAS float*)(lds + S2_XD) + wid * 1152;
              int lt8 = lane >> 3; asm volatile("" : "+v"(lt8));
#pragma unroll
                for (int pb = 0; pb < 2; ++pb) {
#pragma unroll
                    for (int g4 = 0; g4 < 4; ++g4) *(LAS f32x4*)(ex + r32 * 36 + 8 * g4 + 4 * hi) = (f32x4){acc[pb][4 * g4], acc[pb][4 * g4 + 1], acc[pb][4 * g4 + 2], acc[pb][4 * g4 + 3]};
#pragma unroll
                    for (int i = 0; i < 4; ++i) { const int tok = 8 * i + lt8, pc = lane & 7; const size_t tg = (size_t)t0 + 32 * wid + tok;
                        *(f32x4*)(yraw + tg * 512 + h * 64 + 32 * pb + 4 * pc) = *(LAS const f32x4*)(ex + tok * 36 + 4 * pc); } } }
        }
#undef S2_FETCH
        asm volatile("s_waitcnt vmcnt(0)" ::: "memory"); __syncthreads();
        { const int ch = g * 256 + 4 * lane; const float D = p.d_skip[g * 4 + (lane >> 4)]; const float4 gn = *(const float4*)(p.ssm_norm + ch);
          for (int i = 0; i < 4; ++i) { f32x4 yv[8]; float4 xv[8]; u32x2 zr[8]; float gg[8][4], ss[8];
#pragma unroll
              for (int q = 0; q < 8; ++q) { const size_t tg = (size_t)t0 + 32 * wid + 8 * i + q; yv[q] = *(const f32x4*)(yraw + tg * 512 + ch); xv[q] = *(const float4*)(xsf + tg * 512 + ch); zr[q] = *(const u32x2*)(projp + tg * 2304 + 768 + ch); }
#pragma unroll
              for (int q = 0; q < 8; ++q) { gg[q][0] = (yv[q][0] + D * xv[q].x) * silu(bflo(zr[q].x)); gg[q][1] = (yv[q][1] + D * xv[q].y) * silu(bfhi(zr[q].x)); gg[q][2] = (yv[q][2] + D * xv[q].z) * silu(bflo(zr[q].y)); gg[q][3] = (yv[q][3] + D * xv[q].w) * silu(bfhi(zr[q].y));
                  ss[q] = gg[q][0] * gg[q][0] + gg[q][1] * gg[q][1] + gg[q][2] * gg[q][2] + gg[q][3] * gg[q][3]; }
#pragma unroll
              for (int o = 32; o; o >>= 1) {
#pragma unroll
                  for (int q = 0; q < 8; ++q) ss[q] += __shfl_xor(ss[q], o); }
#pragma unroll
              for (int q = 0; q < 8; ++q) { const size_t tg = (size_t)t0 + 32 * wid + 8 * i + q; const float rs = rsqrtf(ss[q] * (1.f / 256.f) + 1e-6f);
                  u32x2 o; o.x = cvt_pk_bf16(gg[q][0] * rs * gn.x, gg[q][1] * rs * gn.y); o.y = cvt_pk_bf16(gg[q][2] * rs * gn.z, gg[q][3] * rs * gn.w); *(u32x2*)(cat + tg * 1024 + 512 + ch) = o; } } }
    }
}
constexpr int SA_Q = 0, SA_T = 36864, SA_TB = 36864, SA_ROPE = 32768, SA_NP0 = 32;
__device__ __forceinline__ void attn_sample_item(const P& p, int b, int split, LAS unsigned char* lds) {
    const int tid = pg8::opaque_tid(), lane = tid & 63, r32 = lane & 31, hi = lane >> 5; const int wid = __builtin_amdgcn_readfirstlane(tid >> 6);
    const bool loader = wid >= 4; const int qb = wid & 1, kb = (wid >> 1) & 1, ltid = tid & 255;
    const bf16_t* Qs = (const bf16_t*)(p.ws + W_QS);
    __syncthreads();
    for (int idx = tid; idx < 2304; idx += 512) { const int qrow = idx / 36, ch = idx % 36;
        *(LAS u32x4*)(lds + SA_Q + ch * 1024 + qrow * 16) = *(const u32x4*)(Qs + (size_t)(b * 64 + qrow) * 288 + 8 * ch); }
    const int pg0 = split ? SA_NP0 : 0, nreal = 2 * (split ? 64 - SA_NP0 : SA_NP0), ntiles = nreal + (split ? 1 : 0);
    const int lw4 = ltid >> 6, ld4 = ltid & 63, lch = (ld4 & 31) >> 1, lbase = (ld4 >> 5) * 16384 + 256 * lw4 + 8 * (ld4 & 1), lrope = SA_ROPE + ((ltid & 7) >> 1) * 1024 + (ltid >> 3) * 16 + (ltid & 1) * 8;
#define SA_LOAD(st, t) do { const unsigned pg_ = (unsigned)__builtin_amdgcn_readlane(ptv, (t) >> 1); const unsigned skv_ = pg_ * 131072u + ((t) & 1) * 65536u, skr_ = pg_ * 16384u + ((t) & 1) * 8192u; \
        _Pragma("unroll") for (int i_ = 0; i_ < 16; ++i_) st[i_] = __builtin_bit_cast(f32x4, __builtin_amdgcn_raw_buffer_load_b128(rkv, lvo, skv_ + 4096u * i_, 2)); \
        st[16] = __builtin_bit_cast(f32x4, __builtin_amdgcn_raw_buffer_load_b128(rkr, lvo, skr_, 2)); st[17] = __builtin_bit_cast(f32x4, __builtin_amdgcn_raw_buffer_load_b128(rkr, lvo, skr_ + 4096u, 2)); } while (0)
#define SA_WRITE(st, buf) do { LAS unsigned char* tb_ = lds + SA_T + (buf) * SA_TB; int lb_ = lbase, lc_ = lch; asm volatile("" : "+v"(lb_), "+v"(lc_)); \
        _Pragma("unroll") for (int i_ = 0; i_ < 16; ++i_) { u32x2 o_; o_.x = cvt_pk_bf16(st[i_][0], st[i_][1]); o_.y = cvt_pk_bf16(st[i_][2], st[i_][3]); \
            *(LAS u32x2*)(tb_ + lb_ + 1024 * i_ + 16 * (lc_ ^ ((lw4 << 2) | (i_ & 3)))) = o_; } \
        _Pragma("unroll") for (int j_ = 0; j_ < 2; ++j_) { u32x2 o_; o_.x = cvt_pk_bf16(st[16 + j_][0], st[16 + j_][1]); o_.y = cvt_pk_bf16(st[16 + j_][2], st[16 + j_][3]); *(LAS u32x2*)(tb_ + lrope + 512 * j_) = o_; } } while (0)
#define SA_STAGE_NEW(buf) do { LAS unsigned char* tn_ = lds + SA_T + (buf) * SA_TB;     \
        int ltid = tid; asm volatile("" : "+v"(ltid)); ltid &= 255;     \
        { const int key_ = ltid >> 5, c32_ = ltid & 31; *(LAS u32x4*)(tn_ + (c32_ >> 4) * 16384 + off_b(key_, c32_ & 15)) = *(const u32x4*)((const bf16_t*)(p.ws + W_CB) + (size_t)(TP + b * 8 + key_) * 256 + 8 * c32_); } \
        if (ltid < 32) { const int key_ = ltid >> 2, pc_ = ltid & 3; *(LAS u32x4*)(tn_ + SA_ROPE + pc_ * 1024 + key_ * 16) = *(const u32x4*)((const bf16_t*)(p.ws + W_KRS) + (size_t)(b * 8 + key_) * 32 + 8 * pc_); } } while (0)
    const int q4 = (lane & 15) >> 2, p4 = lane & 3, blk = (lane >> 4) & 1, lq = 4 * qb + (r32 >> 3);
    const int kxor = ((r32 & 3) << 2) | ((r32 >> 2) & 3), krow = 256 * (32 * kb + r32), txl = (q4 << 2) | hi, trow = 256 * (32 * kb + 4 * hi + q4) + 8 * (p4 & 1);
#define SA_COMPUTE(t, buf) do { LAS const unsigned char* tb = lds + SA_T + (buf) * SA_TB; int kx_ = kxor, txl_ = txl, txh_ = txl + 2, krow_ = krow, trow_ = trow; asm volatile("" : "+v"(kx_), "+v"(txl_), "+v"(txh_), "+v"(krow_), "+v"(trow_)); \
        f32x16 s; \
        _Pragma("unroll") for (int r = 0; r < 16; ++r) s[r] = 0.f; \
        _Pragma("unroll") for (int ks = 0; ks < 16; ++ks) { const bf16x8 a = lds128(tb + (ks >> 3) * 16384 + krow_ + 16 * ((2 * (ks & 7) + hi) ^ kx_)), bq = lds128(lds + SA_Q + (2 * ks + hi) * 1024 + (32 * qb + r32) * 16); s = MFMA32(a, bq, s); if ((ks & 3) == 3) __builtin_amdgcn_sched_barrier(0); } \
        _Pragma("unroll") for (int ks = 16; ks < 18; ++ks) { const bf16x8 a = lds128(tb + SA_ROPE + (2 * (ks - 16) + hi) * 1024 + (32 * kb + r32) * 16), bq = lds128(lds + SA_Q + (2 * ks + hi) * 1024 + (32 * qb + r32) * 16); s = MFMA32(a, bq, s); } \
        if ((t) == nreal) { _Pragma("unroll") for (int r = 0; r < 16; ++r) { const int key = 32 * kb + crow(r, hi); if (key >= 8 || key > lq) s[r] = -INFINITY; } } \
        float mx = max16(s); mx = fmaxf(mx, __shfl_xor(mx, 32)); \
        const float m_new = fmaxf(m_run, mx), alpha = __builtin_amdgcn_exp2f(m_run - m_new); m_run = m_new; \
        float ps = 0.f; \
        _Pragma("unroll") for (int r = 0; r < 16; ++r) { s[r] = __builtin_amdgcn_exp2f(s[r] - m_new); ps += s[r]; } \
        l_run = l_run * alpha + ps; \
        if (__any(alpha != 1.f)) { _Pragma("unroll") for (int d = 0; d < 8; ++d) _Pragma("unroll") for (int r = 0; r < 16; ++r) o[d][r] *= alpha; } \
        bf16x8 pf[2]; pf[0] = pack8(s, 0); pf[1] = pack8(s, 1); \
        _Pragma("unroll") for (int sx = 0; sx < 2; ++sx) _Pragma("unroll") for (int db = 0; db < 8; ++db) { const int ch = 4 * (db & 3) + 2 * blk + (p4 >> 1); \
                const s16x4 lo = tr_read(tb + (db >> 2) * 16384 + trow_ + 4096 * sx + 16 * (ch ^ txl_)), hh = tr_read(tb + (db >> 2) * 16384 + trow_ + 4096 * sx + 2048 + 16 * (ch ^ txh_)); \
                const bf16x8 a = __builtin_shufflevector(lo, hh, 0, 1, 2, 3, 4, 5, 6, 7); o[db] = MFMA32(a, pf[sx], o[db]); if ((db & 3) == 3) __builtin_amdgcn_sched_barrier(0); } } while (0)
    if (loader) {
        const __amdgpu_buffer_rsrc_t rkv = __builtin_amdgcn_make_buffer_rsrc((void*)p.ckv, 0, 0x7ffffffc, 0x00020000), rkr = __builtin_amdgcn_make_buffer_rsrc((void*)p.ckr, 0, 0x7ffffffc, 0x00020000);
        const int lvo = ltid * 16, ptv = p.pt[b * 64 + pg0 + (lane & 31)];
        f32x4 stA[18], stB[18], stC[18];
        SA_LOAD(stA, 0); SA_LOAD(stB, 1); SA_LOAD(stC, 2); SA_WRITE(stA, 0);
        __syncthreads();
#define SA_FAST(k, SL, SW, BUF) { SA_LOAD(SL, t + (k) + 3); SA_WRITE(SW, BUF); __syncthreads(); }
#define SA_STEP(k, SL, SW, BUF) { if (t + (k) + 3 < nreal) SA_LOAD(SL, t + (k) + 3); \
            if (t + (k) + 1 < nreal) SA_WRITE(SW, BUF); else if (t + (k) + 1 < ntiles) SA_STAGE_NEW(BUF); \
            __syncthreads(); \
            if (t + (k) + 1 >= ntiles) break; }
        int t = 0;
        for (; t + 8 < nreal; t += 6) {
            SA_FAST(0, stA, stB, 1) SA_FAST(1, stB, stC, 0) SA_FAST(2, stC, stA, 1) SA_FAST(3, stA, stB, 0) SA_FAST(4, stB, stC, 1) SA_FAST(5, stC, stA, 0) }
        for (;; t += 6) {
            SA_STEP(0, stA, stB, 1) SA_STEP(1, stB, stC, 0) SA_STEP(2, stC, stA, 1) SA_STEP(3, stA, stB, 0) SA_STEP(4, stB, stC, 1) SA_STEP(5, stC, stA, 0) }
#undef SA_STEP
#undef SA_FAST
        __syncthreads();
    } else {
    f32x16 o[8];
#pragma unroll
    for (int d = 0; d < 8; ++d)
#pragma unroll
        for (int r = 0; r < 16; ++r) o[d][r] = 0.f;
    float m_run = -INFINITY, l_run = 0.f;
        __syncthreads();
        for (int t = 0; t < ntiles; t += 2) {
            SA_COMPUTE(t, 0);
            __syncthreads();
            if (t + 1 >= ntiles) break;
            SA_COMPUTE(t + 1, 1);
            __syncthreads(); }
        const float l_tot = l_run + __shfl_xor(l_run, 32);
        LAS float* xo = (LAS float*)(lds + SA_T) + qb * 8192; LAS float* xs = (LAS float*)(lds + SA_T + 65536) + qb * 128;
        if (kb == 1) {
#pragma unroll
            for (int d = 0; d < 8; ++d)
#pragma unroll
                for (int r = 0; r < 16; ++r) xo[(d * 16 + r) * 64 + lane] = o[d][r];
            xs[lane] = m_run; xs[64 + lane] = l_tot; }
        __syncthreads();
        if (kb == 0) { const float m1 = xs[lane], l1 = xs[64 + lane], m = fmaxf(m_run, m1), w0 = __builtin_amdgcn_exp2f(m_run - m), w1 = __builtin_amdgcn_exp2f(m1 - m), l = l_tot * w0 + l1 * w1;
            float* po = (float*)(p.ws + W_PO) + ((size_t)(b * 2 + split) * 64 + 32 * qb + r32) * 256 + 4 * hi;
#pragma unroll
            for (int d = 0; d < 8; ++d)
#pragma unroll
                for (int g4 = 0; g4 < 4; ++g4) { float4 v;
                    v.x = o[d][4 * g4] * w0 + xo[(d * 16 + 4 * g4) * 64 + lane] * w1; v.y = o[d][4 * g4 + 1] * w0 + xo[(d * 16 + 4 * g4 + 1) * 64 + lane] * w1;
                    v.z = o[d][4 * g4 + 2] * w0 + xo[(d * 16 + 4 * g4 + 2) * 64 + lane] * w1; v.w = o[d][4 * g4 + 3] * w0 + xo[(d * 16 + 4 * g4 + 3) * 64 + lane] * w1;
                    *(float4*)(po + 32 * d + 8 * g4) = v; }
            if (hi == 0) { float* pm = (float*)(p.ws + W_PML) + ((size_t)(b * 2 + split) * 64 + 32 * qb + r32) * 2; pm[0] = m; pm[1] = l; } }
    }
#undef SA_LOAD
#undef SA_WRITE
#undef SA_STAGE_NEW
#undef SA_COMPUTE
}
__device__ __forceinline__ void phase_attn_sample(const P& p, LAS unsigned char* lds) {
    for (int it = blockIdx.x; it < 256; it += gridDim.x) attn_sample_item(p, it >> 1, it & 1, lds);
}
__device__ __forceinline__ void phase_sample_combine(const P& p, LAS unsigned char* lds) {
    const int tid = pg8::opaque_tid(); LAS float* ol = (LAS float*)lds;
    const float* po = (const float*)(p.ws + W_PO); const float* pm = (const float*)(p.ws + W_PML); bf16_t* cat = (bf16_t*)(p.ws + W_CAT);
    for (int b = blockIdx.x; b < 128; b += gridDim.x) {
        __syncthreads();
        { const int row = tid >> 3, seg = tid & 7; const float m0 = pm[((size_t)(b * 2) * 64 + row) * 2], l0 = pm[((size_t)(b * 2) * 64 + row) * 2 + 1], m1 = pm[((size_t)(b * 2 + 1) * 64 + row) * 2], l1 = pm[((size_t)(b * 2 + 1) * 64 + row) * 2 + 1];
          const float m = fmaxf(m0, m1), w0 = __builtin_amdgcn_exp2f(m0 - m), w1 = __builtin_amdgcn_exp2f(m1 - m), li = 1.f / (l0 * w0 + l1 * w1);
#pragma unroll
          for (int j = 0; j < 8; ++j) { const float4 a = *(const float4*)(po + ((size_t)(b * 2) * 64 + row) * 256 + seg * 32 + 4 * j), c = *(const float4*)(po + ((size_t)(b * 2 + 1) * 64 + row) * 256 + seg * 32 + 4 * j);
              *(LAS f32x4*)(ol + ((row & 7) * 8 + (row >> 3)) * 260 + seg * 32 + 4 * j) = (f32x4){(a.x * w0 + c.x * w1) * li, (a.y * w0 + c.y * w1) * li, (a.z * w0 + c.z * w1) * li, (a.w * w0 + c.w * w1) * li}; } }
        __syncthreads();
        { const int h = tid >> 6, l = (tid >> 3) & 7, v0 = (tid & 7) * 8; const float* wv = p.w_uv + (size_t)h * 16384 + v0; LAS const float* orow = ol + (h * 8 + l) * 260; float acc[8];
#pragma unroll
          for (int j = 0; j < 8; ++j) acc[j] = 0.f;
#pragma unroll 8
          for (int r = 0; r < 256; ++r) { const float ov = orow[r]; const float4 a = *(const float4*)(wv + r * 64), c = *(const float4*)(wv + r * 64 + 4);
              acc[0] += ov * a.x; acc[1] += ov * a.y; acc[2] += ov * a.z; acc[3] += ov * a.w; acc[4] += ov * c.x; acc[5] += ov * c.y; acc[6] += ov * c.z; acc[7] += ov * c.w; }
          u32x4 w; w.x = cvt_pk_bf16(acc[0], acc[1]); w.y = cvt_pk_bf16(acc[2], acc[3]); w.z = cvt_pk_bf16(acc[4], acc[5]); w.w = cvt_pk_bf16(acc[6], acc[7]);
          *(u32x4*)(cat + (size_t)(TP + b * 8 + l) * 1024 + h * 64 + v0) = w; }
    }
}
constexpr int SG_BUF = 65536;
template <class Epi> __device__ __forceinline__ void sg_tile(LAS unsigned char* lds, const bf16_t* A, int lda, const bf16_t* Bt, int ldb, int K, int m0, int n0, const Epi& E) {
    const int tid = pg8::opaque_tid(), lane = tid & 63, fr = lane & 15, fq = lane >> 4; const int wid = __builtin_amdgcn_readfirstlane(tid >> 6), wr = wid >> 2, wc = wid & 3;
    const int nch = K >> 7;
    unsigned voffA[2], voffB[2];
#pragma unroll
    for (int i = 0; i < 2; ++i) { int R, C; pg8::stage_rc(tid * 16 + i * 8192, R, C); voffA[i] = (unsigned)(R * lda + C) * 2u; voffB[i] = (unsigned)(R * ldb + C) * 2u; }
    const char* gA = (const char*)(A + (size_t)m0 * lda); const char* gB = (const char*)(Bt + (size_t)n0 * ldb);
    const int aoff = pg8::lds_byte(wr * 64 + fr, fq * 8), boff = pg8::lds_byte(wc * 32 + fr, fq * 8);
    f32x4 acc[4][2];
#pragma unroll
    for (int m = 0; m < 4; ++m)
#pragma unroll
        for (int n = 0; n < 2; ++n) acc[m][n] = (f32x4){0.f, 0.f, 0.f, 0.f};
#define SG_ISSUE(c, buf) do { _Pragma("unroll") for (int kt_ = 0; kt_ < 2; ++kt_) _Pragma("unroll") for (int i_ = 0; i_ < 2; ++i_) { \
        glds16(gA + (size_t)(2 * (c) + kt_) * 128 + voffA[i_], lds + (buf) * SG_BUF + kt_ * 32768 + wid * 1024 + i_ * 8192); \
        glds16(gB + (size_t)(2 * (c) + kt_) * 128 + voffB[i_], lds + (buf) * SG_BUF + kt_ * 32768 + 16384 + wid * 1024 + i_ * 8192); } } while (0)
    __syncthreads();
    SG_ISSUE(0, 0);
    asm volatile("s_waitcnt vmcnt(0)" ::: "memory"); __syncthreads();
    for (int c = 0; c < nch; ++c) { const int buf = c & 1;
        if (c + 1 < nch) SG_ISSUE(c + 1, buf ^ 1);
#pragma unroll
        for (int kt = 0; kt < 2; ++kt) { LAS const unsigned char* ab = lds + buf * SG_BUF + kt * 32768 + aoff; LAS const unsigned char* bb = lds + buf * SG_BUF + kt * 32768 + 16384 + boff;
            bf16x8 At[4][2], Bf[2][2];
#pragma unroll
            for (int n = 0; n < 2; ++n)
#pragma unroll
                for (int k = 0; k < 2; ++k) Bf[n][k] = lds128(bb + n * 2048 + k * 1024);
#pragma unroll
            for (int m = 0; m < 4; ++m)
#pragma unroll
                for (int k = 0; k < 2; ++k) At[m][k] = lds128(ab + m * 2048 + k * 1024);
#pragma unroll
            for (int m = 0; m < 4; ++m)
#pragma unroll
                for (int n = 0; n < 2; ++n)
#pragma unroll
                    for (int k = 0; k < 2; ++k) acc[m][n] = __builtin_amdgcn_mfma_f32_16x16x32_bf16(Bf[n][k], At[m][k], acc[m][n], 0, 0, 0); }
        asm volatile("s_waitcnt vmcnt(0)" ::: "memory"); __syncthreads();
    }
#undef SG_ISSUE
    E(acc, m0 + wr * 64 + fr, n0 + wc * 32 + 4 * fq, (n0 >> 7) * 4 + wc, fq);
}
struct SgRes {
    const float* xs; bf16_t* Cb; float* ssqS;
    __device__ __forceinline__ void operator()(const f32x4 (&acc)[4][2], int row0, int col0, int slot, int fq) const {
#pragma unroll
        for (int m = 0; m < 4; ++m) { const int row = row0 + 16 * m; float ss = 0.f;
#pragma unroll
            for (int n = 0; n < 2; ++n) { const int col = col0 + 16 * n; const f32x4 v = acc[m][n] + *(const f32x4*)(xs + (size_t)row * 1024 + col); ss += v[0] * v[0] + v[1] * v[1] + v[2] * v[2] + v[3] * v[3];
                u32x2 w; w.x = cvt_pk_bf16(v[0], v[1]); w.y = cvt_pk_bf16(v[2], v[3]); *(u32x2*)(Cb + (size_t)(TP + row) * 1024 + col) = w; }
            ss += __shfl_xor(ss, 16); ss += __shfl_xor(ss, 32); if (fq == 0) ssqS[(size_t)row * 32 + slot] = ss; } }
};
struct SgUp {
    bf16_t* O; const float* ssqS;
    __device__ __forceinline__ void operator()(const f32x4 (&acc)[4][2], int row0, int col0, int slot, int fq) const {
#pragma unroll
        for (int m = 0; m < 4; ++m) { const int row = row0 + 16 * m; const f32x4* sp = (const f32x4*)(ssqS + (size_t)row * 32); f32x4 t = sp[0];
#pragma unroll
            for (int q = 1; q < 8; ++q) t += sp[q];
            const float rs = rsqrtf((t[0] + t[1] + t[2] + t[3]) * (1.f / 1024.f) + 1e-6f), rs2 = rs * rs;
#pragma unroll
            for (int n = 0; n < 2; ++n) { float v[4];
#pragma unroll
                for (int j = 0; j < 4; ++j) { const float q = fmaxf(acc[m][n][j], 0.f); v[j] = q * q * rs2; }
                u32x2 w; w.x = cvt_pk_bf16(v[0], v[1]); w.y = cvt_pk_bf16(v[2], v[3]); *(u32x2*)(O + (size_t)(TP + row) * 4096 + col0 + 16 * n) = w; } } }
};
struct SgSlab {
    float* C;
    __device__ __forceinline__ void operator()(const f32x4 (&acc)[4][2], int row0, int col0, int slot, int fq) const {
#pragma unroll
        for (int m = 0; m < 4; ++m)
#pragma unroll
            for (int n = 0; n < 2; ++n) *(f32x4*)(C + (size_t)(row0 + 16 * m) * 1024 + col0 + 16 * n) = acc[m][n]; }
};
#ifndef REP_P0
#define REP_P0 1
#endif
#ifndef REP_P1
#define REP_P1 1
#endif
#ifndef REP_P2
#define REP_P2 1
#endif
#ifndef REP_P6
#define REP_P6 1
#endif
#ifndef REP_P7
#define REP_P7 1
#endif
#ifndef REP_P8
#define REP_P8 1
#endif
#ifndef REP_P9
#define REP_P9 1
#endif
#ifndef REP_CB
#define REP_CB 1
#endif
#ifndef REP_TC
#define REP_TC 1
#endif
#ifndef REP_AP
#define REP_AP 1
#endif
#ifndef REP_AS
#define REP_AS 1
#endif
#ifndef REP_S2
#define REP_S2 1
#endif
#ifndef REP_SS
#define REP_SS 1
#endif
#ifndef REP_S1
#define REP_S1 1
#endif
__global__ void __launch_bounds__(512, 2) mega(P p) {
    extern __shared__ __attribute__((aligned(16))) unsigned char lds[];
    LAS unsigned char* ldsl = (LAS unsigned char*)lds;
    if (threadIdx.x < 4) ((volatile LAS unsigned*)(ldsl + LDS_XB))[threadIdx.x] = 0u;
    __syncthreads();
    XcdBarrier bar = xcd_barrier_post((unsigned*)(p.ws + W_CTL), (volatile LAS unsigned*)(ldsl + LDS_XB));
    const int lo = p.ph_lo, hi = p.ph_hi;
#define IN(k) (lo <= (k) && (k) < hi)
#ifdef PROF_SEAM
    unsigned long long prof_t0 = __builtin_amdgcn_s_memrealtime(), prof_tk = 0ull;
#define SEAM(k) do { if (IN(k) && IN((k) + 1)) xcd_barrier(bar); if ((k) == PROF_SEAM) prof_tk = __builtin_amdgcn_s_memrealtime(); } while (0)
#else
#define SEAM(k) do { if (IN(k) && IN((k) + 1)) xcd_barrier(bar); } while (0)
#endif
    if (IN(0)) { for (int rep_ = 0; rep_ < REP_P0; ++rep_) { __syncthreads(); phase_prep(p, lds); } }
    SEAM(0);
    if (IN(1)) for (int rep_ = 0; rep_ < REP_P1; ++rep_) { pg8::Gemm g{(const bf16_t*)(p.ws + W_HN), (const bf16_t*)(p.ws + W_BIN), T, 2304, 1024}; pg8::StaticOrder S; S.init(T, 2304, gridDim.x, (int)blockIdx.x);
        pg8::EpiBf16<0> E{(bf16_t*)(p.ws + W_PROJ), 2304, nullptr, 0, 0}; pg8::gemm_phase<pg8::EpiBf16<0>, pg8::StaticOrder>(ldsl, g, S, E, nullptr);
        if (blockIdx.x >= 100) tconv_run(p, lds, 340 + (int)blockIdx.x - 100, 1120, 156); }
    SEAM(1);
    if (IN(2)) { for (int rep_ = 0; rep_ < REP_P2; ++rep_) phase_thin(p); }
    SEAM(2);
    if (IN(3)) {
        const float qscale = 0.14724418f;
        const bf16_t* qn = (const bf16_t*)(p.ws + W_QN); const float* rope = (const float*)(p.ws + W_ROPE);
        if (blockIdx.x < 128) { for (int rep_ = 0; rep_ < REP_S1; ++rep_) phase_ssd_pass1(p, ldsl); __syncthreads(); }
        else { pg8::Gemm g{(const bf16_t*)(p.ws + W_CB), (const bf16_t*)(p.ws + W_BKV), TP, 1024, 256}; pg8::StaticOrder S; S.init(TP, 1024, 128, (int)blockIdx.x - 128);
          EpiKV E{(bf16_t*)(p.ws + W_KP), (bf16_t*)(p.ws + W_VP)}; pg8::gemm_phase<EpiKV, pg8::StaticOrder>(ldsl, g, S, E, nullptr); }
        asm volatile("" ::: "memory"); __builtin_amdgcn_sched_barrier(0);
        { pg8::Gemm g{qn, (const bf16_t*)(p.ws + W_BUQP), TP, 768, 384}; pg8::StaticOrder S; S.init(TP, 768, gridDim.x, (int)blockIdx.x);
          EpiQ<96, 64, 0> E{(bf16_t*)(p.ws + W_QP), 768, rope, qscale}; pg8::gemm_phase<EpiQ<96, 64, 0>, pg8::StaticOrder>(ldsl, g, S, E, nullptr); }
        asm volatile("" ::: "memory"); __builtin_amdgcn_sched_barrier(0);
        { pg8::Gemm g{qn + (size_t)TP * 384, (const bf16_t*)(p.ws + W_BQS), TS, 2304, 384}; pg8::StaticOrder S; S.init(TS, 2304, gridDim.x, (int)((blockIdx.x + 64) & 255));
          EpiQ<288, 256, 1> E{(bf16_t*)(p.ws + W_QS), 2304, rope, qscale}; pg8::gemm_phase<EpiQ<288, 256, 1>, pg8::StaticOrder>(ldsl, g, S, E, nullptr); }
    }
    SEAM(3);
    if (IN(5)) { const bool odd = (blockIdx.x >> 3) & 1;
        phase_ssd_scan(p);
        if (odd) { for (int rep_ = 0; rep_ < REP_AS; ++rep_) phase_attn_sample(p, ldsl); }
        for (int rep_ = 0; rep_ < REP_AP; ++rep_) phase_attn_prompt(p, ldsl);
        __syncthreads();
        for (int rep_ = 0; rep_ < REP_SS; ++rep_) phase_ssd_sample(p, ldsl);
        if (!odd) { for (int rep_ = 0; rep_ < REP_AS; ++rep_) phase_attn_sample(p, ldsl); } }
    SEAM(5);
    if (IN(6)) { if (blockIdx.x < 128) { phase_sample_combine(p, ldsl); tconv_run(p, lds, 1120 + (int)blockIdx.x, 1492, 128); }
        else { for (int rep_ = 0; rep_ < REP_S2; ++rep_) phase_ssd_pass2(p, ldsl); } }
    SEAM(6);
    if (IN(7)) for (int rep_ = 0; rep_ < REP_P6; ++rep_) { const bf16_t* catp = (const bf16_t*)(p.ws + W_CAT); const bf16_t* Bo = (const bf16_t*)(p.ws + W_BOUT);
        { pg8::Gemm g{catp, Bo, TP, 1024, 1024}; pg8::StaticOrder S; S.init(TP, 1024, gridDim.x, (int)blockIdx.x);
          EpiRes<false> E{p.x_p, p.x_s, (bf16_t*)(p.ws + W_X1B), (float*)(p.ws + W_SSQ1)}; pg8::gemm_phase<EpiRes<false>, pg8::StaticOrder>(ldsl, g, S, E, nullptr); }
        if (blockIdx.x >= 192) { const int c_ = (int)blockIdx.x - 192; SgRes E{p.x_s, (bf16_t*)(p.ws + W_X1B), (float*)(p.ws + W_SSQS)};
            sg_tile(ldsl, catp + (size_t)TP * 1024, 1024, Bo, 1024, 1024, (c_ >> 3) * 128, (c_ & 7) * 128, E); } }
    SEAM(7);
    if (IN(8)) for (int rep_ = 0; rep_ < REP_P7; ++rep_) { const bf16_t* x1b = (const bf16_t*)(p.ws + W_X1B); const bf16_t* Bu = (const bf16_t*)(p.ws + W_BUP);
        { pg8::Gemm g{x1b, Bu, TP, 4096, 1024}; pg8::StaticOrder S; S.init(TP, 4096, gridDim.x, (int)blockIdx.x);
          LAS float* rsl = (LAS float*)(ldsl + 131072);
          { pg8::Unit u0; S.next(0, u0); const int t_ = pg8::opaque_tid();
            if (t_ < 256) { const f32x4* sp = (const f32x4*)((const float*)(p.ws + W_SSQ1) + (size_t)(u0.pm * 256 + t_) * 16); const f32x4 a = sp[0], b = sp[1], c = sp[2], d = sp[3];
                const float tot = (a[0] + a[1] + a[2] + a[3]) + (b[0] + b[1] + b[2] + b[3]) + (c[0] + c[1] + c[2] + c[3]) + (d[0] + d[1] + d[2] + d[3]);
                const float rs = rsqrtf(tot * (1.f / 1024.f) + 1e-6f); rsl[t_] = rs * rs; }
            __syncthreads(); }
          EpiUp E{(bf16_t*)(p.ws + W_U), rsl}; pg8::gemm_phase<EpiUp, pg8::StaticOrder>(ldsl, g, S, E, nullptr); }
        { const int c_ = (int)blockIdx.x & 255; SgUp E{(bf16_t*)(p.ws + W_U), (const float*)(p.ws + W_SSQS)};
          sg_tile(ldsl, x1b + (size_t)TP * 1024, 1024, Bu, 1024, 1024, (c_ >> 5) * 128, (c_ & 31) * 128, E); } }
    SEAM(8);
    if (IN(9)) for (int rep_ = 0; rep_ < REP_P8; ++rep_) { const bf16_t* U = (const bf16_t*)(p.ws + W_U); const bf16_t* Bd = (const bf16_t*)(p.ws + W_BDOWN); const bf16_t* x1 = (const bf16_t*)(p.ws + W_X1B);
        { pg8::Gemm g{U, Bd, TP, 1024, 4096}; pg8::StaticOrder S; S.init(TP, 1024, gridDim.x, (int)blockIdx.x);
          EpiRes<true> E{x1, x1, (bf16_t*)(p.ws + W_X2B), (float*)(p.ws + W_SSQ2)}; pg8::gemm_phase<EpiRes<true>, pg8::StaticOrder>(ldsl, g, S, E, nullptr); }
        { const int c_ = (int)blockIdx.x & 255, sl = c_ & 3, tile = c_ >> 2; SgSlab E{(float*)(p.ws + W_SLAB) + (size_t)sl * 1024 * 1024};
          sg_tile(ldsl, U + (size_t)TP * 4096 + sl * 1024, 4096, Bd + sl * 1024, 4096, 1024, (tile >> 3) * 128, (tile & 7) * 128, E); } }
    SEAM(9);
    if (IN(10)) { for (int rep_ = 0; rep_ < REP_P9; ++rep_) phase_final(p); }
#ifdef PROF_SEAM
    if (blockIdx.x == 0 && threadIdx.x == 0) { const unsigned long long te = __builtin_amdgcn_s_memrealtime(), wait = (prof_tk - prof_t0) * 8ull;
        while (__builtin_amdgcn_s_memrealtime() - te < wait) __builtin_amdgcn_s_sleep(8); }
#endif
#ifdef PROF_SEC
    if (blockIdx.x == 135 && threadIdx.x == 0) { const unsigned long long te = __builtin_amdgcn_s_memrealtime(), wait = *(volatile unsigned long long*)(p.ws + W_CTL + 8192) * 32ull;
        while (__builtin_amdgcn_s_memrealtime() - te < wait) __builtin_amdgcn_s_sleep(8); }
#endif
#undef IN
#undef SEAM
}

static void fill_params(P& p, void* const* d_in, float* out, unsigned char* ws) {
    p.x_p = (const float*)d_in[0]; p.x_s = (const float*)d_in[1]; p.ckv = (const float*)d_in[2]; p.ckr = (const float*)d_in[3]; p.st_ssm = (const float*)d_in[4]; p.st_conv = (const float*)d_in[5];
    p.pt = (const int*)d_in[6]; p.norm_attn = (const float*)d_in[7]; p.w_in = (const float*)d_in[8]; p.q_norm = (const float*)d_in[9]; p.kv_norm = (const float*)d_in[10]; p.w_uq = (const float*)d_in[11];
    p.w_uk = (const float*)d_in[12]; p.w_uv = (const float*)d_in[13]; p.conv_w = (const float*)d_in[14]; p.conv_b = (const float*)d_in[15]; p.dt_bias = (const float*)d_in[16]; p.a_log = (const float*)d_in[17];
    p.d_skip = (const float*)d_in[18]; p.ssm_norm = (const float*)d_in[19]; p.w_out = (const float*)d_in[20]; p.norm_mlp = (const float*)d_in[21]; p.w_up = (const float*)d_in[22]; p.w_down = (const float*)d_in[23];
    p.norm_final = (const float*)d_in[24]; p.out = out; p.ws = ws;
}
static bool launch(void* const* d_in, float* out, unsigned char* ws, int ph_lo, int ph_hi, hipStream_t stream) {
    static int ready = 0;
    if (!ready) {
        if (hipFuncSetAttribute((const void*)mega, hipFuncAttributeMaxDynamicSharedMemorySize, LDS_BYTES) != hipSuccess) { fprintf(stderr, "mk: hipFuncSetAttribute failed\n"); ready = -1; }
        else { int per_cu = 0; if (hipOccupancyMaxActiveBlocksPerMultiprocessor(&per_cu, (const void*)mega, 512, LDS_BYTES) != hipSuccess || per_cu < 1) fprintf(stderr, "mk: occupancy query says %d\n", per_cu); (void)hipGetLastError(); ready = 1; }
    }
    if (ready < 0) return false;
    hipMemsetAsync(ws + W_CTL, 0, 16384, stream);
    P p{}; fill_params(p, d_in, out, ws); p.ph_lo = ph_lo; p.ph_hi = ph_hi;
    hipLaunchKernelGGL(mega, dim3(256), dim3(512), LDS_BYTES, stream, p);
    return hipPeekAtLastError() == hipSuccess;
}
}
extern "C" void kernel_launch(void* const* d_in, const int* in_sizes, int n_in, void* d_out, int out_size, void* d_ws, size_t ws_size, hipStream_t stream) {
    if (n_in != 25 || out_size != (int)mk::O_TOTAL || ws_size < mk::W_END) { fprintf(stderr, "kernel_launch: unexpected shapes (n_in %d, out %d, ws %zu)\n", n_in, out_size, ws_size); return; }
    mk::launch(d_in, (float*)d_out, (unsigned char*)d_ws, 0, 11, stream);
}
```

```cpp
#include <hip/hip_runtime.h>
#include <cstdio>
#include <cstdint>
#define XB_TMO      128
#define XB_XCNT(j)  (256  + 64 * (j))
#define XB_XSUB(j)  (1280 + 64 * (j))
#define XB_XGEN(j)  (2304 + 64 * (j))
#define XB_TOP      3328
#define XB_TOPGEN   3392
#define XCD_BAR_WORDS 3456
#define XB_SPIN_CAP (1u << 18)
#define LAS __attribute__((address_space(3)))

__device__ __forceinline__ unsigned xb_ld(unsigned* p)              { return __hip_atomic_load(p, __ATOMIC_RELAXED, __HIP_MEMORY_SCOPE_AGENT); }
__device__ __forceinline__ unsigned xb_add(unsigned* p, unsigned v) { return __hip_atomic_fetch_add(p, v, __ATOMIC_RELAXED, __HIP_MEMORY_SCOPE_AGENT); }
__device__ __forceinline__ unsigned xb_xcc_id() { return (unsigned)__builtin_amdgcn_s_getreg((3 << 11) | 20) & 0xFu; }
#define XB_SPIN(cond, bar) do { unsigned _sp = 0; while (cond) { __builtin_amdgcn_s_sleep(1); \
    if ((++_sp & 255u) == 0u) { if (xb_ld(&(bar)[XB_TMO])) break; if (_sp > XB_SPIN_CAP) { atomicAdd(&(bar)[XB_TMO], 1u); break; } } } } while (0)

struct XcdBarrier {
    unsigned* bar; unsigned x;
    volatile LAS unsigned* st;
};

__device__ __forceinline__ XcdBarrier xcd_barrier_post(unsigned* bar, volatile LAS unsigned* st) {
    XcdBarrier b; b.bar = bar; b.x = xb_xcc_id(); b.st = st;
    if (threadIdx.x == 0) (void)xb_add(&bar[XB_XCNT(b.x)], 1u);
    return b;
}
__device__ __forceinline__ void xcd_barrier_complete(unsigned* bar, unsigned x, unsigned& nloc, unsigned& nx) {
    const unsigned G = gridDim.x * gridDim.y * gridDim.z;
    unsigned sum, cnt, mine, sp = 0u;
    for (;;) {
        sum = 0u; cnt = 0u; mine = 0u;
#pragma unroll
        for (unsigned j = 0; j < 16; ++j) { const unsigned c = xb_ld(&bar[XB_XCNT(j)]); sum += c; cnt += (c > 0u) ? 1u : 0u; mine = (j == x) ? c : mine; }
        if (sum == G) break;
        __builtin_amdgcn_s_sleep(1);
        if ((++sp & 255u) == 0u) { if (xb_ld(&bar[XB_TMO])) break; if (sp > XB_SPIN_CAP) { atomicAdd(&bar[XB_TMO], 1u); break; } }
    }
    nloc = mine > 0u ? mine : 1u; nx = cnt > 0u ? cnt : 1u;
}

__device__ __forceinline__ void xcd_barrier(const XcdBarrier& b) {
    asm volatile("s_waitcnt vmcnt(0)" ::: "memory");
    __syncthreads();
    if (threadIdx.x == 0) {
        unsigned* bar = b.bar;
        __builtin_amdgcn_s_waitcnt(0);
        unsigned nloc = b.st[0], nx = b.st[1];
        if (nloc == 0u) { xcd_barrier_complete(bar, b.x, nloc, nx); b.st[0] = nloc; b.st[1] = nx; }
        const unsigned old = xb_add(&bar[XB_XSUB(b.x)], 1u);
        const unsigned gen = old / nloc;
        if (old + 1u == (gen + 1u) * nloc) {
            __builtin_amdgcn_fence(__ATOMIC_RELEASE, "agent");
            asm volatile("s_waitcnt vmcnt(0)" ::: "memory");
            const unsigned og = xb_add(&bar[XB_TOP], 1u);
            const unsigned tg = og / nx;
            if (og + 1u == (tg + 1u) * nx) xb_add(&bar[XB_TOPGEN], 1u);
            else XB_SPIN(xb_ld(&bar[XB_TOPGEN]) == tg, bar);
            __builtin_amdgcn_fence(__ATOMIC_ACQUIRE, "agent");
            xb_add(&bar[XB_XGEN(b.x)], 1u);
            asm volatile("s_waitcnt vmcnt(0)" ::: "memory");
        } else {
            XB_SPIN(xb_ld(&bar[XB_XGEN(b.x)]) == gen, bar);
            __builtin_amdgcn_fence(__ATOMIC_ACQUIRE, "agent");
            asm volatile("s_waitcnt vmcnt(0)" ::: "memory");
        }
    }
    __syncthreads();
}
namespace pg8 {
__device__ __forceinline__ int opaque_tid() { int t; asm volatile("v_mov_b32 %0, %1" : "=v"(t) : "v"((int)threadIdx.x)); return t; }
#define PG8_LAS __attribute__((address_space(3)))
typedef unsigned short bf16_t;
typedef short bf16x8 __attribute__((ext_vector_type(8)));
typedef float f32x4 __attribute__((ext_vector_type(4)));
typedef unsigned u32x4 __attribute__((ext_vector_type(4)));
constexpr int BM = 256, BK = 64, HALF = 128, HTB = HALF * BK * 2  , STAGE_BYTES = 8 * HTB, NXCD = 8, WGM = 8;

__host__ __device__ __forceinline__ int lds_byte(int r, int c) { const int st = (r >> 4) * 2 + (c >> 5), rr = r & 15, cc = c & 31, ob = rr * 64 + cc * 2; return st * 1024 + (ob ^ (((ob >> 9) & 1) << 5)); }
__host__ __device__ __forceinline__ void stage_rc(int b, int& R, int& C) { const int st = b / 1024, sb = b % 1024, swz = sb ^ (((sb >> 9) & 1) << 5); R = (st >> 1) * 16 + swz / 64; C = (st & 1) * 32 + (swz % 64) / 2; }
__host__ __device__ __forceinline__ int perm32(int rho) { const int n = rho >> 4, i = rho & 15; return 8 * (i >> 2) + 4 * n + (i & 3); }

struct Unit { int pm, pn; };
struct Gemm { const bf16_t* A; const bf16_t* Bt; int M, N, K; int ldk = 0; };

struct StaticOrder {
    int nM, nN, nwg, G, c;
    __host__ __device__ __forceinline__ void init(int M, int N, int G_, int c_) { nM = M / BM; nN = N / BM; nwg = nM * nN; G = G_; c = c_; }
    __host__ __device__ __forceinline__ bool next(int i, Unit& u) const {
        const long L = (long)i * G + c; if (L >= nwg) return false;
        int wgid = (int)L; { const int q = nwg / NXCD, r = nwg % NXCD, xcd = wgid % NXCD, off = wgid / NXCD; wgid = (xcd < r ? xcd * (q + 1) : r * (q + 1) + (xcd - r) * q) + off; }
        const int nig = WGM * nN, gid = wgid / nig, fm = gid * WGM, gsz = (nM - fm) < WGM ? (nM - fm) : WGM;
        u.pm = fm + ((wgid % nig) % gsz); u.pn = (wgid % nig) / gsz; return true;
    }
    __device__ __forceinline__ void a_ready(const Unit&) const {}
    __device__ __forceinline__ void done(const Unit&) const {}
};

__device__ __forceinline__ unsigned cvt_pk_bf16(float lo, float hi) { unsigned r; asm volatile("v_cvt_pk_bf16_f32 %0, %1, %2" : "=v"(r) : "v"(lo), "v"(hi)); return r; }
typedef float f32x2 __attribute__((ext_vector_type(2)));

struct EpiF32 {
    static constexpr bool PERM = false, AFTER_DRAIN = false;
    float* C; int ldc; const float* bias;
    __device__ __forceinline__ void operator()(const f32x4 (&acc)[2][2][4][2], const Unit& u, int wr, int wc, int fr, int fq) const {
        const int row0 = u.pm * BM + wr * 64 + fr, col0 = u.pn * BM + wc * 32 + 4 * fq;
        f32x4 bv[2][2];
#pragma unroll
        for (int bj = 0; bj < 2; ++bj)
#pragma unroll
            for (int n = 0; n < 2; ++n) bv[bj][n] = bias ? *(const f32x4*)(bias + col0 + bj * HALF + n * 16) : (f32x4){0.f, 0.f, 0.f, 0.f};
#pragma unroll
        for (int ai = 0; ai < 2; ++ai)
#pragma unroll
            for (int m = 0; m < 4; ++m) { float* rowp = C + (size_t)(row0 + ai * HALF + m * 16) * ldc + col0;
#pragma unroll
                for (int bj = 0; bj < 2; ++bj)
#pragma unroll
                    for (int n = 0; n < 2; ++n) *(f32x4*)(rowp + bj * HALF + n * 16) = acc[ai][bj][m][n] + bv[bj][n]; }
    }
};
template <int ACT  > struct EpiBf16 {
    static constexpr bool PERM = true, AFTER_DRAIN = false;
    bf16_t* O; int ldc; const float* bias; int split_cols; size_t split_stride;
    __device__ __forceinline__ void operator()(const f32x4 (&acc)[2][2][4][2], const Unit& u, int wr, int wc, int fr, int fq) const {
        const int row0 = u.pm * BM + wr * 64 + fr; int colt = u.pn * BM; bf16_t* base = O;
        if (split_cols) { const int t = colt / split_cols; base += (size_t)t * split_stride; colt -= t * split_cols; }
        const int col0 = colt + wc * 32 + 8 * fq, bcol0 = u.pn * BM + wc * 32 + 8 * fq;
        f32x4 bv[2][2];
#pragma unroll
        for (int bj = 0; bj < 2; ++bj)
#pragma unroll
            for (int n = 0; n < 2; ++n) bv[bj][n] = bias ? *(const f32x4*)(bias + bcol0 + bj * HALF + 4 * n) : (f32x4){0.f, 0.f, 0.f, 0.f};
#pragma unroll
        for (int ai = 0; ai < 2; ++ai)
#pragma unroll
            for (int m = 0; m < 4; ++m) { bf16_t* rowp = base + (size_t)(row0 + ai * HALF + m * 16) * ldc + col0;
#pragma unroll
                for (int bj = 0; bj < 2; ++bj) { f32x4 v0 = acc[ai][bj][m][0] + bv[bj][0], v1 = acc[ai][bj][m][1] + bv[bj][1];
                    u32x4 w; w.x = cvt_pk_bf16(v0[0], v0[1]); w.y = cvt_pk_bf16(v0[2], v0[3]); w.z = cvt_pk_bf16(v1[0], v1[1]); w.w = cvt_pk_bf16(v1[2], v1[3]);
                    *(u32x4*)(rowp + bj * HALF) = w; } }
    }
};

template <class Epi, class Sched, bool STAMP = false>
__device__ __forceinline__ void gemm_phase(PG8_LAS unsigned char* lds, const Gemm g, const Sched& S, const Epi& E, unsigned long long* stamps) {
    const int tid = opaque_tid(), wid = __builtin_amdgcn_readfirstlane(tid >> 6), lane = tid & 63, wr = wid >> 2, wc = wid & 3, fr = lane & 15, fq = lane >> 4;
    const int nt = g.K / BK, K = g.ldk ? g.ldk : g.K;
    int ts_lo = 0, ts_hi = 0, nts = 0; const unsigned long long rt_entry = STAMP ? (unsigned long long)wall_clock64() : 0ull;
#define PG8_STAMP() do { if (STAMP && wid == 0 && nts < 64) { const unsigned long long _c = (unsigned long long)clock64(); \
        ts_lo = (lane == nts) ? (int)(unsigned)_c : ts_lo; ts_hi = (lane == nts) ? (int)(unsigned)(_c >> 32) : ts_hi; ++nts; } } while (0)
    PG8_STAMP();
    unsigned voffA[2], voffB[2];
#pragma unroll
    for (int i = 0; i < 2; ++i) { int R, C; stage_rc(tid * 16 + i * 8192, R, C); const int Rb = Epi::PERM ? ((R & ~31) + perm32(R & 31)) : R;
        voffA[i] = (unsigned)(R * K + C) * 2u; voffB[i] = (unsigned)(Rb * K + C) * 2u; }
    const size_t kstep = (size_t)(BK * 2);
    const size_t hstep = (size_t)HALF * K * 2;
    const size_t tstep = 2 * hstep;
    const unsigned ldsw = (unsigned)wid * 1024u;
    const int aoff = lds_byte(wr * 64 + fr, fq * 8), boff = lds_byte(wc * 32 + fr, fq * 8);
#define PG8_SA(b, h) (((b) * 2 + (h)) * HTB)
#define PG8_SB(b, h) ((4 + (b) * 2 + (h)) * HTB)
#define PG8_STAGE(bufoff, gbase, voff) do { _Pragma("unroll") for (int _i = 0; _i < 2; ++_i) \
        __builtin_amdgcn_global_load_lds((const unsigned*)((const char*)(gbase) + (voff)[_i]), (PG8_LAS unsigned*)(lds + (bufoff) + ldsw + _i * 8192), 16, 0, 0); } while (0)
#define PG8_LDA(dst, b, h) do { _Pragma("unroll") for (int m = 0; m < 4; ++m) _Pragma("unroll") for (int k = 0; k < 2; ++k) dst[m][k] = *(const PG8_LAS bf16x8*)(lds + PG8_SA(b, h) + aoff + m * 2048 + k * 1024); } while (0)
#define PG8_LDB(dst, b, h) do { _Pragma("unroll") for (int n = 0; n < 2; ++n) _Pragma("unroll") for (int k = 0; k < 2; ++k) dst[n][k] = *(const PG8_LAS bf16x8*)(lds + PG8_SB(b, h) + boff + n * 2048 + k * 1024); } while (0)
#define PG8_MMA(ai, bj, At, Bt) do { __builtin_amdgcn_s_setprio(1); _Pragma("unroll") for (int m = 0; m < 4; ++m) _Pragma("unroll") for (int n = 0; n < 2; ++n) _Pragma("unroll") for (int k = 0; k < 2; ++k) \
        acc[ai][bj][m][n] = __builtin_amdgcn_mfma_f32_16x16x32_bf16(Bt[n][k], At[m][k], acc[ai][bj][m][n], 0, 0, 0); __builtin_amdgcn_s_setprio(0); } while (0)
#define PG8_WAIT_V(n) asm volatile("s_waitcnt vmcnt(" #n ")" ::: "memory")
#define PG8_WAIT_L(n) asm volatile("s_waitcnt lgkmcnt(" #n ")" ::: "memory")
#define PG8_BAR __builtin_amdgcn_s_barrier()
#define PG8_SCHED __builtin_amdgcn_sched_barrier(0)
    Unit cur, nxt; int ui = 0;
    if (!S.next(0, cur)) return;
    f32x4 acc[2][2][4][2];
#pragma unroll
    for (int a = 0; a < 2; ++a)
#pragma unroll
        for (int b = 0; b < 2; ++b)
#pragma unroll
            for (int m = 0; m < 4; ++m)
#pragma unroll
                for (int n = 0; n < 2; ++n) acc[a][b][m][n] = (f32x4){0.f, 0.f, 0.f, 0.f};
    bf16x8 At[4][2], B0[2][2], B1[2][2];
    const char* cA = (const char*)g.A + (size_t)cur.pm * tstep; const char* cB = (const char*)g.Bt + (size_t)cur.pn * tstep;
    S.a_ready(cur);
    PG8_STAGE(PG8_SB(0, 0), cB, voffB); PG8_STAGE(PG8_SA(0, 0), cA, voffA); PG8_STAGE(PG8_SB(0, 1), cB + hstep, voffB); PG8_STAGE(PG8_SA(0, 1), cA + hstep, voffA);
    if (wr == 1) PG8_BAR;
    PG8_WAIT_V(4); PG8_BAR;
    PG8_STAGE(PG8_SB(1, 0), cB + kstep, voffB); PG8_STAGE(PG8_SA(1, 0), cA + kstep, voffA); PG8_STAGE(PG8_SB(1, 1), cB + hstep + kstep, voffB);
    PG8_WAIT_V(6); PG8_BAR;
    PG8_STAMP();
    for (;;) {
        const bool has_next = S.next(ui + 1, nxt);
        const char* nA = has_next ? (const char*)g.A + (size_t)nxt.pm * tstep : cA; const char* nB = has_next ? (const char*)g.Bt + (size_t)nxt.pn * tstep : cB;
        for (int t = 0; t < nt; t += 2) {
            const bool last = (t == nt - 2);
            const char* a1 = cA + (size_t)(t + 1) * kstep;
            const char* a2 = last ? nA : cA + (size_t)(t + 2) * kstep; const char* b2 = last ? nB : cB + (size_t)(t + 2) * kstep;
            const char* a3 = a2 + kstep; const char* b3 = b2 + kstep;
            if (last && has_next) S.a_ready(nxt);
            PG8_LDB(B0, 0, 0); PG8_SCHED; PG8_LDA(At, 0, 0); PG8_STAGE(PG8_SA(1, 1), a1 + hstep, voffA);
            PG8_WAIT_L(8); PG8_BAR; PG8_WAIT_L(0); PG8_MMA(0, 0, At, B0); PG8_BAR; PG8_SCHED;
            PG8_LDB(B1, 0, 1); PG8_STAGE(PG8_SB(0, 0), b2, voffB);
            PG8_BAR; PG8_WAIT_L(0); PG8_MMA(0, 1, At, B1); PG8_BAR;
            PG8_LDA(At, 0, 1); PG8_STAGE(PG8_SA(0, 0), a2, voffA);
            PG8_BAR; PG8_WAIT_L(0); PG8_MMA(1, 0, At, B0); PG8_BAR; PG8_SCHED;
            PG8_STAGE(PG8_SB(0, 1), b2 + hstep, voffB);
            PG8_WAIT_V(6); PG8_BAR; PG8_MMA(1, 1, At, B1); PG8_BAR;
            PG8_LDB(B0, 1, 0); PG8_SCHED; PG8_LDA(At, 1, 0); PG8_STAGE(PG8_SA(0, 1), a2 + hstep, voffA);
            PG8_WAIT_L(8); PG8_BAR; PG8_WAIT_L(0); PG8_MMA(0, 0, At, B0); PG8_BAR; PG8_SCHED;
            PG8_LDB(B1, 1, 1); PG8_STAGE(PG8_SB(1, 0), b3, voffB);
            PG8_BAR; PG8_WAIT_L(0); PG8_MMA(0, 1, At, B1); PG8_BAR;
            PG8_LDA(At, 1, 1); PG8_STAGE(PG8_SA(1, 0), a3, voffA);
            PG8_BAR; PG8_WAIT_L(0); PG8_MMA(1, 0, At, B0); PG8_BAR; PG8_SCHED;
            PG8_STAGE(PG8_SB(1, 1), b3 + hstep, voffB);
            PG8_WAIT_V(6); PG8_BAR; PG8_MMA(1, 1, At, B1); PG8_BAR;
        }
        PG8_STAMP();
        if constexpr (!Epi::AFTER_DRAIN) { E(acc, cur, wr, wc, fr, fq); S.done(cur); }
        PG8_STAMP();
        if (!has_next) break;
#pragma unroll
        for (int a = 0; a < 2; ++a)
#pragma unroll
            for (int b = 0; b < 2; ++b)
#pragma unroll
                for (int m = 0; m < 4; ++m)
#pragma unroll
                    for (int n = 0; n < 2; ++n) acc[a][b][m][n] = (f32x4){0.f, 0.f, 0.f, 0.f};
        cur = nxt; cA = nA; cB = nB; ++ui;
    }
    PG8_WAIT_V(0);
    if (wr == 0) PG8_BAR;
    PG8_BAR;
    if constexpr (Epi::AFTER_DRAIN) { E.fused(acc, cur, wr, wc, fr, fq, lds, wid, lane); S.done(cur); }
    PG8_STAMP();
    if (STAMP && wid == 0) { stamps[lane] = lane < nts ? (((unsigned long long)(unsigned)ts_hi << 32) | (unsigned)ts_lo) : 0ull;
        if (lane == 62) stamps[62] = rt_entry; if (lane == 63) stamps[63] = (unsigned long long)wall_clock64(); }
#undef PG8_STAMP
#undef PG8_SA
#undef PG8_SB
#undef PG8_STAGE
#undef PG8_LDA
#undef PG8_LDB
#undef PG8_MMA
#undef PG8_WAIT_V
#undef PG8_WAIT_L
#undef PG8_BAR
#undef PG8_SCHED
}
}
namespace mk {
using pg8::bf16_t; using pg8::bf16x8; using pg8::f32x4; using pg8::u32x4; using pg8::cvt_pk_bf16;
typedef float f32x16 __attribute__((ext_vector_type(16)));
typedef short s16x4 __attribute__((ext_vector_type(4)));
typedef unsigned u32x2 __attribute__((ext_vector_type(2)));
constexpr int T = 17408, TP = 16384, TS = 1024, NPOS = 2056;
constexpr long O_Y_P = 0, O_Y_S = 16777216, O_KV_P = 17825792, O_KR_P = 22020096, O_SSM_P = 22544384, O_CONV_P = 23068672,
               O_KV_S = 23093248, O_KR_S = 23355392, O_SSM_S = 23388160, O_CONV_S = 31776768, O_TOTAL = 32169984;
constexpr int LDS_BYTES = 147456;
constexpr int LDS_XB = LDS_BYTES - 16;

constexpr size_t al(size_t x) { return (x + 255) & ~(size_t)255; }
constexpr size_t W_CTL = 0;
constexpr size_t W_ROPE = 16384;
constexpr size_t W_BIN = W_ROPE + al((size_t)NPOS * 32 * 4);
constexpr size_t W_BUQP = W_BIN + (size_t)2304 * 1024 * 2;
constexpr size_t W_BQS = W_BUQP + (size_t)768 * 384 * 2;
constexpr size_t W_BKV = W_BQS + (size_t)2304 * 384 * 2;
constexpr size_t W_BOUT = W_BKV + (size_t)1024 * 256 * 2;
constexpr size_t W_BUP = W_BOUT + (size_t)1024 * 1024 * 2;
constexpr size_t W_BDOWN = W_BUP + (size_t)4096 * 1024 * 2;
constexpr size_t W_HN = W_BDOWN + (size_t)1024 * 4096 * 2;
constexpr size_t W_PROJ = W_HN + (size_t)T * 1024 * 2;
constexpr size_t W_QN = W_PROJ + (size_t)T * 2304 * 2;
constexpr size_t W_CB = W_QN + (size_t)T * 384 * 2;
constexpr size_t W_KP = W_CB + (size_t)T * 256 * 2;
constexpr size_t W_VP = W_KP + (size_t)TP * 768 * 2;
constexpr size_t W_QP = W_VP + (size_t)TP * 512 * 2;
constexpr size_t W_QS = W_QP + (size_t)TP * 768 * 2;
constexpr size_t W_KRS = W_QS + (size_t)TS * 2304 * 2;
constexpr size_t W_BC = W_KRS + (size_t)TS * 32 * 2;
constexpr size_t W_CC = W_BC + (size_t)T * 256 * 2;
constexpr size_t W_XSF = W_CC + (size_t)T * 256 * 2;
constexpr size_t W_DTF = W_XSF + (size_t)T * 512 * 4;
constexpr size_t W_CAT = W_DTF + (size_t)T * 8 * 4;
constexpr size_t W_X1B = W_CAT + (size_t)T * 1024 * 2;
constexpr size_t W_SSQ1 = W_X1B + (size_t)T * 1024 * 2;
constexpr size_t W_SSQ2 = W_SSQ1 + (size_t)T * 16 * 4;
constexpr size_t W_U = W_SSQ2 + (size_t)T * 16 * 4;
constexpr size_t W_X2B = W_U + (size_t)T * 4096 * 2;
constexpr size_t W_STATES = W_X2B + (size_t)T * 1024 * 2;
constexpr size_t W_CHDEC = W_STATES + (size_t)512 * 8192 * 4;
constexpr size_t W_PML = W_CHDEC + 4096;
constexpr size_t W_PO = W_PML + (size_t)128 * 2 * 64 * 2 * 4;
constexpr size_t W_SLAB = W_PO + (size_t)128 * 2 * 64 * 256 * 4;
constexpr size_t W_HPREV = W_SLAB + (size_t)16 * 1024 * 1024 * 4;
constexpr size_t W_SSQS = W_HPREV + (size_t)512 * 8192 * 2;
constexpr size_t W_YRAW = W_SSQS + (size_t)TS * 32 * 4;
constexpr size_t W_END = W_YRAW + (size_t)TP * 512 * 4;

struct P {
    const float *x_p, *x_s, *ckv, *ckr, *st_ssm, *st_conv; const int* pt;
    const float *norm_attn, *w_in, *q_norm, *kv_norm, *w_uq, *w_uk, *w_uv, *conv_w, *conv_b, *dt_bias, *a_log, *d_skip, *ssm_norm, *w_out, *norm_mlp, *w_up, *w_down, *norm_final;
    float* out; unsigned char* ws; int ph_lo, ph_hi;
};

__device__ __forceinline__ float bf2f(unsigned short b) { return __uint_as_float(((unsigned)b) << 16); }
__device__ __forceinline__ float bflo(unsigned w) { return __uint_as_float(w << 16); }
__device__ __forceinline__ float bfhi(unsigned w) { return __uint_as_float(w & 0xffff0000u); }
__device__ __forceinline__ unsigned short f2bf(float f) { return (unsigned short)(cvt_pk_bf16(f, 0.f) & 0xffffu); }
__device__ __forceinline__ float wave_sum(float v) {
#pragma unroll
    for (int o = 32; o; o >>= 1) v += __shfl_xor(v, o);
    return v; }
__device__ __forceinline__ float silu(float v) { return v / (1.f + __expf(-v)); }

__device__ __forceinline__ int inproj_colmap(int n) {
    if (n < 256) return 384 + n; if (n < 640) return n - 256; if (n < 672) return n; if (n < 680) return n + 1536; if (n < 768) return -1; return n - 96; }
struct TJob { bf16_t* dst; const float* src; const float* ks; int ld, K, n0, k0, mode; };
__device__ __forceinline__ TJob tjob(const P& p, int j) {
    unsigned char* ws = p.ws; TJob t; t.ks = nullptr; t.mode = 0;
    if (j < 288) { const int kt = j & 7, nt = j >> 3; t.dst = (bf16_t*)(ws + W_BIN); t.src = p.w_in; t.ld = 2216; t.K = 1024; t.n0 = nt * 64; t.k0 = kt * 128; t.mode = 1; }
    else if (j < 324) { const int q = j - 288, kt = q % 3, nt = q / 3; t.dst = (bf16_t*)(ws + W_BUQP); t.src = p.w_uq; t.ld = 768; t.K = 384; t.n0 = nt * 64; t.k0 = kt * 128; }
    else if (j < 340) { const int q = j - 324, kt = q & 1, h = q >> 1; t.dst = (bf16_t*)(ws + W_BKV) + (size_t)(512 + h * 64) * 256; t.src = p.w_uv + (size_t)h * 16384; t.ld = 64; t.K = 256; t.n0 = 0; t.k0 = kt * 128; }
    else if (j < 468) { const int q = j - 340, kt = q & 7, nt = q >> 3; t.dst = (bf16_t*)(ws + W_BOUT); t.src = p.w_out; t.ld = 1024; t.K = 1024; t.n0 = nt * 64; t.k0 = kt * 128; }
    else if (j < 980) { const int q = j - 468, kt = q & 7, nt = q >> 3; t.dst = (bf16_t*)(ws + W_BUP); t.src = p.w_up; t.ld = 4096; t.K = 1024; t.n0 = nt * 64; t.k0 = kt * 128; t.ks = p.norm_mlp; }
    else { const int q = j - 980, kt = q & 31, nt = q >> 5; t.dst = (bf16_t*)(ws + W_BDOWN); t.src = p.w_down; t.ld = 1024; t.K = 4096; t.n0 = nt * 64; t.k0 = kt * 128; }
    return t;
}
__device__ __forceinline__ void tload(const TJob& t, int tid, float4 (&v)[4]) {
    float sc[4];
#pragma unroll
    for (int i = 0; i < 4; ++i) { const int e = tid + i * 512, kk = e >> 4, n4 = (e & 15) * 4, n = t.n0 + n4, c = t.mode ? inproj_colmap(n) : n;
        v[i] = *(const float4*)(t.src + (size_t)(t.k0 + kk) * t.ld + (c >= 0 ? c : 0)); sc[i] = c >= 0 ? 1.f : 0.f; }
    if (t.ks) {
#pragma unroll
        for (int i = 0; i < 4; ++i) { const int kk = (tid + i * 512) >> 4; sc[i] *= t.ks[t.k0 + kk]; } }
#pragma unroll
    for (int i = 0; i < 4; ++i) { v[i].x *= sc[i]; v[i].y *= sc[i]; v[i].z *= sc[i]; v[i].w *= sc[i]; }
}
__device__ __forceinline__ void tconv_run(const P& p, unsigned char* lds, int j0, int jend, int step) {
    const int tid = pg8::opaque_tid();
    float* tile = (float*)lds; int j = j0; float4 v[4]; TJob cur = tjob(p, j < jend ? j : 0);
    if (j < jend) tload(cur, tid, v);
    while (j < jend) {
        __syncthreads();
#pragma unroll
        for (int i = 0; i < 4; ++i) { const int e = tid + i * 512, kk = e >> 4, n4 = (e & 15) * 4; *(float4*)(tile + kk * 68 + ((n4 + 4 * (kk >> 3)) & 63)) = v[i]; }
        __syncthreads();
        const int jn = j + step; const TJob nxt = tjob(p, jn < jend ? jn : 0);
        if (jn < jend) tload(nxt, tid, v);
#pragma unroll
        for (int i = 0; i < 2; ++i) { const int e = tid + i * 512, nn = e >> 4, kc = (e & 15) * 8; float f[8];
#pragma unroll
            for (int q = 0; q < 8; ++q) f[q] = tile[(kc + q) * 68 + ((nn + 4 * (kc >> 3)) & 63)];
            u32x4 w; w.x = cvt_pk_bf16(f[0], f[1]); w.y = cvt_pk_bf16(f[2], f[3]); w.z = cvt_pk_bf16(f[4], f[5]); w.w = cvt_pk_bf16(f[6], f[7]);
            *(u32x4*)(cur.dst + (size_t)(cur.n0 + nn) * cur.K + cur.k0 + kc) = w; }
        cur = nxt; j = jn; }
    __syncthreads();
}
template <int NT> __device__ __forceinline__ void xprep(const P& p, bf16_t* hn, const float4 (&gn)[4], int t0, int lane) {
    float4 v[NT][4]; float ss[NT];
#pragma unroll
    for (int q = 0; q < NT; ++q) { const int t = t0 + q; const float* xr = t < TP ? p.x_p + (size_t)t * 1024 : p.x_s + (size_t)(t - TP) * 1024;
#pragma unroll
        for (int i = 0; i < 4; ++i) v[q][i] = *(const float4*)(xr + i * 256 + lane * 4); }
#pragma unroll
    for (int q = 0; q < NT; ++q) { ss[q] = 0.f;
#pragma unroll
        for (int i = 0; i < 4; ++i) ss[q] += v[q][i].x * v[q][i].x + v[q][i].y * v[q][i].y + v[q][i].z * v[q][i].z + v[q][i].w * v[q][i].w; }
#pragma unroll
    for (int o = 32; o; o >>= 1) {
#pragma unroll
        for (int q = 0; q < NT; ++q) ss[q] += __shfl_xor(ss[q], o); }
#pragma unroll
    for (int q = 0; q < NT; ++q) { const float rs = rsqrtf(ss[q] * (1.f / 1024.f) + 1e-6f);
#pragma unroll
        for (int i = 0; i < 4; ++i) { u32x2 w; w.x = cvt_pk_bf16(v[q][i].x * rs * gn[i].x, v[q][i].y * rs * gn[i].y); w.y = cvt_pk_bf16(v[q][i].z * rs * gn[i].z, v[q][i].w * rs * gn[i].w);
            *(u32x2*)(hn + (size_t)(t0 + q) * 1024 + i * 256 + lane * 4) = w; } }
}
__device__ __forceinline__ void phase_prep(const P& p, unsigned char* lds) {
    const int tid = pg8::opaque_tid(), lane = tid & 63, wid = tid >> 6, G = gridDim.x;
    unsigned char* ws = p.ws;
    { bf16_t* hn = (bf16_t*)(ws + W_HN); float4 gn[4];
#pragma unroll
      for (int i = 0; i < 4; ++i) gn[i] = *(const float4*)(p.norm_attn + i * 256 + lane * 4);
      for (int g8 = blockIdx.x * 8 + wid; g8 < TP / 8; g8 += G * 8) xprep<8>(p, hn, gn, g8 * 8, lane);
      for (int s1 = blockIdx.x * 8 + wid; s1 < TS; s1 += G * 8) xprep<1>(p, hn, gn, TP + s1, lane); }
    tconv_run(p, lds, (int)blockIdx.x, 340, G);
    { const int job = 255 - (int)blockIdx.x;
      if (job < 96) { const int h = job / 12, k0 = (job % 12) * 32; float* Bl = (float*)lds; float* Al = (float*)(lds + 65536);
        __syncthreads();
#pragma unroll
        for (int i = 0; i < 8; ++i) { const int f = tid + 512 * i; *(float4*)(Bl + f * 4) = *(const float4*)(p.w_uk + (size_t)h * 16384 + f * 4); }
        { const int kk = tid >> 4, d4 = tid & 15; *(float4*)(Al + kk * 68 + 4 * d4) = *(const float4*)(p.w_uq + (size_t)(k0 + kk) * 768 + h * 96 + 4 * d4); }
        __syncthreads();
        const int c = tid & 255, kh = tid >> 8; float acc[16];
#pragma unroll
        for (int q = 0; q < 16; ++q) acc[q] = 0.f;
        for (int d4 = 0; d4 < 16; ++d4) { const float b0 = Bl[(4 * d4) * 256 + c], b1 = Bl[(4 * d4 + 1) * 256 + c], b2 = Bl[(4 * d4 + 2) * 256 + c], b3 = Bl[(4 * d4 + 3) * 256 + c];
#pragma unroll
            for (int q = 0; q < 16; ++q) { const float4 a = *(const float4*)(Al + (kh * 16 + q) * 68 + 4 * d4); acc[q] += a.x * b0 + a.y * b1 + a.z * b2 + a.w * b3; } }
        u32x4 w0, w1; w0.x = cvt_pk_bf16(acc[0], acc[1]); w0.y = cvt_pk_bf16(acc[2], acc[3]); w0.z = cvt_pk_bf16(acc[4], acc[5]); w0.w = cvt_pk_bf16(acc[6], acc[7]);
        w1.x = cvt_pk_bf16(acc[8], acc[9]); w1.y = cvt_pk_bf16(acc[10], acc[11]); w1.z = cvt_pk_bf16(acc[12], acc[13]); w1.w = cvt_pk_bf16(acc[14], acc[15]);
        bf16_t* d = (bf16_t*)(ws + W_BQS) + (size_t)(h * 288 + c) * 384 + k0 + kh * 16; *(u32x4*)d = w0; *(u32x4*)(d + 8) = w1; } }
    const long gtid = (long)blockIdx.x * 512 + tid, gstride = (long)G * 512;
    { bf16_t* d = (bf16_t*)(ws + W_BQS);
      for (long i = gtid; i < 8L * 32 * 384; i += gstride) { const int k = (int)(i % 384), hj = (int)(i / 384), h = hj >> 5, jj = hj & 31;
        d[(size_t)(h * 288 + 256 + jj) * 384 + k] = f2bf(p.w_uq[(size_t)k * 768 + h * 96 + 64 + jj]); } }
    { bf16_t* d = (bf16_t*)(ws + W_BKV); for (long i = gtid; i < 131072 / 2; i += gstride) { const float2 v = *(const float2*)(p.w_uk + 2 * i); *(unsigned*)(d + 2 * i) = cvt_pk_bf16(v.x, v.y); } }
    { float* rt = (float*)(ws + W_ROPE);
      for (long i = gtid; i < (long)NPOS * 16; i += gstride) { const int pi = (int)(i >> 4), fi = (int)(i & 15), pos = pi < 2048 ? pi : 8192 + (pi - 2048);
        const double inv = exp2(-(double)(2 * fi) / 32.0 * 13.287712379549449); double sd, cd; sincos((double)pos * inv, &sd, &cd);
        rt[pi * 32 + fi] = (float)cd; rt[pi * 32 + 16 + fi] = (float)sd; } }
}

__device__ __forceinline__ void phase_thin(const P& p) {
    const int tid = pg8::opaque_tid(), lane = tid & 63, wid = tid >> 6, G = gridDim.x;
    unsigned char* ws = p.ws;
    const bf16_t* projp = (const bf16_t*)(ws + W_PROJ); const float* rope = (const float*)(ws + W_ROPE);
    bf16_t* cb = (bf16_t*)(ws + W_CB); bf16_t* qn = (bf16_t*)(ws + W_QN); bf16_t* Kp = (bf16_t*)(ws + W_KP); bf16_t* krs = (bf16_t*)(ws + W_KRS);
    bf16_t* Bc = (bf16_t*)(ws + W_BC); bf16_t* Cc = (bf16_t*)(ws + W_CC); float* xsf = (float*)(ws + W_XSF); float* dtf = (float*)(ws + W_DTF);
    float cw[4][16], cbias[16];
#pragma unroll
    for (int k = 0; k < 4; ++k)
#pragma unroll
        for (int j = 0; j < 4; ++j) { const float4 v = *(const float4*)(p.conv_w + k * 1024 + 16 * lane + 4 * j); cw[k][4 * j] = v.x; cw[k][4 * j + 1] = v.y; cw[k][4 * j + 2] = v.z; cw[k][4 * j + 3] = v.w; }
#pragma unroll
    for (int j = 0; j < 4; ++j) { const float4 v = *(const float4*)(p.conv_b + 16 * lane + 4 * j); cbias[4 * j] = v.x; cbias[4 * j + 1] = v.y; cbias[4 * j + 2] = v.z; cbias[4 * j + 3] = v.w; }
    const float4 kvn = *(const float4*)(p.kv_norm + 4 * lane);
    float qg[6];
#pragma unroll
    for (int j = 0; j < 6; ++j) qg[j] = p.q_norm[6 * lane + j];
    for (int t = blockIdx.x * 8 + wid; t < T; t += G * 8) {
        const bool pr = t < TP; const int l = pr ? (t & 2047) : ((t - TP) & 7), b = pr ? (t >> 11) : ((t - TP) >> 3), L = pr ? 2048 : 8;
        const bf16_t* row = projp + (size_t)t * 2304;
        { const u32x2 raw = *(const u32x2*)(row + 4 * lane); const float v0 = bflo(raw.x), v1 = bfhi(raw.x), v2 = bflo(raw.y), v3 = bfhi(raw.y);
          const float ss = wave_sum(v0 * v0 + v1 * v1 + v2 * v2 + v3 * v3), rs = rsqrtf(ss * (1.f / 256.f) + 1e-6f);
          const float o0 = v0 * rs * kvn.x, o1 = v1 * rs * kvn.y, o2 = v2 * rs * kvn.z, o3 = v3 * rs * kvn.w;
          float* od = pr ? p.out + O_KV_P + (size_t)t * 256 : p.out + O_KV_S + (size_t)(t - TP) * 256;
          *(float4*)(od + 4 * lane) = make_float4(o0, o1, o2, o3);
          u32x2 w; w.x = cvt_pk_bf16(o0, o1); w.y = cvt_pk_bf16(o2, o3); *(u32x2*)(cb + (size_t)t * 256 + 4 * lane) = w; }
        { const unsigned* qr = (const unsigned*)(row + 256 + 6 * lane); const unsigned r0 = qr[0], r1 = qr[1], r2 = qr[2];
          float q[6] = {bflo(r0), bfhi(r0), bflo(r1), bfhi(r1), bflo(r2), bfhi(r2)};
          float ss = 0.f;
#pragma unroll
          for (int j = 0; j < 6; ++j) ss += q[j] * q[j];
          ss = wave_sum(ss); const float rs = rsqrtf(ss * (1.f / 384.f) + 1e-6f);
          unsigned* qo = (unsigned*)(qn + (size_t)t * 384 + 6 * lane);
          qo[0] = cvt_pk_bf16(q[0] * rs * qg[0], q[1] * rs * qg[1]); qo[1] = cvt_pk_bf16(q[2] * rs * qg[2], q[3] * rs * qg[3]); qo[2] = cvt_pk_bf16(q[4] * rs * qg[4], q[5] * rs * qg[5]); }
        { const int i = lane & 15, pidx = pr ? l : 2048 + l; const float x1 = bf2f(row[640 + i]), x2 = bf2f(row[656 + i]);
          const float c = rope[pidx * 32 + i], s = rope[pidx * 32 + 16 + i];
          const float val = (lane & 16) ? (x2 * c + x1 * s) : (x1 * c - x2 * s); const int e = lane & 31;
          if (lane < 32) { float* od = pr ? p.out + O_KR_P + (size_t)t * 32 : p.out + O_KR_S + (size_t)(t - TP) * 32; od[e] = val; }
          const unsigned short vb = f2bf(val);
          if (pr) {
#pragma unroll
              for (int j = 0; j < 4; ++j) Kp[(size_t)t * 768 + ((lane >> 5) * 4 + j) * 96 + 64 + e] = vb; }
          else if (lane < 32) krs[(size_t)(t - TP) * 32 + e] = vb; }
        if (lane < 8) { const float v = bf2f(row[672 + lane]) + p.dt_bias[lane]; dtf[(size_t)t * 8 + lane] = v > 20.f ? v : log1pf(expf(v)); }
        { float acc[16], xc[16];
#pragma unroll
          for (int j = 0; j < 16; ++j) { acc[j] = cbias[j]; xc[j] = 0.f; }
          u32x4 ra[4], rb[4];
#pragma unroll
          for (int k = 0; k < 4; ++k) { const int lk = l + k - 3; const u32x4* src = (const u32x4*)(projp + (size_t)(lk >= 0 ? t + k - 3 : t) * 2304 + 1280 + 16 * lane); ra[k] = src[0]; rb[k] = src[1]; }
#pragma unroll
          for (int k = 0; k < 4; ++k) { const int lk = l + k - 3; float xv[16]; const u32x4 a = ra[k], c2 = rb[k];
            xv[0] = bflo(a.x); xv[1] = bfhi(a.x); xv[2] = bflo(a.y); xv[3] = bfhi(a.y); xv[4] = bflo(a.z); xv[5] = bfhi(a.z); xv[6] = bflo(a.w); xv[7] = bfhi(a.w);
            xv[8] = bflo(c2.x); xv[9] = bfhi(c2.x); xv[10] = bflo(c2.y); xv[11] = bfhi(c2.y); xv[12] = bflo(c2.z); xv[13] = bfhi(c2.z); xv[14] = bflo(c2.w); xv[15] = bfhi(c2.w);
            if (lk < 0) {
                if (!pr) { const float* src = p.st_conv + ((size_t)b * 3 + (l + k)) * 1024 + 16 * lane;
#pragma unroll
                    for (int j = 0; j < 4; ++j) { const float4 v = *(const float4*)(src + 4 * j); xv[4 * j] = v.x; xv[4 * j + 1] = v.y; xv[4 * j + 2] = v.z; xv[4 * j + 3] = v.w; } }
                else {
#pragma unroll
                    for (int j = 0; j < 16; ++j) xv[j] = 0.f; } }
#pragma unroll
            for (int j = 0; j < 16; ++j) { acc[j] += xv[j] * cw[k][j]; if (k == 3) xc[j] = xv[j]; } }
#pragma unroll
          for (int j = 0; j < 16; ++j) acc[j] = silu(acc[j]);
          if (lane < 32) { float* d = xsf + (size_t)t * 512 + 16 * lane;
#pragma unroll
              for (int j = 0; j < 4; ++j) *(float4*)(d + 4 * j) = make_float4(acc[4 * j], acc[4 * j + 1], acc[4 * j + 2], acc[4 * j + 3]); }
          else { bf16_t* d = (lane < 48 ? Bc + (size_t)t * 256 + 16 * (lane - 32) : Cc + (size_t)t * 256 + 16 * (lane - 48));
              u32x4 w0, w1; w0.x = cvt_pk_bf16(acc[0], acc[1]); w0.y = cvt_pk_bf16(acc[2], acc[3]); w0.z = cvt_pk_bf16(acc[4], acc[5]); w0.w = cvt_pk_bf16(acc[6], acc[7]);
              w1.x = cvt_pk_bf16(acc[8], acc[9]); w1.y = cvt_pk_bf16(acc[10], acc[11]); w1.z = cvt_pk_bf16(acc[12], acc[13]); w1.w = cvt_pk_bf16(acc[14], acc[15]);
              *(u32x4*)d = w0; *(u32x4*)(d + 8) = w1; }
          if (l >= L - 3) { float* d = (pr ? p.out + O_CONV_P : p.out + O_CONV_S) + ((size_t)b * 3 + (l - (L - 3))) * 1024 + 16 * lane;
#pragma unroll
              for (int j = 0; j < 4; ++j) *(float4*)(d + 4 * j) = make_float4(xc[4 * j], xc[4 * j + 1], xc[4 * j + 2], xc[4 * j + 3]); } }
    }
}
struct EpiKV {
    static constexpr bool PERM = true, AFTER_DRAIN = false;
    bf16_t* Kp; bf16_t* Vp;
    __device__ __forceinline__ void operator()(const f32x4 (&acc)[2][2][4][2], const pg8::Unit& u, int wr, int wc, int fr, int fq) const {
        const int row0 = u.pm * 256 + wr * 64 + fr, col = u.pn * 256 + wc * 32 + 8 * fq; const bool km = u.pn < 2;
        bf16_t* base = km ? Kp + (size_t)row0 * 768 + (col >> 6) * 96 + (col & 63) : Vp + (size_t)row0 * 512 + (col - 512);
        const int pitch = km ? 768 : 512, bjo = km ? 192 : 128;
#pragma unroll
        for (int ai = 0; ai < 2; ++ai)
#pragma unroll
            for (int m = 0; m < 4; ++m) { bf16_t* rp = base + (size_t)(ai * 128 + m * 16) * pitch;
#pragma unroll
                for (int bj = 0; bj < 2; ++bj) { const f32x4 v0 = acc[ai][bj][m][0], v1 = acc[ai][bj][m][1];
                    u32x4 w; w.x = cvt_pk_bf16(v0[0], v0[1]); w.y = cvt_pk_bf16(v0[2], v0[3]); w.z = cvt_pk_bf16(v1[0], v1[1]); w.w = cvt_pk_bf16(v1[2], v1[3]);
                    *(u32x4*)(rp + bj * bjo) = w; }
                asm volatile("" ::: "memory"); }
    }
};
template <int HD, int ROPE_OFF, int POS_MODE> struct EpiQ {
    static constexpr bool PERM = false, AFTER_DRAIN = false;
    bf16_t* O; int ldc; const float* rope; float scale;
    __device__ __forceinline__ void operator()(const f32x4 (&acc)[2][2][4][2], const pg8::Unit& u, int wr, int wc, int fr, int fq) const {
        const int row0 = u.pm * 256 + wr * 64 + fr;
#pragma unroll
        for (int bj = 0; bj < 2; ++bj) { const int g32 = u.pn * 256 + bj * 128 + wc * 32; const bool rg = ((g32 % HD) == ROPE_OFF);
#pragma unroll
            for (int ai = 0; ai < 2; ++ai)
#pragma unroll
                for (int m = 0; m < 4; ++m) { const int row = row0 + ai * 128 + m * 16; const int pidx = POS_MODE ? 2048 + (row & 7) : (row & 2047);
                    f32x4 v0 = acc[ai][bj][m][0], v1 = acc[ai][bj][m][1];
                    if (rg) { const f32x4 c = *(const f32x4*)(rope + pidx * 32 + 4 * fq), s = *(const f32x4*)(rope + pidx * 32 + 16 + 4 * fq);
                        const f32x4 r1 = v0 * c - v1 * s, r2 = v1 * c + v0 * s; v0 = r1; v1 = r2; }
                    v0 *= scale; v1 *= scale;
                    bf16_t* dst = O + (size_t)row * ldc + g32 + 4 * fq;
                    u32x2 w0, w1; w0.x = cvt_pk_bf16(v0[0], v0[1]); w0.y = cvt_pk_bf16(v0[2], v0[3]); w1.x = cvt_pk_bf16(v1[0], v1[1]); w1.y = cvt_pk_bf16(v1[2], v1[3]);
                    *(u32x2*)dst = w0; *(u32x2*)(dst + 16) = w1; asm volatile("" ::: "memory"); } }
    }
};

#define MFMA32(a, b, c) __builtin_amdgcn_mfma_f32_32x32x16_bf16((a), (b), (c), 0, 0, 0)
typedef short v4i16_t __attribute__((ext_vector_type(4)));
__device__ __forceinline__ s16x4 tr_read(LAS const unsigned char* p) { return __builtin_bit_cast(s16x4, __builtin_amdgcn_ds_read_tr16_b64_v4i16((LAS v4i16_t*)p)); }
__device__ __forceinline__ bf16x8 lds128(LAS const unsigned char* p) { return *(LAS const bf16x8*)p; }
__device__ __forceinline__ int crow(int r, int hi) { return (r & 3) + 8 * (r >> 2) + 4 * hi; }
__device__ __forceinline__ bf16x8 pack8(const f32x16& x, int s) {
    u32x4 w; w.x = cvt_pk_bf16(x[8 * s], x[8 * s + 1]); w.y = cvt_pk_bf16(x[8 * s + 2], x[8 * s + 3]); w.z = cvt_pk_bf16(x[8 * s + 4], x[8 * s + 5]); w.w = cvt_pk_bf16(x[8 * s + 6], x[8 * s + 7]);
    return __builtin_bit_cast(bf16x8, w); }
__device__ __forceinline__ void glds16(const void* g, LAS unsigned char* l) { __builtin_amdgcn_global_load_lds((const unsigned*)g, (LAS unsigned*)l, 16, 0, 0); }
__device__ __forceinline__ float max16(const f32x16& a) { float m = fmaxf(a[0], a[1]);
#pragma unroll
    for (int r = 2; r < 16; ++r) m = fmaxf(m, a[r]);
    return m; }

constexpr int PA_K = 0, PA_V = 49152, PA_KB = 12288, PA_VB = 8192;
__device__ __forceinline__ void attn_prompt_unit(const bf16_t* Qp, const bf16_t* Kp, const bf16_t* Vp, bf16_t* cat, int b, int h, int qb, LAS unsigned char* lds) {
    const int tid = pg8::opaque_tid(), lane = tid & 63, r32 = lane & 31, hi = lane >> 5; const int wid = __builtin_amdgcn_readfirstlane(tid >> 6);
    const size_t rowbase = (size_t)b * 2048; const int q0 = qb * 256, NT = 4 * qb + 4;
    const int qrow = q0 + wid * 32 + r32, qmin = q0 + wid * 32, qmax = qmin + 31;
    bf16x8 qf[6];
    const bf16_t* Qw = Qp + (rowbase + qrow) * 768 + h * 96 + hi * 8;
    const bf16_t* ksrc = Kp + (rowbase + lane) * 768 + h * 96;
    const bf16_t* vsrc = Vp + (rowbase + 16 * (wid & 3) + (lane >> 2)) * 512 + h * 64 + (wid >> 2) * 32 + (lane & 3) * 8;
#define PA_ISSUE(t, buf) do { const bf16_t* kt_ = ksrc + (size_t)(t) * 64 * 768; \
        glds16(kt_ + wid * 8, lds + PA_K + (buf) * PA_KB + wid * 1024); \
        if (wid < 4) glds16(kt_ + (8 + wid) * 8, lds + PA_K + (buf) * PA_KB + (8 + wid) * 1024); \
        glds16(vsrc + (size_t)(t) * 64 * 512, lds + PA_V + (buf) * PA_VB + wid * 1024); } while (0)
    f32x16 o0, o1;
#pragma unroll
    for (int r = 0; r < 16; ++r) { o0[r] = 0.f; o1[r] = 0.f; }
    float m_run = -INFINITY, l_run = 0.f;
    const int voff = (4 * hi + ((lane & 15) >> 2)) * 64 + ((lane >> 4) & 1) * 32 + (lane & 3) * 8;
    PA_ISSUE(0, 0); PA_ISSUE(1, 1); PA_ISSUE(2, 2);
    asm volatile("global_load_dwordx4 %0, %6, off\n\tglobal_load_dwordx4 %1, %6, off offset:32\n\tglobal_load_dwordx4 %2, %6, off offset:64\n\tglobal_load_dwordx4 %3, %6, off offset:96\n\t"
                 "global_load_dwordx4 %4, %6, off offset:128\n\tglobal_load_dwordx4 %5, %6, off offset:160\n\ts_waitcnt vmcnt(0)"
                 : "=&v"(qf[0]), "=&v"(qf[1]), "=&v"(qf[2]), "=&v"(qf[3]), "=&v"(qf[4]), "=&v"(qf[5]) : "v"(Qw) : "memory");
    __builtin_amdgcn_s_barrier(); asm volatile("" ::: "memory");
    for (int t = 0; t < NT; ++t) { const int buf = t & 3, kbase = t * 64;
        if (t + 3 < NT) PA_ISSUE(t + 3, (t + 3) & 3);
        if (kbase <= qmax) {
            LAS const unsigned char* kb = lds + PA_K + buf * PA_KB + hi * 1024 + r32 * 16;
            f32x16 s0, s1;
#pragma unroll
            for (int r = 0; r < 16; ++r) { s0[r] = 0.f; s1[r] = 0.f; }
#pragma unroll
            for (int d0 = 0; d0 < 6; ++d0) { const bf16x8 k0 = lds128(kb + d0 * 2048), k1 = lds128(kb + d0 * 2048 + 512); s0 = MFMA32(k0, qf[d0], s0); s1 = MFMA32(k1, qf[d0], s1); }
            if (kbase + 63 > qmin) {
#pragma unroll
                for (int r = 0; r < 16; ++r) { const int key = kbase + crow(r, hi); if (key > qrow) s0[r] = -INFINITY; if (key + 32 > qrow) s1[r] = -INFINITY; } }
            float mx = fmaxf(max16(s0), max16(s1)); mx = fmaxf(mx, __shfl_xor(mx, 32));
            const float m_new = fmaxf(m_run, mx), alpha = __builtin_amdgcn_exp2f(m_run - m_new); m_run = m_new;
            float ps = 0.f;
#pragma unroll
            for (int r = 0; r < 16; ++r) { s0[r] = __builtin_amdgcn_exp2f(s0[r] - m_new); s1[r] = __builtin_amdgcn_exp2f(s1[r] - m_new); ps += s0[r] + s1[r]; }
            l_run = l_run * alpha + ps;
            if (__any(alpha != 1.f)) {
#pragma unroll
                for (int r = 0; r < 16; ++r) { o0[r] *= alpha; o1[r] *= alpha; } }
            bf16x8 pf[4]; pf[0] = pack8(s0, 0); pf[1] = pack8(s0, 1); pf[2] = pack8(s1, 0); pf[3] = pack8(s1, 1);
            LAS const unsigned char* vb = lds + PA_V + buf * PA_VB + voff;
            s16x4 tv[16];
#define PA_TR(i, off) asm volatile("ds_read_b64_tr_b16 %0, %1 offset:%2" : "=v"(tv[i]) : "v"(vb), "i"(off))
#define PA_TRW(i) asm volatile("s_waitcnt lgkmcnt(0)" : "+v"(tv[i]), "+v"(tv[i + 1]), "+v"(tv[i + 2]), "+v"(tv[i + 3]), "+v"(tv[i + 4]), "+v"(tv[i + 5]), "+v"(tv[i + 6]), "+v"(tv[i + 7]))
            PA_TR(0, 0); PA_TR(1, 512); PA_TR(2, 4096); PA_TR(3, 4608); PA_TR(4, 1024); PA_TR(5, 1536); PA_TR(6, 5120); PA_TR(7, 5632);
            PA_TRW(0);
            PA_TR(8, 2048); PA_TR(9, 2560); PA_TR(10, 6144); PA_TR(11, 6656); PA_TR(12, 3072); PA_TR(13, 3584); PA_TR(14, 7168); PA_TR(15, 7680);
#pragma unroll
            for (int ks = 0; ks < 2; ++ks) { const bf16x8 va = __builtin_shufflevector(tv[4 * ks], tv[4 * ks + 1], 0, 1, 2, 3, 4, 5, 6, 7), vc = __builtin_shufflevector(tv[4 * ks + 2], tv[4 * ks + 3], 0, 1, 2, 3, 4, 5, 6, 7);
                o0 = MFMA32(va, pf[ks], o0); o1 = MFMA32(vc, pf[ks], o1); }
            PA_TRW(8);
#pragma unroll
            for (int ks = 2; ks < 4; ++ks) { const bf16x8 va = __builtin_shufflevector(tv[4 * ks], tv[4 * ks + 1], 0, 1, 2, 3, 4, 5, 6, 7), vc = __builtin_shufflevector(tv[4 * ks + 2], tv[4 * ks + 3], 0, 1, 2, 3, 4, 5, 6, 7);
                o0 = MFMA32(va, pf[ks], o0); o1 = MFMA32(vc, pf[ks], o1); }
#undef PA_TR
#undef PA_TRW
        }
        { const int rem = NT - 2 - t;
          if (wid < 4) { if (rem >= 2) asm volatile("s_waitcnt vmcnt(6)" ::: "memory"); else if (rem == 1) asm volatile("s_waitcnt vmcnt(3)" ::: "memory"); else asm volatile("s_waitcnt vmcnt(0)" ::: "memory"); }
          else { if (rem >= 2) asm volatile("s_waitcnt vmcnt(4)" ::: "memory"); else if (rem == 1) asm volatile("s_waitcnt vmcnt(2)" ::: "memory"); else asm volatile("s_waitcnt vmcnt(0)" ::: "memory"); } }
        __builtin_amdgcn_s_barrier(); asm volatile("" ::: "memory");
    }
#undef PA_ISSUE
    const float lt = l_run + __shfl_xor(l_run, 32), inv = 1.f / lt;
    bf16_t* orow = cat + (rowbase + qrow) * 1024 + h * 64 + 4 * hi;
#pragma unroll
    for (int g = 0; g < 4; ++g) { u32x2 w0, w1;
        w0.x = cvt_pk_bf16(o0[4 * g] * inv, o0[4 * g + 1] * inv); w0.y = cvt_pk_bf16(o0[4 * g + 2] * inv, o0[4 * g + 3] * inv);
        w1.x = cvt_pk_bf16(o1[4 * g] * inv, o1[4 * g + 1] * inv); w1.y = cvt_pk_bf16(o1[4 * g + 2] * inv, o1[4 * g + 3] * inv);
        *(u32x2*)(orow + 8 * g) = w0; *(u32x2*)(orow + 32 + 8 * g) = w1; }
}
__device__ __forceinline__ void phase_attn_prompt(const P& p, LAS unsigned char* lds) {
    const bf16_t* Qp = (const bf16_t*)(p.ws + W_QP); const bf16_t* Kp = (const bf16_t*)(p.ws + W_KP); const bf16_t* Vp = (const bf16_t*)(p.ws + W_VP); bf16_t* cat = (bf16_t*)(p.ws + W_CAT);
    __syncthreads();
    for (int it = blockIdx.x; it < 256; it += gridDim.x) { const int x = it & 7, kk = it >> 3, bh = x + 8 * (kk >> 2), j = kk & 3;
        attn_prompt_unit(Qp, Kp, Vp, cat, bh >> 3, bh & 7, j, lds);
        attn_prompt_unit(Qp, Kp, Vp, cat, bh >> 3, bh & 7, 7 - j, lds); }
}
template <bool RES_BF16> struct EpiRes {
    static constexpr bool PERM = false, AFTER_DRAIN = false;
    const void* r0; const void* r1; bf16_t* Cb; float* ssq;
    struct RV { f32x4 f[4]; u32x2 h[4]; };
    __device__ __forceinline__ void ld(int row, int col0, f32x4 (&f)[4], u32x2 (&h)[4]) const {
        const size_t ro = (row < TP ? (size_t)row : (size_t)(row - TP)) * 1024 + col0; const void* rb = row < TP ? r0 : r1;
#pragma unroll
        for (int q = 0; q < 4; ++q) { if (RES_BF16) h[q] = *(const u32x2*)((const bf16_t*)rb + ro + (q >> 1) * 128 + (q & 1) * 16); else f[q] = *(const f32x4*)((const float*)rb + ro + (q >> 1) * 128 + (q & 1) * 16); }
    }
    __device__ __forceinline__ void operator()(const f32x4 (&acc)[2][2][4][2], const pg8::Unit& u, int wr, int wc, int fr, int fq) const {
        const int row0 = u.pm * 256 + wr * 64 + fr, col0 = u.pn * 256 + wc * 32 + 4 * fq;
        f32x4 rf[2][4]; u32x2 rh[2][4];
        ld(row0, col0, rf[0], rh[0]);
#pragma unroll
        for (int it = 0; it < 8; ++it) { const int ai = it >> 2, m = it & 3, row = row0 + ai * 128 + m * 16;
            if (it < 7) ld(row0 + ((it + 1) >> 2) * 128 + ((it + 1) & 3) * 16, col0, rf[(it + 1) & 1], rh[(it + 1) & 1]);
            bf16_t* cp = Cb + (size_t)row * 1024 + col0; float ss = 0.f;
#pragma unroll
            for (int q = 0; q < 4; ++q) { const int bj = q >> 1, n = q & 1; f32x4 rv;
                if (RES_BF16) { const u32x2 w = rh[it & 1][q]; rv = (f32x4){bflo(w.x), bfhi(w.x), bflo(w.y), bfhi(w.y)}; } else rv = rf[it & 1][q];
                const f32x4 v = acc[ai][bj][m][n] + rv; ss += v[0] * v[0] + v[1] * v[1] + v[2] * v[2] + v[3] * v[3];
                u32x2 w; w.x = cvt_pk_bf16(v[0], v[1]); w.y = cvt_pk_bf16(v[2], v[3]); *(u32x2*)(cp + bj * 128 + n * 16) = w; }
            ss += __shfl_xor(ss, 16); ss += __shfl_xor(ss, 32);
            if (fq == 0) ssq[(size_t)row * 16 + u.pn * 4 + wc] = ss;
            asm volatile("" ::: "memory"); }
    }
};
struct EpiUp {
    static constexpr bool PERM = true, AFTER_DRAIN = false;
    bf16_t* O; LAS const float* rsl;
    __device__ __forceinline__ void operator()(const f32x4 (&acc)[2][2][4][2], const pg8::Unit& u, int wr, int wc, int fr, int fq) const {
        const int row0 = u.pm * 256 + wr * 64 + fr, col0 = u.pn * 256 + wc * 32 + 8 * fq;
        float r2[8];
#pragma unroll
        for (int it = 0; it < 8; ++it) r2[it] = rsl[wr * 64 + fr + (it >> 2) * 128 + (it & 3) * 16];
#pragma unroll
        for (int ai = 0; ai < 2; ++ai)
#pragma unroll
            for (int m = 0; m < 4; ++m) { const int row = row0 + ai * 128 + m * 16; const float rs2 = r2[ai * 4 + m];
                bf16_t* rp = O + (size_t)row * 4096 + col0;
#pragma unroll
                for (int bj = 0; bj < 2; ++bj) { f32x4 v0 = acc[ai][bj][m][0], v1 = acc[ai][bj][m][1];
#pragma unroll
                    for (int j = 0; j < 4; ++j) { const float p0 = fmaxf(v0[j], 0.f), p1 = fmaxf(v1[j], 0.f); v0[j] = p0 * p0 * rs2; v1[j] = p1 * p1 * rs2; }
                    u32x4 w; w.x = cvt_pk_bf16(v0[0], v0[1]); w.y = cvt_pk_bf16(v0[2], v0[3]); w.z = cvt_pk_bf16(v1[0], v1[1]); w.w = cvt_pk_bf16(v1[2], v1[3]);
                    *(u32x4*)(rp + bj * 128) = w; }
                asm volatile("" ::: "memory"); }
    }
};
struct OneUnit { int pm, pn; bool has;
    __device__ __forceinline__ bool next(int i, pg8::Unit& u) const { if (i > 0 || !has) return false; u.pm = pm; u.pn = pn; return true; }
    __device__ __forceinline__ void a_ready(const pg8::Unit&) const {}
    __device__ __forceinline__ void done(const pg8::Unit&) const {} };
struct EpiSlab {
    static constexpr bool PERM = false, AFTER_DRAIN = false; float* C;
    __device__ __forceinline__ void operator()(const f32x4 (&acc)[2][2][4][2], const pg8::Unit& u, int wr, int wc, int fr, int fq) const {
        float* base = C + (size_t)(u.pm * 256 + wr * 64 + fr) * 1024 + u.pn * 256 + wc * 32 + 4 * fq;
#pragma unroll
        for (int ai = 0; ai < 2; ++ai)
#pragma unroll
            for (int m = 0; m < 4; ++m) { float* rp = base + (size_t)(ai * 128 + m * 16) * 1024;
#pragma unroll
                for (int bj = 0; bj < 2; ++bj)
#pragma unroll
                    for (int n = 0; n < 2; ++n) *(f32x4*)(rp + bj * 128 + n * 16) = acc[ai][bj][m][n];
                asm volatile("" ::: "memory"); }
    }
};
constexpr int NSLAB = 4;
__device__ __forceinline__ void phase_final(const P& p) {
    const int tid = pg8::opaque_tid(), lane = tid & 63, wid = tid >> 6, G = gridDim.x;
    const bf16_t* x2 = (const bf16_t*)(p.ws + W_X2B); const float* ssq = (const float*)(p.ws + W_SSQ2); const bf16_t* x1 = (const bf16_t*)(p.ws + W_X1B); const float* slab = (const float*)(p.ws + W_SLAB);
    float4 g[4];
#pragma unroll
    for (int i = 0; i < 4; ++i) g[i] = *(const float4*)(p.norm_final + i * 256 + lane * 4);
    if (!(wid & 1)) { const int s = blockIdx.x * 4 + (wid >> 1);
        if (s < TS) { f32x4 v[4]; float ss = 0.f;
#pragma unroll
            for (int i = 0; i < 4; ++i) { const u32x2 w = *(const u32x2*)(x1 + (size_t)(TP + s) * 1024 + i * 256 + lane * 4); v[i] = (f32x4){bflo(w.x), bfhi(w.x), bflo(w.y), bfhi(w.y)}; }
#pragma unroll
            for (int sl = 0; sl < NSLAB; ++sl)
#pragma unroll
                for (int i = 0; i < 4; ++i) v[i] += *(const f32x4*)(slab + ((size_t)sl * 1024 + s) * 1024 + i * 256 + lane * 4);
#pragma unroll
            for (int i = 0; i < 4; ++i) ss += v[i][0] * v[i][0] + v[i][1] * v[i][1] + v[i][2] * v[i][2] + v[i][3] * v[i][3];
            ss = wave_sum(ss); const float rs = rsqrtf(ss * (1.f / 1024.f) + 1e-6f); float* o = p.out + O_Y_S + (size_t)s * 1024;
#pragma unroll
            for (int i = 0; i < 4; ++i) *(float4*)(o + i * 256 + lane * 4) = make_float4(v[i][0] * rs * g[i].x, v[i][1] * rs * g[i].y, v[i][2] * rs * g[i].z, v[i][3] * rs * g[i].w); } }
    for (int t4 = (blockIdx.x * 8 + wid) * 4; t4 < TP; t4 += G * 32) {
        u32x2 w[4][4]; float sq[4];
#pragma unroll
        for (int q = 0; q < 4; ++q) { sq[q] = ssq[(size_t)(t4 + q) * 16 + (lane & 15)];
#pragma unroll
            for (int i = 0; i < 4; ++i) w[q][i] = *(const u32x2*)(x2 + (size_t)(t4 + q) * 1024 + i * 256 + lane * 4); }
#pragma unroll
        for (int o = 1; o < 16; o <<= 1) {
#pragma unroll
            for (int q = 0; q < 4; ++q) sq[q] += __shfl_xor(sq[q], o); }
#pragma unroll
        for (int q = 0; q < 4; ++q) { const float rs = rsqrtf(sq[q] * (1.f / 1024.f) + 1e-6f); float* o = p.out + O_Y_P + (size_t)(t4 + q) * 1024;
#pragma unroll
            for (int i = 0; i < 4; ++i) *(float4*)(o + i * 256 + lane * 4) = make_float4(bflo(w[q][i].x) * rs * g[i].x, bfhi(w[q][i].x) * rs * g[i].y, bflo(w[q][i].y) * rs * g[i].z, bfhi(w[q][i].y) * rs * g[i].w); } }
}

__device__ __forceinline__ void phase_ssd_sample(const P& p, LAS unsigned char* lds) {
    const int tid = pg8::opaque_tid(), row = tid >> 1, nh = tid & 1, hh = row >> 6, pp = row & 63, wid = tid >> 6;
    const float* xsf = (const float*)(p.ws + W_XSF); const float* dtf = (const float*)(p.ws + W_DTF); const bf16_t* Bc = (const bf16_t*)(p.ws + W_BC); const bf16_t* Cc = (const bf16_t*)(p.ws + W_CC);
    const bf16_t* projp = (const bf16_t*)(p.ws + W_PROJ); bf16_t* cat = (bf16_t*)(p.ws + W_CAT);
    LAS float* Bl = (LAS float*)lds; LAS float* Cl = Bl + 1024; LAS float* red = Cl + 1024; LAS float* gl = red + 64;
    for (int it = blockIdx.x; it < 256; it += gridDim.x) { const int b = it >> 1, g = it & 1, h = g * 4 + hh; const size_t tb = (size_t)TP + b * 8;
        const float A = -__expf(p.a_log[h]), D = p.d_skip[h], gn = p.ssm_norm[h * 64 + pp];
        const size_t sidx = (((size_t)b * 8 + h) * 64 + pp) * 128 + nh * 64;
        __syncthreads();
        float hs[64];
#pragma unroll
        for (int j = 0; j < 16; ++j) { const float4 v = *(const float4*)(p.st_ssm + sidx + 4 * j); hs[4 * j] = v.x; hs[4 * j + 1] = v.y; hs[4 * j + 2] = v.z; hs[4 * j + 3] = v.w; }
        float dtc = dtf[tb * 8 + h], xc = xsf[tb * 512 + h * 64 + pp], zc = bf2f(projp[tb * 2304 + 768 + h * 64 + pp]);
        if (tid < 256) { const int c = tid & 127, tok = c >> 4, chk = c & 15; const bf16_t* src = (tid < 128 ? Bc : Cc) + (tb + tok) * 256 + g * 128 + 8 * chk; const u32x4 w = *(const u32x4*)src;
            LAS float* d = (tid < 128 ? Bl : Cl) + tok * 128 + 8 * chk;
            *(LAS f32x4*)d = (f32x4){bflo(w.x), bfhi(w.x), bflo(w.y), bfhi(w.y)}; *(LAS f32x4*)(d + 4) = (f32x4){bflo(w.z), bfhi(w.z), bflo(w.w), bfhi(w.w)}; }
        __syncthreads();
#pragma unroll 1
        for (int l = 0; l < 8; ++l) { const int ln = l < 7 ? l + 1 : 7;
            const float dtn = dtf[(tb + ln) * 8 + h], xn = xsf[(tb + ln) * 512 + h * 64 + pp], zn = bf2f(projp[(tb + ln) * 2304 + 768 + h * 64 + pp]);
            const float da = __expf(dtc * A), cf = dtc * xc; float yp = 0.f; LAS const float* bp = Bl + l * 128 + nh * 64; LAS const float* cp = Cl + l * 128 + nh * 64;
#pragma unroll
            for (int j = 0; j < 16; ++j) { const f32x4 bv = *(LAS const f32x4*)(bp + 4 * j), cv = *(LAS const f32x4*)(cp + 4 * j);
#pragma unroll
                for (int e = 0; e < 4; ++e) { hs[4 * j + e] = da * hs[4 * j + e] + cf * bv[e]; yp += cv[e] * hs[4 * j + e]; } }
            const float y = yp + __shfl_xor(yp, 1) + D * xc; gl[l * 512 + tid] = y * silu(zc);
            dtc = dtn; xc = xn; zc = zn; }
        float gv[8];
        { float ss[8];
#pragma unroll
          for (int l = 0; l < 8; ++l) { gv[l] = gl[l * 512 + tid]; ss[l] = nh == 0 ? gv[l] * gv[l] : 0.f; }
#pragma unroll
          for (int o = 32; o; o >>= 1) {
#pragma unroll
              for (int l = 0; l < 8; ++l) ss[l] += __shfl_xor(ss[l], o); }
          if ((tid & 63) < 8) { float v = ss[0];
#pragma unroll
              for (int l = 1; l < 8; ++l) v = ((tid & 63) == l) ? ss[l] : v;
              red[wid * 8 + (tid & 63)] = v; } }
        __syncthreads();
        if (nh == 0) {
#pragma unroll
            for (int l = 0; l < 8; ++l) { float tot = 0.f;
#pragma unroll
                for (int w = 0; w < 8; ++w) tot += red[w * 8 + l];
                cat[(tb + l) * 1024 + 512 + h * 64 + pp] = f2bf(gv[l] * rsqrtf(tot * (1.f / 256.f) + 1e-6f) * gn); } }
        float* so = p.out + O_SSM_S + sidx;
#pragma unroll
        for (int j = 0; j < 16; ++j) *(float4*)(so + 4 * j) = make_float4(hs[4 * j], hs[4 * j + 1], hs[4 * j + 2], hs[4 * j + 3]);
    }
}
constexpr int SS_CS = 0, SS_DT = 4096, SS_XW = 8192, SS_B1 = 8192 + 32768;
constexpr int SS_H = 8192, SS_BT = 8192 + 32768, SS_XD = SS_BT + 16384;
__device__ __forceinline__ unsigned off_b(unsigned row, unsigned ch) { return 256u * row + 16u * (ch ^ (((row & 3) << 2) | ((row >> 2) & 3))); }
__device__ __forceinline__ bf16x8 trpair(LAS const unsigned char* p) { const s16x4 a = tr_read(p), b = tr_read(p + 512); return __builtin_shufflevector(a, b, 0, 1, 2, 3, 4, 5, 6, 7); }
__device__ __forceinline__ void ssd_cumsum(const P& p, int t0, int g, int wid, int lane, LAS unsigned char* lds) {
    if (wid < 4) { const int h = g * 4 + wid; const float A2 = -__expf(p.a_log[h]) * 1.4426950408889634f; const float* dtf = (const float*)(p.ws + W_DTF);
        float d[4], s[4];
#pragma unroll
        for (int j = 0; j < 4; ++j) d[j] = dtf[(size_t)(t0 + 4 * lane + j) * 8 + h];
        s[0] = d[0] * A2; s[1] = s[0] + d[1] * A2; s[2] = s[1] + d[2] * A2; s[3] = s[2] + d[3] * A2;
        float incl = s[3];
#pragma unroll
        for (int o = 1; o < 64; o <<= 1) { const float v = __shfl_up(incl, o); if (lane >= o) incl += v; }
        const float ex = incl - s[3];
        *(LAS f32x4*)(lds + SS_CS + wid * 1024 + lane * 16) = (f32x4){ex + s[0], ex + s[1], ex + s[2], ex + s[3]};
        *(LAS f32x4*)(lds + SS_DT + wid * 1024 + lane * 16) = (f32x4){d[0], d[1], d[2], d[3]}; }
}
__device__ __forceinline__ void phase_ssd_pass1(const P& p, LAS unsigned char* lds) {
    const int tid = pg8::opaque_tid(), lane = tid & 63, r32 = lane & 31, hi = lane >> 5; const int wid = __builtin_amdgcn_readfirstlane(tid >> 6);
    const float* xsf = (const float*)(p.ws + W_XSF); const bf16_t* Bc = (const bf16_t*)(p.ws + W_BC); float* states = (float*)(p.ws + W_STATES); float* chdec = (float*)(p.ws + W_CHDEC);
    const int voff = (4 * hi + ((lane & 15) >> 2)) * 64 + ((lane >> 4) & 1) * 32 + (lane & 3) * 8;
    LAS const float* cs = (LAS const float*)(lds + SS_CS); LAS const float* dtl = (LAS const float*)(lds + SS_DT);
    for (int it = blockIdx.x; it < 128; it += gridDim.x) { const int b = it >> 4, g = (it >> 3) & 1, c = it & 7, t0 = b * 2048 + c * 256;
        __syncthreads();
        ssd_cumsum(p, t0, g, wid, lane, lds);
        __syncthreads();
        if (tid < 4) chdec[(b * 8 + g * 4 + tid) * 8 + c] = cs[tid * 256 + 255];
        f32x16 acc[4];
#pragma unroll
        for (int nb = 0; nb < 4; ++nb)
#pragma unroll
            for (int r = 0; r < 16; ++r) acc[nb][r] = 0.f;
        for (int ls = 0; ls < 4; ++ls) {
            __syncthreads();
#pragma unroll
            for (int i = 0; i < 8; ++i) { const int f = tid + 512 * i, l = f >> 6, c4 = f & 63, hl = c4 >> 4;
                const float4 v = *(const float4*)(xsf + (size_t)(t0 + 64 * ls + l) * 512 + g * 256 + 4 * c4);
                const float w = __builtin_amdgcn_exp2f(cs[hl * 256 + 255] - cs[hl * 256 + 64 * ls + l]) * dtl[hl * 256 + 64 * ls + l];
                u32x2 o; o.x = cvt_pk_bf16(v.x * w, v.y * w); o.y = cvt_pk_bf16(v.z * w, v.w * w);
                *(LAS u32x2*)(lds + SS_XW + (c4 >> 3) * 4096 + l * 64 + (c4 & 7) * 8) = o; }
#pragma unroll
            for (int i = 0; i < 2; ++i) { const int q = tid + 512 * i, l = q >> 4, ch = q & 15;
                const u32x4 v = *(const u32x4*)(Bc + (size_t)(t0 + 64 * ls + l) * 256 + g * 128 + 8 * ch);
                *(LAS u32x4*)(lds + SS_B1 + (ch >> 2) * 4096 + l * 64 + (ch & 3) * 16) = v; }
            __syncthreads();
#pragma unroll
            for (int ks = 0; ks < 4; ++ks) { const bf16x8 a = trpair(lds + SS_XW + wid * 4096 + voff + ks * 1024);
#pragma unroll
                for (int nb = 0; nb < 4; ++nb) { const bf16x8 bb = trpair(lds + SS_B1 + nb * 4096 + voff + ks * 1024); acc[nb] = MFMA32(a, bb, acc[nb]); } }
        }
        float* so = states + ((size_t)((b * 8 + g * 4 + (wid >> 1)) * 8 + c)) * 8192;
#pragma unroll
        for (int nb = 0; nb < 4; ++nb)
#pragma unroll
            for (int r = 0; r < 16; ++r) so[(32 * (wid & 1) + crow(r, hi)) * 128 + 32 * nb + r32] = acc[nb][r];
    }
}
__device__ __forceinline__ void phase_ssd_scan(const P& p) {
    const int gt = (int)blockIdx.x * 512 + pg8::opaque_tid(); if (gt >= 131072) return;
    const int bh = gt >> 11, rem = gt & 2047, pp = rem >> 5, n4 = rem & 31;
    const float* sb = (const float*)(p.ws + W_STATES) + (size_t)bh * 8 * 8192 + pp * 128 + 4 * n4; const float* cd = (const float*)(p.ws + W_CHDEC) + bh * 8;
    bf16_t* hp = (bf16_t*)(p.ws + W_HPREV) + (size_t)bh * 8 * 8192 + pp * 128 + 4 * n4;
    f32x4 v[8];
#pragma unroll
    for (int c = 0; c < 8; ++c) v[c] = *(const f32x4*)(sb + (size_t)c * 8192);
    f32x4 H = (f32x4){0.f, 0.f, 0.f, 0.f};
#pragma unroll
    for (int c = 0; c < 8; ++c) { u32x2 o; o.x = cvt_pk_bf16(H[0], H[1]); o.y = cvt_pk_bf16(H[2], H[3]); *(u32x2*)(hp + (size_t)c * 8192) = o; H = H * __builtin_amdgcn_exp2f(cd[c]) + v[c]; }
    *(f32x4*)(p.out + O_SSM_P + ((size_t)bh * 64 + pp) * 128 + 4 * n4) = H;
}
constexpr int S2_B = 8192, S2_H = 8192 + 65536, S2_XD = S2_H + 16384;
__device__ __forceinline__ void phase_ssd_pass2(const P& p, LAS unsigned char* lds) {
    const int tid = pg8::opaque_tid(), lane = tid & 63, r32 = lane & 31, hi = lane >> 5; const int wid = __builtin_amdgcn_readfirstlane(tid >> 6);
    const float* xsf = (const float*)(p.ws + W_XSF); const bf16_t* Bc = (const bf16_t*)(p.ws + W_BC); const bf16_t* Cc = (const bf16_t*)(p.ws + W_CC);
    const bf16_t* projp = (const bf16_t*)(p.ws + W_PROJ); bf16_t* cat = (bf16_t*)(p.ws + W_CAT); float* yraw = (float*)(p.ws + W_YRAW);
    const int voff = (4 * hi + ((lane & 15) >> 2)) * 64 + ((lane >> 4) & 1) * 32 + (lane & 3) * 8;
    LAS const float* cs = (LAS const float*)(lds + SS_CS); LAS const float* dtl = (LAS const float*)(lds + SS_DT);
    for (int it = (int)blockIdx.x - 128; it >= 0 && it < 128; it += 128) { const int b = it >> 4, g = (it >> 3) & 1, c = it & 7, t0 = b * 2048 + c * 256;
        const int ll = 32 * wid + r32; const size_t tl = (size_t)t0 + ll;
        __syncthreads();
        ssd_cumsum(p, t0, g, wid, lane, lds);
#pragma unroll
        for (int i = 0; i < 8; ++i) { const int q = tid + 512 * i, s = q >> 4, ch = q & 15;
            const u32x4 v = *(const u32x4*)(Bc + (size_t)(t0 + s) * 256 + g * 128 + 8 * ch);
            *(LAS u32x4*)(lds + S2_B + (s >> 6) * 16384 + off_b(s & 63, ch)) = v; }
        bf16x8 Cf[8];
#pragma unroll
        for (int ks = 0; ks < 8; ++ks) Cf[ks] = *(const bf16x8*)(Cc + tl * 256 + g * 128 + 16 * ks + 8 * hi);
        float4 xq[8]; u32x4 hq[2];
#define S2_FETCH(hh) do { const int h_ = g * 4 + (hh); \
            _Pragma("unroll") for (int i_ = 0; i_ < 8; ++i_) { const int f_ = tid + 512 * i_; xq[i_] = *(const float4*)(xsf + (size_t)(t0 + (f_ >> 4)) * 512 + h_ * 64 + 4 * (f_ & 15)); } \
            if (c > 0) { const bf16_t* hs_ = (const bf16_t*)(p.ws + W_HPREV) + ((size_t)(b * 8 + h_) * 8 + c) * 8192; \
                _Pragma("unroll") for (int i_ = 0; i_ < 2; ++i_) { const int q_ = tid + 512 * i_; hq[i_] = *(const u32x4*)(hs_ + (q_ >> 4) * 128 + 8 * (q_ & 15)); } } } while (0)
        S2_FETCH(0);
        for (int hd = 0; hd < 4; ++hd) { const int h = g * 4 + hd;
            __syncthreads();
            if (c > 0) {
#pragma unroll
                for (int i = 0; i < 2; ++i) { const int q = tid + 512 * i, pp = q >> 4, ch = q & 15; *(LAS u32x4*)(lds + S2_H + off_b(pp, ch)) = hq[i]; } }
#pragma unroll
            for (int i = 0; i < 8; ++i) { const int f = tid + 512 * i, s = f >> 4, c4 = f & 15;
                const float4 v = xq[i]; const float w = dtl[hd * 256 + s];
                u32x2 o; o.x = cvt_pk_bf16(v.x * w, v.y * w); o.y = cvt_pk_bf16(v.z * w, v.w * w);
                *(LAS u32x2*)(lds + S2_XD + (s >> 6) * 8192 + (c4 >> 3) * 4096 + (s & 63) * 64 + (c4 & 7) * 8) = o; }
            if (hd < 3) S2_FETCH(hd + 1);
            f32x16 acc[2];
#pragma unroll
            for (int q = 0; q < 2; ++q)
#pragma unroll
                for (int r = 0; r < 16; ++r) acc[q][r] = 0.f;
            __syncthreads();
            if (c > 0) {
#pragma unroll
                for (int pb = 0; pb < 2; ++pb)
#pragma unroll
                    for (int ks = 0; ks < 8; ++ks) { const bf16x8 a = lds128(lds + S2_H + off_b(32 * pb + r32, 2 * ks + hi)); acc[pb] = MFMA32(a, Cf[ks], acc[pb]); }
                const float e = __builtin_amdgcn_exp2f(cs[hd * 256 + ll]);
#pragma unroll
                for (int r = 0; r < 16; ++r) { acc[0][r] *= e; acc[1][r] *= e; } }
            LAS const float* ch = cs + hd * 256; const float cl = ch[ll];
            for (int kt = 0; kt <= (wid >> 1); ++kt) {
                f32x16 s0, s1;
#pragma unroll
                for (int r = 0; r < 16; ++r) { s0[r] = 0.f; s1[r] = 0.f; }
                LAS const unsigned char* bt = lds + S2_B + kt * 16384;
#pragma unroll
                for (int ks = 0; ks < 8; ++ks) { const bf16x8 a0 = lds128(bt + off_b(r32, 2 * ks + hi)), a1 = lds128(bt + off_b(32 + r32, 2 * ks + hi));
                    s0 = MFMA32(a0, Cf[ks], s0); s1 = MFMA32(a1, Cf[ks], s1); }
#pragma unroll
                for (int g4 = 0; g4 < 4; ++g4) { const int sb = 64 * kt + 8 * g4 + 4 * hi; const f32x4 ca = *(LAS const f32x4*)(ch + sb), cb2 = *(LAS const f32x4*)(ch + sb + 32);
#pragma unroll
                    for (int j = 0; j < 4; ++j) { const int r = 4 * g4 + j;
                        s0[r] = (sb + j <= ll) ? s0[r] * __builtin_amdgcn_exp2f(cl - ca[j]) : 0.f;
                        s1[r] = (sb + 32 + j <= ll) ? s1[r] * __builtin_amdgcn_exp2f(cl - cb2[j]) : 0.f; } }
                bf16x8 pf[4]; pf[0] = pack8(s0, 0); pf[1] = pack8(s0, 1); pf[2] = pack8(s1, 0); pf[3] = pack8(s1, 1);
#pragma unroll
                for (int pb = 0; pb < 2; ++pb)
#pragma unroll
                    for (int ks = 0; ks < 4; ++ks) { const bf16x8 a = trpair(lds + S2_XD + kt * 8192 + pb * 4096 + voff + ks * 1024); acc[pb] = MFMA32(a, pf[ks], acc[pb]); }
            }
            __syncthreads();
            { LAS float* ex = (LAS float*)(lds + S2_XD) + wid * 1152;
              int lt8 = lane >> 3; asm volatile("" : "+v"(lt8));
#pragma unroll
                for (int pb = 0; pb < 2; ++pb) {
#pragma unroll
                    for (int g4 = 0; g4 < 4; ++g4) *(LAS f32x4*)(ex + r32 * 36 + 8 * g4 + 4 * hi) = (f32x4){acc[pb][4 * g4], acc[pb][4 * g4 + 1], acc[pb][4 * g4 + 2], acc[pb][4 * g4 + 3]};
#pragma unroll
                    for (int i = 0; i < 4; ++i) { const int tok = 8 * i + lt8, pc = lane & 7; const size_t tg = (size_t)t0 + 32 * wid + tok;
                        *(f32x4*)(yraw + tg * 512 + h * 64 + 32 * pb + 4 * pc) = *(LAS const f32x4*)(ex + tok * 36 + 4 * pc); } } }
        }
#undef S2_FETCH
        asm volatile("s_waitcnt vmcnt(0)" ::: "memory"); __syncthreads();
        { const int ch = g * 256 + 4 * lane; const float D = p.d_skip[g * 4 + (lane >> 4)]; const float4 gn = *(const float4*)(p.ssm_norm + ch);
          for (int i = 0; i < 4; ++i) { f32x4 yv[8]; float4 xv[8]; u32x2 zr[8]; float gg[8][4], ss[8];
#pragma unroll
              for (int q = 0; q < 8; ++q) { const size_t tg = (size_t)t0 + 32 * wid + 8 * i + q; yv[q] = *(const f32x4*)(yraw + tg * 512 + ch); xv[q] = *(const float4*)(xsf + tg * 512 + ch); zr[q] = *(const u32x2*)(projp + tg * 2304 + 768 + ch); }
#pragma unroll
              for (int q = 0; q < 8; ++q) { gg[q][0] = (yv[q][0] + D * xv[q].x) * silu(bflo(zr[q].x)); gg[q][1] = (yv[q][1] + D * xv[q].y) * silu(bfhi(zr[q].x)); gg[q][2] = (yv[q][2] + D * xv[q].z) * silu(bflo(zr[q].y)); gg[q][3] = (yv[q][3] + D * xv[q].w) * silu(bfhi(zr[q].y));
                  ss[q] = gg[q][0] * gg[q][0] + gg[q][1] * gg[q][1] + gg[q][2] * gg[q][2] + gg[q][3] * gg[q][3]; }
#pragma unroll
              for (int o = 32; o; o >>= 1) {
#pragma unroll
                  for (int q = 0; q < 8; ++q) ss[q] += __shfl_xor(ss[q], o); }
#pragma unroll
              for (int q = 0; q < 8; ++q) { const size_t tg = (size_t)t0 + 32 * wid + 8 * i + q; const float rs = rsqrtf(ss[q] * (1.f / 256.f) + 1e-6f);
                  u32x2 o; o.x = cvt_pk_bf16(gg[q][0] * rs * gn.x, gg[q][1] * rs * gn.y); o.y = cvt_pk_bf16(gg[q][2] * rs * gn.z, gg[q][3] * rs * gn.w); *(u32x2*)(cat + tg * 1024 + 512 + ch) = o; } } }
    }
}
constexpr int SA_Q = 0, SA_T = 36864, SA_TB = 36864, SA_ROPE = 32768, SA_NP0 = 32;
__device__ __forceinline__ void attn_sample_item(const P& p, int b, int split, LAS unsigned char* lds) {
    const int tid = pg8::opaque_tid(), lane = tid & 63, r32 = lane & 31, hi = lane >> 5; const int wid = __builtin_amdgcn_readfirstlane(tid >> 6);
    const bool loader = wid >= 4; const int qb = wid & 1, kb = (wid >> 1) & 1, ltid = tid & 255;
    const bf16_t* Qs = (const bf16_t*)(p.ws + W_QS);
    __syncthreads();
    for (int idx = tid; idx < 2304; idx += 512) { const int qrow = idx / 36, ch = idx % 36;
        *(LAS u32x4*)(lds + SA_Q + ch * 1024 + qrow * 16) = *(const u32x4*)(Qs + (size_t)(b * 64 + qrow) * 288 + 8 * ch); }
    const int pg0 = split ? SA_NP0 : 0, nreal = 2 * (split ? 64 - SA_NP0 : SA_NP0), ntiles = nreal + (split ? 1 : 0);
    const int lw4 = ltid >> 6, ld4 = ltid & 63, lch = (ld4 & 31) >> 1, lbase = (ld4 >> 5) * 16384 + 256 * lw4 + 8 * (ld4 & 1), lrope = SA_ROPE + ((ltid & 7) >> 1) * 1024 + (ltid >> 3) * 16 + (ltid & 1) * 8;
#define SA_LOAD(st, t) do { const unsigned pg_ = (unsigned)__builtin_amdgcn_readlane(ptv, (t) >> 1); const unsigned skv_ = pg_ * 131072u + ((t) & 1) * 65536u, skr_ = pg_ * 16384u + ((t) & 1) * 8192u; \
        _Pragma("unroll") for (int i_ = 0; i_ < 16; ++i_) st[i_] = __builtin_bit_cast(f32x4, __builtin_amdgcn_raw_buffer_load_b128(rkv, lvo, skv_ + 4096u * i_, 2)); \
        st[16] = __builtin_bit_cast(f32x4, __builtin_amdgcn_raw_buffer_load_b128(rkr, lvo, skr_, 2)); st[17] = __builtin_bit_cast(f32x4, __builtin_amdgcn_raw_buffer_load_b128(rkr, lvo, skr_ + 4096u, 2)); } while (0)
#define SA_WRITE(st, buf) do { LAS unsigned char* tb_ = lds + SA_T + (buf) * SA_TB; int lb_ = lbase, lc_ = lch; asm volatile("" : "+v"(lb_), "+v"(lc_)); \
        _Pragma("unroll") for (int i_ = 0; i_ < 16; ++i_) { u32x2 o_; o_.x = cvt_pk_bf16(st[i_][0], st[i_][1]); o_.y = cvt_pk_bf16(st[i_][2], st[i_][3]); \
            *(LAS u32x2*)(tb_ + lb_ + 1024 * i_ + 16 * (lc_ ^ ((lw4 << 2) | (i_ & 3)))) = o_; } \
        _Pragma("unroll") for (int j_ = 0; j_ < 2; ++j_) { u32x2 o_; o_.x = cvt_pk_bf16(st[16 + j_][0], st[16 + j_][1]); o_.y = cvt_pk_bf16(st[16 + j_][2], st[16 + j_][3]); *(LAS u32x2*)(tb_ + lrope + 512 * j_) = o_; } } while (0)
#define SA_STAGE_NEW(buf) do { LAS unsigned char* tn_ = lds + SA_T + (buf) * SA_TB;     \
        int ltid = tid; asm volatile("" : "+v"(ltid)); ltid &= 255;     \
        { const int key_ = ltid >> 5, c32_ = ltid & 31; *(LAS u32x4*)(tn_ + (c32_ >> 4) * 16384 + off_b(key_, c32_ & 15)) = *(const u32x4*)((const bf16_t*)(p.ws + W_CB) + (size_t)(TP + b * 8 + key_) * 256 + 8 * c32_); } \
        if (ltid < 32) { const int key_ = ltid >> 2, pc_ = ltid & 3; *(LAS u32x4*)(tn_ + SA_ROPE + pc_ * 1024 + key_ * 16) = *(const u32x4*)((const bf16_t*)(p.ws + W_KRS) + (size_t)(b * 8 + key_) * 32 + 8 * pc_); } } while (0)
    const int q4 = (lane & 15) >> 2, p4 = lane & 3, blk = (lane >> 4) & 1, lq = 4 * qb + (r32 >> 3);
    const int kxor = ((r32 & 3) << 2) | ((r32 >> 2) & 3), krow = 256 * (32 * kb + r32), txl = (q4 << 2) | hi, trow = 256 * (32 * kb + 4 * hi + q4) + 8 * (p4 & 1);
#define SA_COMPUTE(t, buf) do { LAS const unsigned char* tb = lds + SA_T + (buf) * SA_TB; int kx_ = kxor, txl_ = txl, txh_ = txl + 2, krow_ = krow, trow_ = trow; asm volatile("" : "+v"(kx_), "+v"(txl_), "+v"(txh_), "+v"(krow_), "+v"(trow_)); \
        f32x16 s; \
        _Pragma("unroll") for (int r = 0; r < 16; ++r) s[r] = 0.f; \
        _Pragma("unroll") for (int ks = 0; ks < 16; ++ks) { const bf16x8 a = lds128(tb + (ks >> 3) * 16384 + krow_ + 16 * ((2 * (ks & 7) + hi) ^ kx_)), bq = lds128(lds + SA_Q + (2 * ks + hi) * 1024 + (32 * qb + r32) * 16); s = MFMA32(a, bq, s); if ((ks & 3) == 3) __builtin_amdgcn_sched_barrier(0); } \
        _Pragma("unroll") for (int ks = 16; ks < 18; ++ks) { const bf16x8 a = lds128(tb + SA_ROPE + (2 * (ks - 16) + hi) * 1024 + (32 * kb + r32) * 16), bq = lds128(lds + SA_Q + (2 * ks + hi) * 1024 + (32 * qb + r32) * 16); s = MFMA32(a, bq, s); } \
        if ((t) == nreal) { _Pragma("unroll") for (int r = 0; r < 16; ++r) { const int key = 32 * kb + crow(r, hi); if (key >= 8 || key > lq) s[r] = -INFINITY; } } \
        float mx = max16(s); mx = fmaxf(mx, __shfl_xor(mx, 32)); \
        const float m_new = fmaxf(m_run, mx), alpha = __builtin_amdgcn_exp2f(m_run - m_new); m_run = m_new; \
        float ps = 0.f; \
        _Pragma("unroll") for (int r = 0; r < 16; ++r) { s[r] = __builtin_amdgcn_exp2f(s[r] - m_new); ps += s[r]; } \
        l_run = l_run * alpha + ps; \
        if (__any(alpha != 1.f)) { _Pragma("unroll") for (int d = 0; d < 8; ++d) _Pragma("unroll") for (int r = 0; r < 16; ++r) o[d][r] *= alpha; } \
        bf16x8 pf[2]; pf[0] = pack8(s, 0); pf[1] = pack8(s, 1); \
        _Pragma("unroll") for (int sx = 0; sx < 2; ++sx) _Pragma("unroll") for (int db = 0; db < 8; ++db) { const int ch = 4 * (db & 3) + 2 * blk + (p4 >> 1); \
                const s16x4 lo = tr_read(tb + (db >> 2) * 16384 + trow_ + 4096 * sx + 16 * (ch ^ txl_)), hh = tr_read(tb + (db >> 2) * 16384 + trow_ + 4096 * sx + 2048 + 16 * (ch ^ txh_)); \
                const bf16x8 a = __builtin_shufflevector(lo, hh, 0, 1, 2, 3, 4, 5, 6, 7); o[db] = MFMA32(a, pf[sx], o[db]); if ((db & 3) == 3) __builtin_amdgcn_sched_barrier(0); } } while (0)
    if (loader) {
        const __amdgpu_buffer_rsrc_t rkv = __builtin_amdgcn_make_buffer_rsrc((void*)p.ckv, 0, 0x7ffffffc, 0x00020000), rkr = __builtin_amdgcn_make_buffer_rsrc((void*)p.ckr, 0, 0x7ffffffc, 0x00020000);
        const int lvo = ltid * 16, ptv = p.pt[b * 64 + pg0 + (lane & 31)];
        f32x4 stA[18], stB[18], stC[18];
        SA_LOAD(stA, 0); SA_LOAD(stB, 1); SA_LOAD(stC, 2); SA_WRITE(stA, 0);
        __syncthreads();
#define SA_FAST(k, SL, SW, BUF) { SA_LOAD(SL, t + (k) + 3); SA_WRITE(SW, BUF); __syncthreads(); }
#define SA_STEP(k, SL, SW, BUF) { if (t + (k) + 3 < nreal) SA_LOAD(SL, t + (k) + 3); \
            if (t + (k) + 1 < nreal) SA_WRITE(SW, BUF); else if (t + (k) + 1 < ntiles) SA_STAGE_NEW(BUF); \
            __syncthreads(); \
            if (t + (k) + 1 >= ntiles) break; }
        int t = 0;
        for (; t + 8 < nreal; t += 6) {
            SA_FAST(0, stA, stB, 1) SA_FAST(1, stB, stC, 0) SA_FAST(2, stC, stA, 1) SA_FAST(3, stA, stB, 0) SA_FAST(4, stB, stC, 1) SA_FAST(5, stC, stA, 0) }
        for (;; t += 6) {
            SA_STEP(0, stA, stB, 1) SA_STEP(1, stB, stC, 0) SA_STEP(2, stC, stA, 1) SA_STEP(3, stA, stB, 0) SA_STEP(4, stB, stC, 1) SA_STEP(5, stC, stA, 0) }
#undef SA_STEP
#undef SA_FAST
        __syncthreads();
    } else {
    f32x16 o[8];
#pragma unroll
    for (int d = 0; d < 8; ++d)
#pragma unroll
        for (int r = 0; r < 16; ++r) o[d][r] = 0.f;
    float m_run = -INFINITY, l_run = 0.f;
        __syncthreads();
        for (int t = 0; t < ntiles; t += 2) {
            SA_COMPUTE(t, 0);
            __syncthreads();
            if (t + 1 >= ntiles) break;
            SA_COMPUTE(t + 1, 1);
            __syncthreads(); }
        const float l_tot = l_run + __shfl_xor(l_run, 32);
        LAS float* xo = (LAS float*)(lds + SA_T) + qb * 8192; LAS float* xs = (LAS float*)(lds + SA_T + 65536) + qb * 128;
        if (kb == 1) {
#pragma unroll
            for (int d = 0; d < 8; ++d)
#pragma unroll
                for (int r = 0; r < 16; ++r) xo[(d * 16 + r) * 64 + lane] = o[d][r];
            xs[lane] = m_run; xs[64 + lane] = l_tot; }
        __syncthreads();
        if (kb == 0) { const float m1 = xs[lane], l1 = xs[64 + lane], m = fmaxf(m_run, m1), w0 = __builtin_amdgcn_exp2f(m_run - m), w1 = __builtin_amdgcn_exp2f(m1 - m), l = l_tot * w0 + l1 * w1;
            float* po = (float*)(p.ws + W_PO) + ((size_t)(b * 2 + split) * 64 + 32 * qb + r32) * 256 + 4 * hi;
#pragma unroll
            for (int d = 0; d < 8; ++d)
#pragma unroll
                for (int g4 = 0; g4 < 4; ++g4) { float4 v;
                    v.x = o[d][4 * g4] * w0 + xo[(d * 16 + 4 * g4) * 64 + lane] * w1; v.y = o[d][4 * g4 + 1] * w0 + xo[(d * 16 + 4 * g4 + 1) * 64 + lane] * w1;
                    v.z = o[d][4 * g4 + 2] * w0 + xo[(d * 16 + 4 * g4 + 2) * 64 + lane] * w1; v.w = o[d][4 * g4 + 3] * w0 + xo[(d * 16 + 4 * g4 + 3) * 64 + lane] * w1;
                    *(float4*)(po + 32 * d + 8 * g4) = v; }
            if (hi == 0) { float* pm = (float*)(p.ws + W_PML) + ((size_t)(b * 2 + split) * 64 + 32 * qb + r32) * 2; pm[0] = m; pm[1] = l; } }
    }
#undef SA_LOAD
#undef SA_WRITE
#undef SA_STAGE_NEW
#undef SA_COMPUTE
}
__device__ __forceinline__ void phase_attn_sample(const P& p, LAS unsigned char* lds) {
    for (int it = blockIdx.x; it < 256; it += gridDim.x) attn_sample_item(p, it >> 1, it & 1, lds);
}
__device__ __forceinline__ void phase_sample_combine(const P& p, LAS unsigned char* lds) {
    const int tid = pg8::opaque_tid(); LAS float* ol = (LAS float*)lds;
    const float* po = (const float*)(p.ws + W_PO); const float* pm = (const float*)(p.ws + W_PML); bf16_t* cat = (bf16_t*)(p.ws + W_CAT);
    for (int b = blockIdx.x; b < 128; b += gridDim.x) {
        __syncthreads();
        { const int row = tid >> 3, seg = tid & 7; const float m0 = pm[((size_t)(b * 2) * 64 + row) * 2], l0 = pm[((size_t)(b * 2) * 64 + row) * 2 + 1], m1 = pm[((size_t)(b * 2 + 1) * 64 + row) * 2], l1 = pm[((size_t)(b * 2 + 1) * 64 + row) * 2 + 1];
          const float m = fmaxf(m0, m1), w0 = __builtin_amdgcn_exp2f(m0 - m), w1 = __builtin_amdgcn_exp2f(m1 - m), li = 1.f / (l0 * w0 + l1 * w1);
#pragma unroll
          for (int j = 0; j < 8; ++j) { const float4 a = *(const float4*)(po + ((size_t)(b * 2) * 64 + row) * 256 + seg * 32 + 4 * j), c = *(const float4*)(po + ((size_t)(b * 2 + 1) * 64 + row) * 256 + seg * 32 + 4 * j);
              *(LAS f32x4*)(ol + ((row & 7) * 8 + (row >> 3)) * 260 + seg * 32 + 4 * j) = (f32x4){(a.x * w0 + c.x * w1) * li, (a.y * w0 + c.y * w1) * li, (a.z * w0 + c.z * w1) * li, (a.w * w0 + c.w * w1) * li}; } }
        __syncthreads();
        { const int h = tid >> 6, l = (tid >> 3) & 7, v0 = (tid & 7) * 8; const float* wv = p.w_uv + (size_t)h * 16384 + v0; LAS const float* orow = ol + (h * 8 + l) * 260; float acc[8];
#pragma unroll
          for (int j = 0; j < 8; ++j) acc[j] = 0.f;
#pragma unroll 8
          for (int r = 0; r < 256; ++r) { const float ov = orow[r]; const float4 a = *(const float4*)(wv + r * 64), c = *(const float4*)(wv + r * 64 + 4);
              acc[0] += ov * a.x; acc[1] += ov * a.y; acc[2] += ov * a.z; acc[3] += ov * a.w; acc[4] += ov * c.x; acc[5] += ov * c.y; acc[6] += ov * c.z; acc[7] += ov * c.w; }
          u32x4 w; w.x = cvt_pk_bf16(acc[0], acc[1]); w.y = cvt_pk_bf16(acc[2], acc[3]); w.z = cvt_pk_bf16(acc[4], acc[5]); w.w = cvt_pk_bf16(acc[6], acc[7]);
          *(u32x4*)(cat + (size_t)(TP + b * 8 + l) * 1024 + h * 64 + v0) = w; }
    }
}
constexpr int SG_ST = 32768;
template <class Epi> __device__ __forceinline__ void sg_tile(LAS unsigned char* lds, const bf16_t* A, int lda, const bf16_t* Bt, int ldb, int K, int m0, int n0, const Epi& E) {
    const int tid = pg8::opaque_tid(), lane = tid & 63, fr = lane & 15, fq = lane >> 4; const int wid = __builtin_amdgcn_readfirstlane(tid >> 6), wr = wid >> 2, wc = wid & 3;
    const int nch = K >> 6;
    unsigned voffA[2], voffB[2];
#pragma unroll
    for (int i = 0; i < 2; ++i) { int R, C; pg8::stage_rc(tid * 16 + i * 8192, R, C); voffA[i] = (unsigned)(R * lda + C) * 2u; voffB[i] = (unsigned)(R * ldb + C) * 2u; }
    const char* gA = (const char*)(A + (size_t)m0 * lda); const char* gB = (const char*)(Bt + (size_t)n0 * ldb);
    const int aoff = pg8::lds_byte(wr * 64 + fr, fq * 8), boff = pg8::lds_byte(wc * 32 + fr, fq * 8);
    f32x4 acc[4][2];
#pragma unroll
    for (int m = 0; m < 4; ++m)
#pragma unroll
        for (int n = 0; n < 2; ++n) acc[m][n] = (f32x4){0.f, 0.f, 0.f, 0.f};
#define SG_ISSUE(c) do { const int st_ = (c) & 3; _Pragma("unroll") for (int i_ = 0; i_ < 2; ++i_) { \
        glds16(gA + (size_t)(c) * 128 + voffA[i_], lds + st_ * SG_ST + wid * 1024 + i_ * 8192); \
        glds16(gB + (size_t)(c) * 128 + voffB[i_], lds + st_ * SG_ST + 16384 + wid * 1024 + i_ * 8192); } } while (0)
    __syncthreads();
    SG_ISSUE(0); SG_ISSUE(1); SG_ISSUE(2);
    for (int c = 0; c < nch; ++c) { const int rem = nch - 1 - c;
        if (rem >= 2) asm volatile("s_waitcnt vmcnt(8)" ::: "memory"); else if (rem == 1) asm volatile("s_waitcnt vmcnt(4)" ::: "memory"); else asm volatile("s_waitcnt vmcnt(0)" ::: "memory");
        __builtin_amdgcn_s_barrier(); asm volatile("" ::: "memory");
        if (c + 3 < nch) SG_ISSUE(c + 3);
        LAS const unsigned char* ab = lds + (c & 3) * SG_ST + aoff; LAS const unsigned char* bb = lds + (c & 3) * SG_ST + 16384 + boff;
        bf16x8 At[4][2], Bf[2][2];
#pragma unroll
        for (int n = 0; n < 2; ++n)
#pragma unroll
            for (int k = 0; k < 2; ++k) Bf[n][k] = lds128(bb + n * 2048 + k * 1024);
#pragma unroll
        for (int m = 0; m < 4; ++m)
#pragma unroll
            for (int k = 0; k < 2; ++k) At[m][k] = lds128(ab + m * 2048 + k * 1024);
#pragma unroll
        for (int m = 0; m < 4; ++m)
#pragma unroll
            for (int n = 0; n < 2; ++n)
#pragma unroll
                for (int k = 0; k < 2; ++k) acc[m][n] = __builtin_amdgcn_mfma_f32_16x16x32_bf16(Bf[n][k], At[m][k], acc[m][n], 0, 0, 0);
    }
#undef SG_ISSUE
    E(acc, m0 + wr * 64 + fr, n0 + wc * 32 + 4 * fq, (n0 >> 7) * 4 + wc, fq);
}
struct SgRes {
    const float* xs; bf16_t* Cb; float* ssqS;
    __device__ __forceinline__ void operator()(const f32x4 (&acc)[4][2], int row0, int col0, int slot, int fq) const {
#pragma unroll
        for (int m = 0; m < 4; ++m) { const int row = row0 + 16 * m; float ss = 0.f;
#pragma unroll
            for (int n = 0; n < 2; ++n) { const int col = col0 + 16 * n; const f32x4 v = acc[m][n] + *(const f32x4*)(xs + (size_t)row * 1024 + col); ss += v[0] * v[0] + v[1] * v[1] + v[2] * v[2] + v[3] * v[3];
                u32x2 w; w.x = cvt_pk_bf16(v[0], v[1]); w.y = cvt_pk_bf16(v[2], v[3]); *(u32x2*)(Cb + (size_t)(TP + row) * 1024 + col) = w; }
            ss += __shfl_xor(ss, 16); ss += __shfl_xor(ss, 32); if (fq == 0) ssqS[(size_t)row * 32 + slot] = ss; } }
};
struct SgUp {
    bf16_t* O; const float* ssqS;
    __device__ __forceinline__ void operator()(const f32x4 (&acc)[4][2], int row0, int col0, int slot, int fq) const {
#pragma unroll
        for (int m = 0; m < 4; ++m) { const int row = row0 + 16 * m; const f32x4* sp = (const f32x4*)(ssqS + (size_t)row * 32); f32x4 t = sp[0];
#pragma unroll
            for (int q = 1; q < 8; ++q) t += sp[q];
            const float rs = rsqrtf((t[0] + t[1] + t[2] + t[3]) * (1.f / 1024.f) + 1e-6f), rs2 = rs * rs;
#pragma unroll
            for (int n = 0; n < 2; ++n) { float v[4];
#pragma unroll
                for (int j = 0; j < 4; ++j) { const float q = fmaxf(acc[m][n][j], 0.f); v[j] = q * q * rs2; }
                u32x2 w; w.x = cvt_pk_bf16(v[0], v[1]); w.y = cvt_pk_bf16(v[2], v[3]); *(u32x2*)(O + (size_t)(TP + row) * 4096 + col0 + 16 * n) = w; } } }
};
struct SgSlab {
    float* C;
    __device__ __forceinline__ void operator()(const f32x4 (&acc)[4][2], int row0, int col0, int slot, int fq) const {
#pragma unroll
        for (int m = 0; m < 4; ++m)
#pragma unroll
            for (int n = 0; n < 2; ++n) *(f32x4*)(C + (size_t)(row0 + 16 * m) * 1024 + col0 + 16 * n) = acc[m][n]; }
};
#ifndef REP_P0
#define REP_P0 1
#endif
#ifndef REP_P1
#define REP_P1 1
#endif
#ifndef REP_P2
#define REP_P2 1
#endif
#ifndef REP_P6
#define REP_P6 1
#endif
#ifndef REP_P7
#define REP_P7 1
#endif
#ifndef REP_P8
#define REP_P8 1
#endif
#ifndef REP_P9
#define REP_P9 1
#endif
#ifndef REP_CB
#define REP_CB 1
#endif
#ifndef REP_TC
#define REP_TC 1
#endif
#ifndef REP_AP
#define REP_AP 1
#endif
#ifndef REP_AS
#define REP_AS 1
#endif
#ifndef REP_S2
#define REP_S2 1
#endif
#ifndef REP_SS
#define REP_SS 1
#endif
#ifndef REP_S1
#define REP_S1 1
#endif
__global__ void __launch_bounds__(512, 2) mega(P p) {
    extern __shared__ __attribute__((aligned(16))) unsigned char lds[];
    LAS unsigned char* ldsl = (LAS unsigned char*)lds;
    if (threadIdx.x < 4) ((volatile LAS unsigned*)(ldsl + LDS_XB))[threadIdx.x] = 0u;
    __syncthreads();
    XcdBarrier bar = xcd_barrier_post((unsigned*)(p.ws + W_CTL), (volatile LAS unsigned*)(ldsl + LDS_XB));
    const int lo = p.ph_lo, hi = p.ph_hi;
#define IN(k) (lo <= (k) && (k) < hi)
#ifdef PROF_SEAM
    unsigned long long prof_t0 = __builtin_amdgcn_s_memrealtime(), prof_tk = 0ull;
#define SEAM(k) do { if (IN(k) && IN((k) + 1)) xcd_barrier(bar); if ((k) == PROF_SEAM) prof_tk = __builtin_amdgcn_s_memrealtime(); } while (0)
#else
#define SEAM(k) do { if (IN(k) && IN((k) + 1)) xcd_barrier(bar); } while (0)
#endif
    if (IN(0)) { for (int rep_ = 0; rep_ < REP_P0; ++rep_) { __syncthreads(); phase_prep(p, lds); } }
    SEAM(0);
    if (IN(1)) for (int rep_ = 0; rep_ < REP_P1; ++rep_) { pg8::Gemm g{(const bf16_t*)(p.ws + W_HN), (const bf16_t*)(p.ws + W_BIN), T, 2304, 1024}; pg8::StaticOrder S; S.init(T, 2304, gridDim.x, (int)blockIdx.x);
        pg8::EpiBf16<0> E{(bf16_t*)(p.ws + W_PROJ), 2304, nullptr, 0, 0}; pg8::gemm_phase<pg8::EpiBf16<0>, pg8::StaticOrder>(ldsl, g, S, E, nullptr);
        if (blockIdx.x >= 100) tconv_run(p, lds, 340 + (int)blockIdx.x - 100, 1120, 156); }
    SEAM(1);
    if (IN(2)) { for (int rep_ = 0; rep_ < REP_P2; ++rep_) phase_thin(p); }
    SEAM(2);
    if (IN(3)) {
        const float qscale = 0.14724418f;
        const bf16_t* qn = (const bf16_t*)(p.ws + W_QN); const float* rope = (const float*)(p.ws + W_ROPE);
        if (blockIdx.x < 128) { for (int rep_ = 0; rep_ < REP_S1; ++rep_) phase_ssd_pass1(p, ldsl); __syncthreads(); }
        else { pg8::Gemm g{(const bf16_t*)(p.ws + W_CB), (const bf16_t*)(p.ws + W_BKV), TP, 1024, 256}; pg8::StaticOrder S; S.init(TP, 1024, 128, (int)blockIdx.x - 128);
          EpiKV E{(bf16_t*)(p.ws + W_KP), (bf16_t*)(p.ws + W_VP)}; pg8::gemm_phase<EpiKV, pg8::StaticOrder>(ldsl, g, S, E, nullptr); }
        asm volatile("" ::: "memory"); __builtin_amdgcn_sched_barrier(0);
        { pg8::Gemm g{qn, (const bf16_t*)(p.ws + W_BUQP), TP, 768, 384}; pg8::StaticOrder S; S.init(TP, 768, gridDim.x, (int)blockIdx.x);
          EpiQ<96, 64, 0> E{(bf16_t*)(p.ws + W_QP), 768, rope, qscale}; pg8::gemm_phase<EpiQ<96, 64, 0>, pg8::StaticOrder>(ldsl, g, S, E, nullptr); }
        asm volatile("" ::: "memory"); __builtin_amdgcn_sched_barrier(0);
        { pg8::Gemm g{qn + (size_t)TP * 384, (const bf16_t*)(p.ws + W_BQS), TS, 2304, 384}; pg8::StaticOrder S; S.init(TS, 2304, gridDim.x, (int)((blockIdx.x + 64) & 255));
          EpiQ<288, 256, 1> E{(bf16_t*)(p.ws + W_QS), 2304, rope, qscale}; pg8::gemm_phase<EpiQ<288, 256, 1>, pg8::StaticOrder>(ldsl, g, S, E, nullptr); }
    }
    SEAM(3);
#ifdef PROF_SEC
    unsigned long long sec_acc = 0ull, sec_t0 = 0ull;
#define SEC_B(id) do { if (PROF_SEC == (id)) { __syncthreads(); sec_t0 = __builtin_amdgcn_s_memrealtime(); } } while (0)
#define SEC_E(id) do { if (PROF_SEC == (id)) { __syncthreads(); sec_acc += __builtin_amdgcn_s_memrealtime() - sec_t0; } } while (0)
#else
#define SEC_B(id) do { } while (0)
#define SEC_E(id) do { } while (0)
#endif
    if (IN(5)) { const bool odd = (blockIdx.x >> 3) & 1;
        SEC_B(4); phase_ssd_scan(p); SEC_E(4);
        if (odd) { SEC_B(1); for (int rep_ = 0; rep_ < REP_AS; ++rep_) phase_attn_sample(p, ldsl); SEC_E(1); }
        SEC_B(2); for (int rep_ = 0; rep_ < REP_AP; ++rep_) phase_attn_prompt(p, ldsl); SEC_E(2);
        __syncthreads();
        SEC_B(3); for (int rep_ = 0; rep_ < REP_SS; ++rep_) phase_ssd_sample(p, ldsl); SEC_E(3);
        if (!odd) { SEC_B(1); for (int rep_ = 0; rep_ < REP_AS; ++rep_) phase_attn_sample(p, ldsl); SEC_E(1); } }
    SEC_B(5); SEAM(5); SEC_E(5);
    if (IN(6)) { if (blockIdx.x < 128) { SEC_B(6); phase_sample_combine(p, ldsl); SEC_E(6); SEC_B(7); tconv_run(p, lds, 1120 + (int)blockIdx.x, 1492, 128); SEC_E(7); }
        else { SEC_B(8); for (int rep_ = 0; rep_ < REP_S2; ++rep_) phase_ssd_pass2(p, ldsl); SEC_E(8); } }
    SEC_B(9); SEAM(6); SEC_E(9);
    if (IN(7)) for (int rep_ = 0; rep_ < REP_P6; ++rep_) { const bf16_t* catp = (const bf16_t*)(p.ws + W_CAT); const bf16_t* Bo = (const bf16_t*)(p.ws + W_BOUT);
        { pg8::Gemm g{catp, Bo, TP, 1024, 1024}; pg8::StaticOrder S; S.init(TP, 1024, gridDim.x, (int)blockIdx.x);
          EpiRes<false> E{p.x_p, p.x_s, (bf16_t*)(p.ws + W_X1B), (float*)(p.ws + W_SSQ1)}; pg8::gemm_phase<EpiRes<false>, pg8::StaticOrder>(ldsl, g, S, E, nullptr); }
        if (blockIdx.x >= 192) { const int c_ = (int)blockIdx.x - 192; SgRes E{p.x_s, (bf16_t*)(p.ws + W_X1B), (float*)(p.ws + W_SSQS)};
            sg_tile(ldsl, catp + (size_t)TP * 1024, 1024, Bo, 1024, 1024, (c_ >> 3) * 128, (c_ & 7) * 128, E); } }
    SEAM(7);
    if (IN(8)) for (int rep_ = 0; rep_ < REP_P7; ++rep_) { const bf16_t* x1b = (const bf16_t*)(p.ws + W_X1B); const bf16_t* Bu = (const bf16_t*)(p.ws + W_BUP);
        { pg8::Gemm g{x1b, Bu, TP, 4096, 1024}; pg8::StaticOrder S; S.init(TP, 4096, gridDim.x, (int)blockIdx.x);
          LAS float* rsl = (LAS float*)(ldsl + 131072);
          { pg8::Unit u0; S.next(0, u0); const int t_ = pg8::opaque_tid();
            if (t_ < 256) { const f32x4* sp = (const f32x4*)((const float*)(p.ws + W_SSQ1) + (size_t)(u0.pm * 256 + t_) * 16); const f32x4 a = sp[0], b = sp[1], c = sp[2], d = sp[3];
                const float tot = (a[0] + a[1] + a[2] + a[3]) + (b[0] + b[1] + b[2] + b[3]) + (c[0] + c[1] + c[2] + c[3]) + (d[0] + d[1] + d[2] + d[3]);
                const float rs = rsqrtf(tot * (1.f / 1024.f) + 1e-6f); rsl[t_] = rs * rs; }
            __syncthreads(); }
          SEC_B(10); EpiUp E{(bf16_t*)(p.ws + W_U), rsl}; pg8::gemm_phase<EpiUp, pg8::StaticOrder>(ldsl, g, S, E, nullptr); SEC_E(10); }
        { SEC_B(11); const int c_ = (int)blockIdx.x & 255; SgUp E{(bf16_t*)(p.ws + W_U), (const float*)(p.ws + W_SSQS)};
          sg_tile(ldsl, x1b + (size_t)TP * 1024, 1024, Bu, 1024, 1024, (c_ >> 5) * 128, (c_ & 31) * 128, E); SEC_E(11); } }
    SEC_B(12); SEAM(8); SEC_E(12);
    if (IN(9)) for (int rep_ = 0; rep_ < REP_P8; ++rep_) { const bf16_t* U = (const bf16_t*)(p.ws + W_U); const bf16_t* Bd = (const bf16_t*)(p.ws + W_BDOWN); const bf16_t* x1 = (const bf16_t*)(p.ws + W_X1B);
        { pg8::Gemm g{U, Bd, TP, 1024, 4096}; pg8::StaticOrder S; S.init(TP, 1024, gridDim.x, (int)blockIdx.x);
          EpiRes<true> E{x1, x1, (bf16_t*)(p.ws + W_X2B), (float*)(p.ws + W_SSQ2)}; pg8::gemm_phase<EpiRes<true>, pg8::StaticOrder>(ldsl, g, S, E, nullptr); }
        { const int c_ = (int)blockIdx.x & 255, sl = c_ & 3, tile = c_ >> 2; SgSlab E{(float*)(p.ws + W_SLAB) + (size_t)sl * 1024 * 1024};
          sg_tile(ldsl, U + (size_t)TP * 4096 + sl * 1024, 4096, Bd + sl * 1024, 4096, 1024, (tile >> 3) * 128, (tile & 7) * 128, E); } }
    SEAM(9);
    if (IN(10)) { for (int rep_ = 0; rep_ < REP_P9; ++rep_) phase_final(p); }
#ifdef PROF_SEAM
    if (blockIdx.x == 0 && threadIdx.x == 0) { const unsigned long long te = __builtin_amdgcn_s_memrealtime(), wait = (prof_tk - prof_t0) * 8ull;
        while (__builtin_amdgcn_s_memrealtime() - te < wait) __builtin_amdgcn_s_sleep(8); }
#endif
#ifdef PROF_SEC
    if (blockIdx.x == PROF_BLK && threadIdx.x == 0) { const unsigned long long te = __builtin_amdgcn_s_memrealtime(), wait = sec_acc * 32ull;
        while (__builtin_amdgcn_s_memrealtime() - te < wait) __builtin_amdgcn_s_sleep(8); }
#endif
#undef IN
#undef SEAM
}

static void fill_params(P& p, void* const* d_in, float* out, unsigned char* ws) {
    p.x_p = (const float*)d_in[0]; p.x_s = (const float*)d_in[1]; p.ckv = (const float*)d_in[2]; p.ckr = (const float*)d_in[3]; p.st_ssm = (const float*)d_in[4]; p.st_conv = (const float*)d_in[5];
    p.pt = (const int*)d_in[6]; p.norm_attn = (const float*)d_in[7]; p.w_in = (const float*)d_in[8]; p.q_norm = (const float*)d_in[9]; p.kv_norm = (const float*)d_in[10]; p.w_uq = (const float*)d_in[11];
    p.w_uk = (const float*)d_in[12]; p.w_uv = (const float*)d_in[13]; p.conv_w = (const float*)d_in[14]; p.conv_b = (const float*)d_in[15]; p.dt_bias = (const float*)d_in[16]; p.a_log = (const float*)d_in[17];
    p.d_skip = (const float*)d_in[18]; p.ssm_norm = (const float*)d_in[19]; p.w_out = (const float*)d_in[20]; p.norm_mlp = (const float*)d_in[21]; p.w_up = (const float*)d_in[22]; p.w_down = (const float*)d_in[23];
    p.norm_final = (const float*)d_in[24]; p.out = out; p.ws = ws;
}
static bool launch(void* const* d_in, float* out, unsigned char* ws, int ph_lo, int ph_hi, hipStream_t stream) {
    static int ready = 0;
    if (!ready) {
        if (hipFuncSetAttribute((const void*)mega, hipFuncAttributeMaxDynamicSharedMemorySize, LDS_BYTES) != hipSuccess) { fprintf(stderr, "mk: hipFuncSetAttribute failed\n"); ready = -1; }
        else { int per_cu = 0; if (hipOccupancyMaxActiveBlocksPerMultiprocessor(&per_cu, (const void*)mega, 512, LDS_BYTES) != hipSuccess || per_cu < 1) fprintf(stderr, "mk: occupancy query says %d\n", per_cu); (void)hipGetLastError(); ready = 1; }
    }
    if (ready < 0) return false;
    hipMemsetAsync(ws + W_CTL, 0, 16384, stream);
    P p{}; fill_params(p, d_in, out, ws); p.ph_lo = ph_lo; p.ph_hi = ph_hi;
    hipLaunchKernelGGL(mega, dim3(256), dim3(512), LDS_BYTES, stream, p);
    return hipPeekAtLastError() == hipSuccess;
}
}
extern "C" void kernel_launch(void* const* d_in, const int* in_sizes, int n_in, void* d_out, int out_size, void* d_ws, size_t ws_size, hipStream_t stream) {
    if (n_in != 25 || out_size != (int)mk::O_TOTAL || ws_size < mk::W_END) { fprintf(stderr, "kernel_launch: unexpected shapes (n_in %d, out %d, ws %zu)\n", n_in, out_size, ws_size); return; }
    mk::launch(d_in, (float*)d_out, (unsigned char*)d_ws, 0, 11, stream);
}
```
